# Optimizing an MI355X kernel written in HIP

```python
import math
import jax
import jax.numpy as jnp
from jax import lax
import numpy as np

D_MODEL = 1024
BATCH = 2
SEQ = 8192
DEPTH = 2

CTX_LEN = 256
GRID_W = 64
MIX_W = D_MODEL
FOURIER_W = MIX_W // 4
FOURIER_GROUPS = 4
FOURIER_GD = FOURIER_W // FOURIER_GROUPS
POOL_W = MIX_W // 4
POOL_WINDOWS = (2, 4, 8, 16)
POOL_GD = POOL_W // len(POOL_WINDOWS)
ATTN_W = MIX_W - FOURIER_W - POOL_W
QK_DIM = 64
V_DIM = 2 * QK_DIM
N_HEADS = ATTN_W // V_DIM
QK_W = N_HEADS * 2 * QK_DIM
Q_BLOCK = 128
ROPE_THETA = 10000.0
EPS = 1e-6

A_OFF = 0
B_OFF = A_OFF + FOURIER_W
Q_OFF = B_OFF + POOL_W
K_OFF = Q_OFF + QK_W
V_OFF = K_OFF + QK_W
G_OFF = V_OFF + ATTN_W
IN_W = G_OFF + MIX_W

kernel_name = "hybrid_fourier_pool_diffattn_dit"


def rms_norm(t, g):
    tf = t.astype(jnp.float32)
    y = tf * lax.rsqrt(jnp.mean(tf * tf, axis=-1, keepdims=True) + EPS)
    return (y * g.astype(jnp.float32)).astype(t.dtype)


def axial_rope_tables(rows):
    row = jnp.repeat(jnp.arange(rows), GRID_W).astype(jnp.float32)
    col = jnp.tile(jnp.arange(GRID_W), rows).astype(jnp.float32)
    half = QK_DIM // 2
    inv_freq = ROPE_THETA ** (-jnp.arange(0, half, 2, dtype=jnp.float32) / half)
    ang_r = row[:, None] * inv_freq[None, :]
    ang_c = col[:, None] * inv_freq[None, :]
    ang = jnp.concatenate([ang_r, ang_r, ang_c, ang_c], axis=-1)
    return jnp.cos(ang), jnp.sin(ang)


def apply_rope(t, cos, sin):
    tr = t.reshape(t.shape[:-1] + (2, 2, QK_DIM // 4))
    rot = jnp.stack([-tr[..., 1, :], tr[..., 0, :]], axis=-2).reshape(t.shape)
    return (t * cos + rot * sin).astype(t.dtype)


def centred_window_mean(u, w):
    L = u.shape[1]
    lo = w // 2
    hi = w - lo - 1
    cs = jnp.pad(jnp.cumsum(u.astype(jnp.float32), axis=1), ((0, 0), (1, 0), (0, 0)))
    t = jnp.arange(L)
    a = jnp.clip(t - lo, 0, L - 1)
    b = jnp.clip(t + hi, 0, L - 1)
    s = cs[:, b + 1] - cs[:, a]
    cnt = (b - a + 1).astype(jnp.float32)
    return (s / cnt[None, :, None]).astype(u.dtype)


def fourier_mix(a, w_fourier):
    B_, L = a.shape[:2]
    ag = a.reshape(B_, L, FOURIER_GROUPS, FOURIER_GD).astype(jnp.float32)
    f = jnp.fft.fftn(ag, axes=(1, 3), norm='ortho').real.astype(a.dtype)
    y = jnp.einsum('blgc,gcd->blgd', f, w_fourier)
    return y.reshape(B_, L, FOURIER_W)


def pool_mix(b, w_pool, pool_scale):
    B_, L = b.shape[:2]
    bg = b.reshape(B_, L, len(POOL_WINDOWS), POOL_GD)
    pooled = jnp.stack([centred_window_mean(bg[:, :, gi], w) for gi, w in enumerate(POOL_WINDOWS)], axis=2) - bg
    y = jnp.einsum('blgc,gcd->blgd', pooled, w_pool).reshape(B_, L, POOL_W)
    return y * pool_scale


def split_heads_qk(t):
    B_, L = t.shape[:2]
    return t.reshape(B_, L, N_HEADS, 2, QK_DIM).transpose(0, 2, 3, 1, 4)


def split_heads_v(t):
    B_, L = t.shape[:2]
    return t.reshape(B_, L, N_HEADS, V_DIM).transpose(0, 2, 1, 3)


def diff_attend(q, k, v, lam):
    s = jnp.einsum('bhmqd,bhmkd->bhmqk', q, k).astype(jnp.float32) * (QK_DIM ** -0.5)
    p = jax.nn.softmax(s, axis=-1)
    p = p[:, :, 0] - lam * p[:, :, 1]
    return jnp.einsum('bhqk,bhkd->bhqd', p.astype(v.dtype), v)


def attn_post(o, subln_g, lam_init):
    o = rms_norm(o, subln_g) * (1.0 - lam_init)
    B_, H, L, dv = o.shape
    return o.transpose(0, 2, 1, 3).reshape(B_, L, H * dv)


def mixer_out(a_in, b_in, attn, gate, w_fourier, w_pool, pool_scale, w_out):
    y = jnp.concatenate([fourier_mix(a_in, w_fourier), pool_mix(b_in, w_pool, pool_scale), attn], axis=-1)
    return (y * jax.nn.silu(gate)) @ w_out


def mixer_layer(layer_idx, x, ctx, c, c_ctx, norm_g, w_mod, b_mod, w_in, w_fourier, w_pool,
                pool_scale, qk_norm_g, lam_vecs, subln_g, w_out, rope_cos, rope_sin, update_ctx):
    shift, scale, gate = jnp.split(jax.nn.silu(c) @ w_mod + b_mod, 3, axis=-1)
    shift_c, scale_c, gate_c = jnp.split(jax.nn.silu(c_ctx) @ w_mod + b_mod, 3, axis=-1)
    h = rms_norm(x, norm_g) * (1 + scale[:, None]) + shift[:, None]
    hc = rms_norm(ctx, norm_g) * (1 + scale_c) + shift_c

    lam_init = 0.8 - 0.6 * math.exp(-0.3 * layer_idx)
    lv = lam_vecs.astype(jnp.float32)
    lam = jnp.exp(jnp.sum(lv[0] * lv[1])) - jnp.exp(jnp.sum(lv[2] * lv[3])) + lam_init

    p = h @ w_in
    a_in, b_in = p[..., A_OFF:B_OFF], p[..., B_OFF:Q_OFF]
    q, k, v, g = p[..., Q_OFF:K_OFF], p[..., K_OFF:V_OFF], p[..., V_OFF:G_OFF], p[..., G_OFF:]

    if update_ctx:
        pc = hc @ w_in
        kc, vc = pc[..., K_OFF:V_OFF], pc[..., V_OFF:G_OFF]
    else:
        pkv = hc @ w_in[:, K_OFF:G_OFF]
        kc, vc = pkv[..., :QK_W], pkv[..., QK_W:]

    q_lat = apply_rope(rms_norm(split_heads_qk(q), qk_norm_g[0]), rope_cos, rope_sin)
    k_lat = apply_rope(rms_norm(split_heads_qk(k), qk_norm_g[1]), rope_cos, rope_sin)
    k_ctx = rms_norm(split_heads_qk(kc), qk_norm_g[1])
    v_ctx = split_heads_v(vc)
    k_all = jnp.concatenate([k_ctx, k_lat], axis=3)
    v_all = jnp.concatenate([v_ctx, split_heads_v(v)], axis=2)

    B_, H, _, L, d = q_lat.shape
    nb = L // Q_BLOCK
    qb = jnp.moveaxis(q_lat.reshape(B_, H, 2, nb, Q_BLOCK, d), 3, 0)
    ob = lax.map(lambda qblk: diff_attend(qblk, k_all, v_all, lam), qb)
    o = jnp.moveaxis(ob, 0, 2).reshape(B_, H, L, V_DIM)
    attn = attn_post(o, subln_g, lam_init)

    x_new = x + gate[:, None] * mixer_out(a_in, b_in, attn, g, w_fourier, w_pool, pool_scale, w_out)

    if update_ctx:
        qc = rms_norm(split_heads_qk(pc[..., Q_OFF:K_OFF]), qk_norm_g[0])
        attn_c = attn_post(diff_attend(qc, k_ctx, v_ctx, lam), subln_g, lam_init)
        ctx = ctx + gate_c * mixer_out(pc[..., A_OFF:B_OFF], pc[..., B_OFF:Q_OFF], attn_c,
                                       pc[..., G_OFF:], w_fourier, w_pool, pool_scale, w_out)
    return x_new, ctx


def setup_inputs(seed: int = 0) -> dict:
    key = jax.random.key(seed)
    ks = jax.random.split(key, 16)
    f32 = jnp.float32
    nrm = lambda k, shape: jax.random.normal(k, shape, dtype=f32)
    return {
        'x': nrm(ks[0], (BATCH, SEQ, D_MODEL)),
        'c': nrm(ks[1], (BATCH, D_MODEL)),
        'ctx': nrm(ks[2], (BATCH, CTX_LEN, D_MODEL)),
        'c_ctx': nrm(ks[3], (D_MODEL,)),
        'norm_g': 1.0 + 0.02 * nrm(ks[4], (DEPTH, D_MODEL)),
        'w_mod': nrm(ks[5], (DEPTH, D_MODEL, 3 * D_MODEL)) * D_MODEL ** -0.5,
        'b_mod': 0.02 * nrm(ks[6], (DEPTH, 3 * D_MODEL)),
        'w_in': nrm(ks[7], (DEPTH, D_MODEL, IN_W)) * D_MODEL ** -0.5,
        'w_fourier': nrm(ks[8], (DEPTH, FOURIER_GROUPS, FOURIER_GD, FOURIER_GD)) * FOURIER_GD ** -0.5,
        'w_pool': nrm(ks[9], (DEPTH, len(POOL_WINDOWS), POOL_GD, POOL_GD)) * POOL_GD ** -0.5,
        'pool_scale': 1.0 + 0.1 * nrm(ks[10], (DEPTH, POOL_W)),
        'qk_norm_g': 1.0 + 0.02 * nrm(ks[11], (DEPTH, 2, QK_DIM)),
        'lam_vecs': 0.1 * nrm(ks[12], (DEPTH, 4, QK_DIM)),
        'subln_g': 1.0 + 0.02 * nrm(ks[13], (DEPTH, V_DIM)),
        'w_out': nrm(ks[14], (DEPTH, MIX_W, D_MODEL)) * MIX_W ** -0.5,
    }


def reference(x, c, ctx, c_ctx, norm_g, w_mod, b_mod, w_in, w_fourier, w_pool, pool_scale,
              qk_norm_g, lam_vecs, subln_g, w_out):
    rows = x.shape[1] // GRID_W
    rope_cos, rope_sin = axial_rope_tables(rows)
    for l in range(DEPTH):
        x, ctx = mixer_layer(l, x, ctx, c, c_ctx, norm_g[l], w_mod[l], b_mod[l], w_in[l],
                             w_fourier[l], w_pool[l], pool_scale[l], qk_norm_g[l], lam_vecs[l],
                             subln_g[l], w_out[l], rope_cos, rope_sin, l < DEPTH - 1)
    return x
```

```cpp
#include <hip/hip_runtime.h>
#include <math.h>
#include <string.h>
#include <stdio.h>
#include <stdint.h>

#ifndef MK_PER_PHASE
#define MK_PER_PHASE 0
#endif

constexpr int D = 1024, NB = 2, L = 8192, DEPTH = 2, CL = 256;
constexpr int A_OFF = 0, B_OFF = 256, Q_OFF = 512, K_OFF = 1024, V_OFF = 1536, G_OFF = 2048, IN_W = 3072;
constexpr int M = NB * L, MC = NB * CL, MT = M + MC;
constexpr float EPS = 1e-6f;
constexpr float LOG2E = 1.4426950408889634f;
constexpr int NPH = 1 + 5 * DEPTH;

constexpr size_t MiB = 1u << 20, KiB = 1024;
constexpr size_t WS_CTL = 0, CTL_ZERO_BYTES = 64 * KiB;
constexpr size_t WS_MOD = 18 * MiB;
constexpr int MODQ = DEPTH * 3 * 3072;
constexpr size_t WS_SC = 1 * MiB + 96 * KiB;
constexpr size_t WS_ROPE = 1 * MiB + 128 * KiB;
constexpr size_t WS_TW = 1 * MiB + 256 * KiB;
constexpr size_t WS_WF = 1 * MiB + 512 * KiB;
constexpr size_t WS_WP = 1 * MiB + 768 * KiB;
constexpr size_t WS_WIN = 2 * MiB;
constexpr size_t WS_WOUT = 14 * MiB;
constexpr size_t WS_H = 20 * MiB;
constexpr size_t WS_PB = 54 * MiB;
constexpr size_t WS_U = 154 * MiB;
constexpr size_t WS_Y = 172 * MiB;
constexpr size_t WS_CTX1 = 206 * MiB;
constexpr size_t WS_KT = 208 * MiB;
constexpr size_t WS_VT = 226 * MiB;
constexpr size_t WS_AT = 244 * MiB;
constexpr size_t AT_CTX = (size_t)NB * 128 * L;
constexpr size_t WS_END = 253 * MiB;
constexpr int NTILE = (CL + L) / 64;

typedef unsigned short bf16;
#define LAS __attribute__((address_space(3)))
#define GAS __attribute__((address_space(1)))
typedef float f32x4 __attribute__((ext_vector_type(4)));
typedef float f32x16 __attribute__((ext_vector_type(16)));
typedef unsigned u32x4 __attribute__((ext_vector_type(4)));
typedef unsigned u32x2 __attribute__((ext_vector_type(2)));
typedef short bf16x8 __attribute__((ext_vector_type(8)));
typedef short s16x4 __attribute__((ext_vector_type(4)));

__device__ __forceinline__ float silu_f(float t) { return t * __builtin_amdgcn_rcpf(1.f + __expf(-t)); }
template <int MASK> __device__ __forceinline__ float sxor(float v) {
    return __builtin_bit_cast(float, __builtin_amdgcn_ds_swizzle(__builtin_bit_cast(int, v), (MASK << 10) | 0x1f));
}
__device__ __forceinline__ float half_swap_sum(float v) { unsigned a = __builtin_bit_cast(unsigned, v), b = a; asm volatile("" : "+v"(b)); auto rr = __builtin_amdgcn_permlane32_swap(a, b, false, false); unsigned r0 = rr[0], r1 = rr[1]; asm volatile("" : "+v"(r0), "+v"(r1)); return __builtin_bit_cast(float, r0) + __builtin_bit_cast(float, r1); }
__device__ __forceinline__ float half_swap_max(float v) { unsigned a = __builtin_bit_cast(unsigned, v), b = a; asm volatile("" : "+v"(b)); auto rr = __builtin_amdgcn_permlane32_swap(a, b, false, false); unsigned r0 = rr[0], r1 = rr[1]; asm volatile("" : "+v"(r0), "+v"(r1)); return fmaxf(__builtin_bit_cast(float, r0), __builtin_bit_cast(float, r1)); }
__device__ __forceinline__ float wave_sum(float v) {
    v += sxor<16>(v); v += sxor<8>(v); v += sxor<4>(v); v += sxor<2>(v); v += sxor<1>(v);
    return half_swap_sum(v);
}
__device__ __forceinline__ float wave_max(float v) {
    v = fmaxf(v, sxor<16>(v)); v = fmaxf(v, sxor<8>(v)); v = fmaxf(v, sxor<4>(v)); v = fmaxf(v, sxor<2>(v)); v = fmaxf(v, sxor<1>(v));
    return half_swap_max(v);
}
typedef float f32x2_cv __attribute__((ext_vector_type(2))); typedef __bf16 bf16x2_cv __attribute__((ext_vector_type(2)));
__device__ __forceinline__ unsigned pk2(float lo, float hi) { f32x2_cv v = {lo, hi}; bf16x2_cv b = __builtin_convertvector(v, bf16x2_cv); return __builtin_bit_cast(unsigned, b); }
__device__ __forceinline__ unsigned f2bf(float f) { return pk2(f, 0.f) & 0xffffu; }
__device__ __forceinline__ float bflo(unsigned u) { return __builtin_bit_cast(float, u << 16); }
__device__ __forceinline__ float bfhi(unsigned u) { return __builtin_bit_cast(float, u & 0xffff0000u); }
__device__ __forceinline__ float bf2f(bf16 h) { return __builtin_bit_cast(float, (unsigned)h << 16); }

__device__ __forceinline__ f32x4 mod4(const float* p) { return (*(const f32x4*)p + *(const f32x4*)(p + MODQ)) + (*(const f32x4*)(p + 2 * MODQ) + *(const f32x4*)(p + 3 * MODQ)); }

__device__ __forceinline__ void st_wt16(void* p, u32x4 v) { asm volatile("global_store_dwordx4 %0, %1, off sc1\n\ts_nop 1" :: "v"(p), "v"(v) : "memory"); }
namespace pg8 {
#define PG8_LAS __attribute__((address_space(3)))
typedef unsigned short bf16_t;
constexpr int BM = 256, BK = 64, HALF = 128, HTB = HALF * BK * 2, STAGE_BYTES = 8 * HTB, NXCD = 8, WGM = 8;
__host__ __device__ __forceinline__ int lds_byte(int r, int c) { const int st = (r >> 4) * 2 + (c >> 5), rr = r & 15, cc = c & 31, ob = rr * 64 + cc * 2; return st * 1024 + (ob ^ (((ob >> 9) & 1) << 5)); }
__host__ __device__ __forceinline__ void stage_rc(int b, int& R, int& C) { const int st = b / 1024, sb = b % 1024, swz = sb ^ (((sb >> 9) & 1) << 5); R = (st >> 1) * 16 + swz / 64; C = (st & 1) * 32 + (swz % 64) / 2; }
__host__ __device__ __forceinline__ int perm32(int rho) { const int n = rho >> 4, i = rho & 15; return 8 * (i >> 2) + 4 * n + (i & 3); }
struct Unit { int pm, pn; };
struct Gemm { const bf16_t* A; const bf16_t* Bt; int M, N, K; };
struct StaticOrder {
    int nM, nN, nwg, G, c;
    __host__ __device__ void init(int M_, int N_, int G_, int c_) { nM = M_ / BM; nN = N_ / BM; nwg = nM * nN; G = G_; c = c_; }
    __host__ __device__ bool next(int i, Unit& u) const {
        const long Lx = (long)i * G + c; if (Lx >= nwg) return false;
        int wgid = (int)Lx; { const int q = nwg / NXCD, r = nwg % NXCD, xcd = wgid % NXCD, off = wgid / NXCD; wgid = (xcd < r ? xcd * (q + 1) : r * (q + 1) + (xcd - r) * q) + off; }
        const int nig = WGM * nN, gid = wgid / nig, fm = gid * WGM, gsz = (nM - fm) < WGM ? (nM - fm) : WGM;
        u.pm = fm + ((wgid % nig) % gsz); u.pn = (wgid % nig) / gsz; return true;
    }
    __device__ __forceinline__ void a_ready(const Unit&) const {}
    __device__ __forceinline__ void done(const Unit&) const {}
};
__device__ __forceinline__ unsigned cvt_pk_bf16(float lo, float hi) { unsigned r; asm volatile("v_cvt_pk_bf16_f32 %0, %1, %2" : "=v"(r) : "v"(lo), "v"(hi)); return r; }
struct EpiBf16 {
    static constexpr bool PERM = true, AFTER_DRAIN = false, GROUP64 = false;
    bf16_t* O; int ldc;
    __device__ __forceinline__ void operator()(const f32x4 (&acc)[2][2][4][2], const Unit& u, int wr, int wc, int fr, int fq) const {
        const int row0 = u.pm * BM + wr * 64 + fr, col0 = u.pn * BM + wc * 32 + 8 * fq;
#pragma unroll
        for (int ai = 0; ai < 2; ++ai)
#pragma unroll
            for (int m = 0; m < 4; ++m) { bf16_t* rowp = O + (size_t)(row0 + ai * HALF + m * 16) * ldc + col0;
#pragma unroll
                for (int bj = 0; bj < 2; ++bj) { const f32x4 v0 = acc[ai][bj][m][0], v1 = acc[ai][bj][m][1];
                    u32x4 w; w.x = cvt_pk_bf16(v0[0], v0[1]); w.y = cvt_pk_bf16(v0[2], v0[3]); w.z = cvt_pk_bf16(v1[0], v1[1]); w.w = cvt_pk_bf16(v1[2], v1[3]);
                    *(u32x4*)(rowp + bj * HALF) = w; } }
    }
};

struct EpiIn {
    static constexpr bool PERM = true, AFTER_DRAIN = false, GROUP64 = true;
    bf16_t* O; const float* qkg; const float* rope; unsigned char* KT; unsigned char* VT; unsigned* AT;
    static __device__ __forceinline__ size_t kv_block(int row, int h, int& key) { const int b = row >> 13, kidx = CL + (row & (L - 1)); key = kidx & 63; return ((size_t)((b * 4 + h) * NTILE + (kidx >> 6))) * 16384; }
    __device__ __forceinline__ void operator()(const f32x4 (&acc)[2][2][4][2], const Unit& u, int wr, int wc, int fr_, int fq_) const {
        int ln_; asm volatile("v_mbcnt_lo_u32_b32 %0, -1, 0\n\tv_mbcnt_hi_u32_b32 %0, -1, %0" : "=v"(ln_)); const int fr = ln_ & 15, fq = ln_ >> 4; (void)fr_; (void)fq_;
        const int row0 = u.pm * BM + wr * 64 + fr, col0 = u.pn * BM + wc * 64 + 8 * fq;
        if (u.pn == 6 || u.pn == 7) {
            const int g64 = (u.pn - 6) * 4 + wc, h = g64 >> 1;
#pragma unroll
            for (int ai = 0; ai < 2; ++ai)
#pragma unroll
                for (int m = 0; m < 4; ++m) { int key; const size_t blk = kv_block(row0 + ai * HALF + m * 16, h, key);
#pragma unroll
                    for (int bj = 0; bj < 2; ++bj) { const f32x4 v0 = acc[ai][bj][m][0], v1 = acc[ai][bj][m][1];
                        u32x4 w; w.x = cvt_pk_bf16(v0[0], v0[1]); w.y = cvt_pk_bf16(v0[2], v0[3]); w.z = cvt_pk_bf16(v1[0], v1[1]); w.w = cvt_pk_bf16(v1[2], v1[3]);
                        *(u32x4*)(VT + blk + ((g64 & 1) * 2 + bj) * 4096 + key * 64 + fq * 16) = w; } }
            return;
        }
        if (u.pn == 0) {
#pragma unroll
            for (int ai = 0; ai < 2; ++ai)
#pragma unroll
                for (int m = 0; m < 4; ++m) { const int row = row0 + ai * HALF + m * 16; unsigned* ap = AT + ((size_t)((row >> 13) * 128 + 32 * wc + 4 * fq)) * L + (row & (L - 1));
#pragma unroll
                    for (int bj = 0; bj < 2; ++bj) { const f32x4 v0 = acc[ai][bj][m][0], v1 = acc[ai][bj][m][1]; unsigned* a2 = ap + (size_t)(16 * bj) * L;
                        a2[0] = cvt_pk_bf16(v0[0], v0[1]); a2[L] = cvt_pk_bf16(v0[2], v0[3]); a2[2 * L] = cvt_pk_bf16(v1[0], v1[1]); a2[3 * L] = cvt_pk_bf16(v1[2], v1[3]); } }
            return;
        }
        if (u.pn < 2 || u.pn >= 6) {
#pragma unroll
            for (int ai = 0; ai < 2; ++ai)
#pragma unroll
                for (int m = 0; m < 4; ++m) { bf16_t* rowp = O + (size_t)(row0 + ai * HALF + m * 16) * IN_W + col0;
#pragma unroll
                    for (int bj = 0; bj < 2; ++bj) { const f32x4 v0 = acc[ai][bj][m][0], v1 = acc[ai][bj][m][1];
                        u32x4 w; w.x = cvt_pk_bf16(v0[0], v0[1]); w.y = cvt_pk_bf16(v0[2], v0[3]); w.z = cvt_pk_bf16(v1[0], v1[1]); w.w = cvt_pk_bf16(v1[2], v1[3]);
                        *(u32x4*)(rowp + bj * 32) = w; } }
            return;
        }
        const int part = u.pn >= 4 ? 1 : 0;
        const bool isc = u.pm >= 64;
        const float qs = part ? 1.f : 0.125f * LOG2E;
        const int hi = fq >> 1, jb = 8 * (fq & 1);
        f32x4 gv[2][2];
#pragma unroll
        for (int bj = 0; bj < 2; ++bj)
#pragma unroll
            for (int n = 0; n < 2; ++n) gv[bj][n] = *(const f32x4*)(qkg + part * 64 + 32 * bj + 8 * fq + 4 * n);
#pragma unroll
        for (int ai = 0; ai < 2; ++ai)
#pragma unroll
            for (int m = 0; m < 4; ++m) {
                const int row = row0 + ai * HALF + m * 16;
                float ss = 0.f;
#pragma unroll
                for (int bj = 0; bj < 2; ++bj)
#pragma unroll
                    for (int n = 0; n < 2; ++n) { const f32x4 x = acc[ai][bj][m][n]; ss += (x[0] * x[0] + x[1] * x[1]) + (x[2] * x[2] + x[3] * x[3]); }
                ss += sxor<16>(ss); ss = half_swap_sum(ss);
                const float rs = __builtin_amdgcn_rsqf(ss * (1.f / 64.f) + EPS);
                f32x4 y[2][2];
#pragma unroll
                for (int bj = 0; bj < 2; ++bj)
#pragma unroll
                    for (int n = 0; n < 2; ++n) y[bj][n] = acc[ai][bj][m][n] * rs * gv[bj][n];
                if (!isc) {
                    const int t = row & (L - 1);
                    f32x4 tab[2][2][2];
#pragma unroll
                    for (int bj = 0; bj < 2; ++bj) { const float* rp = rope + ((bj ? (t & 63) : (t >> 6)) * 16 + jb) * 2;
#pragma unroll
                        for (int n = 0; n < 2; ++n) { tab[bj][n][0] = *(const f32x4*)(rp + 8 * n); tab[bj][n][1] = *(const f32x4*)(rp + 8 * n + 4); } }
#pragma unroll
                    for (int bj = 0; bj < 2; ++bj) {
#pragma unroll
                        for (int n = 0; n < 2; ++n) {
                            const f32x4 ca = tab[bj][n][0], cb = tab[bj][n][1];
                            const float cs[4] = {ca[0], ca[2], cb[0], cb[2]}, sn[4] = {ca[1], ca[3], cb[1], cb[3]};
#pragma unroll
                            for (int e = 0; e < 4; ++e) {
                                const float yv = y[bj][n][e];
                                unsigned a_ = __builtin_bit_cast(unsigned, yv), b_ = a_; asm volatile("" : "+v"(b_));
                                auto rr = __builtin_amdgcn_permlane32_swap(a_, b_, false, false); unsigned r0 = rr[0], r1 = rr[1]; asm volatile("" : "+v"(r0), "+v"(r1));
                                const float other = __builtin_bit_cast(float, hi ? r0 : r1);
                                y[bj][n][e] = hi ? (yv * cs[e] + other * sn[e]) : (yv * cs[e] - other * sn[e]);
                            }
                        }
                    }
                }
                bf16_t* rowp = O + (size_t)row * IN_W + col0;
                int key = 0; size_t blk = 0; const int g64 = (u.pn & 1) * 4 + wc;
                if (part) blk = kv_block(row, g64 >> 1, key);
#pragma unroll
                for (int bj = 0; bj < 2; ++bj) { const f32x4 v0 = y[bj][0] * qs, v1 = y[bj][1] * qs;
                    u32x4 w; w.x = cvt_pk_bf16(v0[0], v0[1]); w.y = cvt_pk_bf16(v0[2], v0[3]); w.z = cvt_pk_bf16(v1[0], v1[1]); w.w = cvt_pk_bf16(v1[2], v1[3]);
                    if (part) *(u32x4*)(KT + blk + (g64 & 1) * 8192 + (4 * bj + fq) * 1024 + key * 16) = w;
                    else *(u32x4*)(rowp + bj * 32) = w; }
            }
    }
};
struct OneUnit {
    int pm, pn;
    __host__ __device__ bool next(int i, Unit& u) const { if (i != 0) return false; u.pm = pm; u.pn = pn; return true; }
    __device__ __forceinline__ void a_ready(const Unit&) const {}
    __device__ __forceinline__ void done(const Unit&) const {}
};
struct EpiRes {
    static constexpr bool PERM = false, AFTER_DRAIN = false, GROUP64 = false;
    const float* res0; float* out0; const float* res1; float* out1; const float* mod; int mlat, rows_per_vec;
    __device__ __forceinline__ void operator()(const f32x4 (&acc)[2][2][4][2], const Unit& u, int wr, int wc, int fr, int fq) const {
        int row0 = u.pm * BM + wr * 64 + fr; const int col0 = u.pn * BM + wc * 32 + 4 * fq;
        const bool isc = (u.pm * BM) >= mlat;
        const float* res = isc ? res1 : res0; float* out = isc ? out1 : out0;
        const int vec = isc ? 2 : (u.pm * BM) / rows_per_vec;
        if (isc) row0 -= mlat;
        const float* gp = mod + vec * 3072 + 2048 + col0;
        f32x4 gv[2][2];
#pragma unroll
        for (int bj = 0; bj < 2; ++bj)
#pragma unroll
            for (int n = 0; n < 2; ++n) gv[bj][n] = mod4(gp + bj * HALF + n * 16);
#pragma unroll
        for (int ai = 0; ai < 2; ++ai) {
            f32x4 rr[4][2][2];
#pragma unroll
            for (int m = 0; m < 4; ++m) { const size_t off = (size_t)(row0 + ai * HALF + m * 16) * 1024 + col0;
#pragma unroll
                for (int bj = 0; bj < 2; ++bj)
#pragma unroll
                    for (int n = 0; n < 2; ++n) rr[m][bj][n] = *(const f32x4*)(res + off + bj * HALF + n * 16); }
            asm volatile("" ::: "memory");
#pragma unroll
            for (int m = 0; m < 4; ++m) { const size_t off = (size_t)(row0 + ai * HALF + m * 16) * 1024 + col0;
#pragma unroll
                for (int bj = 0; bj < 2; ++bj)
#pragma unroll
                    for (int n = 0; n < 2; ++n) *(f32x4*)(out + off + bj * HALF + n * 16) = rr[m][bj][n] + gv[bj][n] * acc[ai][bj][m][n]; }
            asm volatile("" ::: "memory");
        }
    }
};

struct EpiResL {
    static constexpr bool PERM = false, AFTER_DRAIN = false, GROUP64 = false;
    const float* res; float* out; const float* mod; int rows_per_vec; PG8_LAS unsigned char* lds; int wt;
    __device__ __forceinline__ void operator()(const f32x4 (&acc)[2][2][4][2], const Unit& u, int wr, int wc, int fr_, int fq_) const {
        int ln_; asm volatile("v_mbcnt_lo_u32_b32 %0, -1, 0\n\tv_mbcnt_hi_u32_b32 %0, -1, %0" : "=v"(ln_)); const int fr = ln_ & 15, fq = ln_ >> 4; (void)fr_; (void)fq_;
        const int tid = (wr * 4 + wc) * 64 + ln_;
        asm volatile("s_waitcnt vmcnt(0)" ::: "memory");
        __syncthreads();
        const int vec = (u.pm * BM) / rows_per_vec;
        const float* gp = mod + vec * 3072 + 2048 + u.pn * BM + wc * 32 + 4 * fq;
        f32x4 gv[2][2];
#pragma unroll
        for (int bj = 0; bj < 2; ++bj)
#pragma unroll
            for (int n = 0; n < 2; ++n) gv[bj][n] = mod4(gp + bj * HALF + n * 16);
        PG8_LAS float* X = (PG8_LAS float*)lds;
#pragma unroll
        for (int ai = 0; ai < 2; ++ai)
#pragma unroll
            for (int mh = 0; mh < 2; ++mh) {
#pragma unroll
                for (int j = 0; j < 2; ++j) { PG8_LAS float* xr = X + (wr * 32 + j * 16 + fr) * 260 + wc * 32 + 4 * fq;
#pragma unroll
                    for (int bj = 0; bj < 2; ++bj)
#pragma unroll
                        for (int n = 0; n < 2; ++n) *(PG8_LAS f32x4*)(xr + bj * HALF + n * 16) = gv[bj][n] * acc[ai][bj][2 * mh + j][n]; }
                __syncthreads();
                f32x4 rr[8];
#pragma unroll
                for (int i = 0; i < 8; ++i) { const int id = tid + 512 * i, rl = id >> 6, c4 = id & 63;
                    const size_t off = (size_t)(u.pm * BM + ai * HALF + (rl >> 5) * 64 + (2 * mh + ((rl >> 4) & 1)) * 16 + (rl & 15)) * 1024 + u.pn * BM + 4 * c4;
                    rr[i] = *(const f32x4*)(res + off); }
                asm volatile("" ::: "memory");
#pragma unroll
                for (int i = 0; i < 8; ++i) { const int id = tid + 512 * i, rl = id >> 6, c4 = id & 63;
                    const size_t off = (size_t)(u.pm * BM + ai * HALF + (rl >> 5) * 64 + (2 * mh + ((rl >> 4) & 1)) * 16 + (rl & 15)) * 1024 + u.pn * BM + 4 * c4;
                    const f32x4 o4 = rr[i] + *(const PG8_LAS f32x4*)(X + rl * 260 + 4 * c4);
                    if (wt) st_wt16(out + off, __builtin_bit_cast(u32x4, o4)); else *(f32x4*)(out + off) = o4; }
                asm volatile("" ::: "memory");
                __syncthreads();
            }
    }
};

template <class Epi, class Sched, bool ALIGN_EPI = false, bool SP2 = false>
__device__ __forceinline__ void gemm_phase(PG8_LAS unsigned char* lds, const Gemm g, const Sched& S, const Epi& E, const int tid) {
    const int wid = __builtin_amdgcn_readfirstlane(tid >> 6), lane = tid & 63, wr = wid >> 2, wc = wid & 3, fr = lane & 15, fq = lane >> 4;
    const int K = g.K, nt = K / BK;
    unsigned voffA[2], voffB[2];
#pragma unroll
    for (int i = 0; i < 2; ++i) { int R, C; stage_rc(tid * 16 + i * 8192, R, C);
        const int Rb = Epi::GROUP64 ? ((R >> 5) * 64 + perm32(R & 31)) : (Epi::PERM ? ((R & ~31) + perm32(R & 31)) : R);
        voffA[i] = (unsigned)(R * K + C) * 2u; voffB[i] = (unsigned)(Rb * K + C) * 2u; }
    const size_t kstep = (size_t)(BK * 2);
    const size_t hstep = (size_t)HALF * K * 2;
    const size_t hstepB = Epi::GROUP64 ? (size_t)32 * K * 2 : hstep;
    const size_t tstep = 2 * hstep;
    const unsigned ldsw = (unsigned)wid * 1024u;
    const int aoff = lds_byte(wr * 64 + fr, fq * 8), boff = lds_byte(wc * 32 + fr, fq * 8);
#define PG8_SA(b, h) (((b) * 2 + (h)) * HTB)
#define PG8_SB(b, h) ((4 + (b) * 2 + (h)) * HTB)
#define PG8_STAGE(bufoff, gbase, voff) do { _Pragma("unroll") for (int _i = 0; _i < 2; ++_i) \
        __builtin_amdgcn_global_load_lds((const unsigned*)((const char*)(gbase) + (voff)[_i]), (PG8_LAS unsigned*)(lds + (bufoff) + ldsw + _i * 8192), 16, 0, 0); } while (0)
#define PG8_LDA(dst, b, h) do { _Pragma("unroll") for (int m = 0; m < 4; ++m) _Pragma("unroll") for (int k = 0; k < 2; ++k) dst[m][k] = *(const PG8_LAS bf16x8*)(lds + PG8_SA(b, h) + aoff + m * 2048 + k * 1024); } while (0)
#define PG8_LDB(dst, b, h) do { _Pragma("unroll") for (int n = 0; n < 2; ++n) _Pragma("unroll") for (int k = 0; k < 2; ++k) dst[n][k] = *(const PG8_LAS bf16x8*)(lds + PG8_SB(b, h) + boff + n * 2048 + k * 1024); } while (0)
#define PG8_MMA(ai, bj, At, Bt) do { __builtin_amdgcn_s_setprio(1); _Pragma("unroll") for (int m = 0; m < 4; ++m) _Pragma("unroll") for (int n = 0; n < 2; ++n) _Pragma("unroll") for (int k = 0; k < 2; ++k) \
        acc[ai][bj][m][n] = __builtin_amdgcn_mfma_f32_16x16x32_bf16(Bt[n][k], At[m][k], acc[ai][bj][m][n], 0, 0, 0); __builtin_amdgcn_s_setprio(0); } while (0)
#define PG8_WAIT_V(n) asm volatile("s_waitcnt vmcnt(" #n ")" ::: "memory")
#define PG8_WAIT_L(n) asm volatile("s_waitcnt lgkmcnt(" #n ")" ::: "memory")
#define PG8_BAR __builtin_amdgcn_s_barrier()
#define PG8_SCHED __builtin_amdgcn_sched_barrier(0)
    Unit cur, nxt; int ui = 0;
    if (!S.next(0, cur)) return;
    f32x4 acc[2][2][4][2];
#pragma unroll
    for (int a = 0; a < 2; ++a)
#pragma unroll
        for (int b = 0; b < 2; ++b)
#pragma unroll
            for (int m = 0; m < 4; ++m)
#pragma unroll
                for (int n = 0; n < 2; ++n) acc[a][b][m][n] = (f32x4){0.f, 0.f, 0.f, 0.f};
    bf16x8 At[4][2], B0[2][2], B1[2][2];
    const char* cA = (const char*)g.A + (size_t)cur.pm * tstep; const char* cB = (const char*)g.Bt + (size_t)cur.pn * tstep;
    S.a_ready(cur);
    if constexpr (SP2) {
        PG8_STAGE(PG8_SB(0, 0), cB, voffB); PG8_STAGE(PG8_SB(0, 1), cB + hstepB, voffB); PG8_STAGE(PG8_SA(0, 0), cA, voffA); PG8_STAGE(PG8_SA(0, 1), cA + hstep, voffA);
        if (wr == 1) PG8_BAR;
        PG8_WAIT_V(2); PG8_BAR;
        PG8_STAGE(PG8_SB(1, 0), cB + kstep, voffB); PG8_STAGE(PG8_SA(1, 0), cA + kstep, voffA); PG8_STAGE(PG8_SB(1, 1), cB + hstepB + kstep, voffB);
        PG8_WAIT_V(6); PG8_BAR;
    } else {
        PG8_STAGE(PG8_SB(0, 0), cB, voffB); PG8_STAGE(PG8_SA(0, 0), cA, voffA); PG8_STAGE(PG8_SB(0, 1), cB + hstepB, voffB); PG8_STAGE(PG8_SA(0, 1), cA + hstep, voffA);
        if (wr == 1) PG8_BAR;
        PG8_WAIT_V(4); PG8_BAR;
        PG8_STAGE(PG8_SB(1, 0), cB + kstep, voffB); PG8_STAGE(PG8_SA(1, 0), cA + kstep, voffA); PG8_STAGE(PG8_SB(1, 1), cB + hstepB + kstep, voffB);
        PG8_WAIT_V(6); PG8_BAR;
    }
    for (;;) {
        const bool has_next = S.next(ui + 1, nxt);
        const char* nA = has_next ? (const char*)g.A + (size_t)nxt.pm * tstep : cA; const char* nB = has_next ? (const char*)g.Bt + (size_t)nxt.pn * tstep : cB;
        for (int t = 0; t < nt; t += 2) {
            const bool last = (t == nt - 2);
            const char* a1 = cA + (size_t)(t + 1) * kstep;
            const char* a2 = last ? nA : cA + (size_t)(t + 2) * kstep; const char* b2 = last ? nB : cB + (size_t)(t + 2) * kstep;
            const char* a3 = a2 + kstep; const char* b3 = b2 + kstep;
            if (last && has_next) S.a_ready(nxt);
            if constexpr (SP2) {
            PG8_LDB(B0, 0, 0); PG8_LDB(B1, 0, 1); PG8_SCHED; PG8_LDA(At, 0, 0); PG8_STAGE(PG8_SA(1, 1), a1 + hstep, voffA);
            PG8_WAIT_V(8); PG8_WAIT_L(0); PG8_BAR; PG8_MMA(0, 0, At, B0); PG8_MMA(0, 1, At, B1); PG8_BAR; PG8_SCHED;
            PG8_LDA(At, 0, 1); PG8_STAGE(PG8_SB(0, 0), b2, voffB); PG8_STAGE(PG8_SB(0, 1), b2 + hstepB, voffB); PG8_STAGE(PG8_SA(0, 0), a2, voffA);
            PG8_WAIT_V(8); PG8_WAIT_L(0); PG8_BAR; PG8_MMA(1, 0, At, B0); PG8_MMA(1, 1, At, B1); PG8_BAR; PG8_SCHED;
            PG8_LDB(B0, 1, 0); PG8_LDB(B1, 1, 1); PG8_SCHED; PG8_LDA(At, 1, 0); PG8_STAGE(PG8_SA(0, 1), a2 + hstep, voffA);
            PG8_WAIT_V(8); PG8_WAIT_L(0); PG8_BAR; PG8_MMA(0, 0, At, B0); PG8_MMA(0, 1, At, B1); PG8_BAR; PG8_SCHED;
            PG8_LDA(At, 1, 1); PG8_STAGE(PG8_SB(1, 0), b3, voffB); PG8_STAGE(PG8_SB(1, 1), b3 + hstepB, voffB); PG8_STAGE(PG8_SA(1, 0), a3, voffA);
            PG8_WAIT_V(8); PG8_WAIT_L(0); PG8_BAR; PG8_MMA(1, 0, At, B0); PG8_MMA(1, 1, At, B1); PG8_BAR; PG8_SCHED;
            } else {
            PG8_LDB(B0, 0, 0); PG8_SCHED; PG8_LDA(At, 0, 0); PG8_STAGE(PG8_SA(1, 1), a1 + hstep, voffA);
            PG8_WAIT_L(8); PG8_BAR; PG8_WAIT_L(0); PG8_MMA(0, 0, At, B0); PG8_BAR; PG8_SCHED;
            PG8_LDB(B1, 0, 1); PG8_STAGE(PG8_SB(0, 0), b2, voffB);
            PG8_BAR; PG8_WAIT_L(0); PG8_MMA(0, 1, At, B1); PG8_BAR;
            PG8_LDA(At, 0, 1); PG8_STAGE(PG8_SA(0, 0), a2, voffA);
            PG8_BAR; PG8_WAIT_L(0); PG8_MMA(1, 0, At, B0); PG8_BAR; PG8_SCHED;
            PG8_STAGE(PG8_SB(0, 1), b2 + hstepB, voffB);
            PG8_WAIT_V(6); PG8_BAR; PG8_MMA(1, 1, At, B1); PG8_BAR;
            PG8_LDB(B0, 1, 0); PG8_SCHED; PG8_LDA(At, 1, 0); PG8_STAGE(PG8_SA(0, 1), a2 + hstep, voffA);
            PG8_WAIT_L(8); PG8_BAR; PG8_WAIT_L(0); PG8_MMA(0, 0, At, B0); PG8_BAR; PG8_SCHED;
            PG8_LDB(B1, 1, 1); PG8_STAGE(PG8_SB(1, 0), b3, voffB);
            PG8_BAR; PG8_WAIT_L(0); PG8_MMA(0, 1, At, B1); PG8_BAR;
            PG8_LDA(At, 1, 1); PG8_STAGE(PG8_SA(1, 0), a3, voffA);
            PG8_BAR; PG8_WAIT_L(0); PG8_MMA(1, 0, At, B0); PG8_BAR; PG8_SCHED;
            PG8_STAGE(PG8_SB(1, 1), b3 + hstepB, voffB);
            PG8_WAIT_V(6); PG8_BAR; PG8_MMA(1, 1, At, B1); PG8_BAR;
            }
        }
        if constexpr (ALIGN_EPI) { if (wr == 0) PG8_BAR; }
        if constexpr (!Epi::AFTER_DRAIN) { E(acc, cur, wr, wc, fr, fq); S.done(cur); }
        if (!has_next) break;
#pragma unroll
        for (int a = 0; a < 2; ++a)
#pragma unroll
            for (int b = 0; b < 2; ++b)
#pragma unroll
                for (int m = 0; m < 4; ++m)
#pragma unroll
                    for (int n = 0; n < 2; ++n) acc[a][b][m][n] = (f32x4){0.f, 0.f, 0.f, 0.f};
        cur = nxt; cA = nA; cB = nB; ++ui;
        if constexpr (ALIGN_EPI) { if (wr == 1) PG8_BAR; }
    }
    PG8_WAIT_V(0);
    if constexpr (!ALIGN_EPI) { if (wr == 0) PG8_BAR; }
    PG8_BAR;
#undef PG8_SA
#undef PG8_SB
#undef PG8_STAGE
#undef PG8_LDA
#undef PG8_LDB
#undef PG8_MMA
#undef PG8_WAIT_V
#undef PG8_WAIT_L
#undef PG8_BAR
#undef PG8_SCHED
}
}

namespace att {
constexpr int NW = 8, QBLK = 32, KVBLK = 64;
constexpr size_t SHM_V = KVBLK * 128 * 2, SHM_K = KVBLK * 128 * 2, SHM_ATTN = 2 * SHM_V + 2 * SHM_K + NW * 64 * 4;
#define KSWZ(row, colB) ((row) * 256 + ((colB) ^ (((row) & 7) << 4)))
#define SBAR() __builtin_amdgcn_sched_barrier(0)
__device__ __forceinline__ int crow(int r, int hi) { return (r & 3) + 8 * (r >> 2) + 4 * hi; }
__device__ __forceinline__ unsigned cvtpk(float lo, float hi) { unsigned r; asm volatile("v_cvt_pk_bf16_f32 %0, %1, %2" : "=v"(r) : "v"(lo), "v"(hi)); return r; }
__device__ __forceinline__ void expA(f32x16& p0) {
#pragma unroll
    for (int r = 0; r < 16; ++r) p0[r] = __builtin_amdgcn_exp2f(p0[r]);
}
__device__ __forceinline__ void finishSM(f32x16& p0, f32x16& p1, float& l_reg, bf16x8& pa0, bf16x8& pa1, bf16x8& pa2, bf16x8& pa3) {
#pragma unroll
    for (int r = 0; r < 16; ++r) p1[r] = __builtin_amdgcn_exp2f(p1[r]);
    float ps = 0;
#pragma unroll
    for (int r = 0; r < 16; ++r) ps += p0[r];
#pragma unroll
    for (int r = 0; r < 16; ++r) ps += p1[r];
    l_reg += ps;
#define PK4(P, BASE, OUT) do { unsigned a0 = cvtpk(P[BASE + 0], P[BASE + 1]), a1 = cvtpk(P[BASE + 2], P[BASE + 3]);   \
    unsigned b0 = cvtpk(P[BASE + 4], P[BASE + 5]), b1 = cvtpk(P[BASE + 6], P[BASE + 7]);                              \
    auto r0 = __builtin_amdgcn_permlane32_swap(a0, b0, false, false); auto r1 = __builtin_amdgcn_permlane32_swap(a1, b1, false, false); \
    u32x4 w = {r0[0], r1[0], r0[1], r1[1]}; OUT = *reinterpret_cast<bf16x8*>(&w); } while (0)
    PK4(p0, 0, pa0); PK4(p0, 8, pa1); PK4(p1, 0, pa2); PK4(p1, 8, pa3);
#undef PK4
}
__device__ __forceinline__ void qkt(f32x16& p0, f32x16& p1, const char* Ks, const bf16x8* qr, int kbase, float negM) {
#pragma unroll
    for (int r = 0; r < 16; ++r) { p0[r] = negM; p1[r] = negM; }
#pragma unroll
    for (int d0 = 0; d0 < 4; ++d0) { int kb = kbase; asm volatile("" : "+v"(kb)); const int ad = kb ^ (d0 * 32);
        bf16x8 b0 = *reinterpret_cast<const bf16x8*>(Ks + ad);
        bf16x8 b1 = *reinterpret_cast<const bf16x8*>(Ks + ad + 8192);
        p0 = __builtin_amdgcn_mfma_f32_32x32x16_bf16(b0, qr[d0], p0, 0, 0, 0);
        p1 = __builtin_amdgcn_mfma_f32_32x32x16_bf16(b1, qr[d0], p1, 0, 0, 0); }
}
__device__ __forceinline__ int v_st(int k, int c) { const int kk = (k & ~0xC) | ((k & 4) << 1) | ((k & 8) >> 1); return ((kk >> 3) * 4 + (c >> 5)) * 512 + ((kk & 7) * 32 + (c & 31)) * 2; }
__device__ __forceinline__ int v_rd_base(int lane) { return ((lane & 3) << 3) | (((lane >> 2) & 3) << 6) | (((lane >> 4) & 1) << 5) | (((lane >> 5) & 1) << 8); }
constexpr int v_rd_off(int d0, int ks, int half) { return d0 * 512 + ks * 4096 + half * 2048; }
template <int OFF> __device__ __forceinline__ s16x4 tr_read(int vb) { s16x4 r; asm volatile("ds_read_b64_tr_b16 %0, %1 offset:%2" : "=&v"(r) : "v"(vb), "i"(OFF) : "memory"); return r; }
template <int D0> __device__ __forceinline__ void pv_one(f32x16& od, int vb, bf16x8 pa0, bf16x8 pa1, bf16x8 pa2, bf16x8 pa3) {
    const s16x4 l0 = tr_read<v_rd_off(D0, 0, 0)>(vb), h0 = tr_read<v_rd_off(D0, 0, 1)>(vb), l1 = tr_read<v_rd_off(D0, 1, 0)>(vb), h1 = tr_read<v_rd_off(D0, 1, 1)>(vb);
    const s16x4 l2 = tr_read<v_rd_off(D0, 2, 0)>(vb), h2 = tr_read<v_rd_off(D0, 2, 1)>(vb), l3 = tr_read<v_rd_off(D0, 3, 0)>(vb), h3 = tr_read<v_rd_off(D0, 3, 1)>(vb);
    asm volatile("s_waitcnt lgkmcnt(0)" ::: "memory"); SBAR();
#define PK(Lo, Hi) (bf16x8){Lo[0], Lo[1], Lo[2], Lo[3], Hi[0], Hi[1], Hi[2], Hi[3]}
    od = __builtin_amdgcn_mfma_f32_32x32x16_bf16(pa0, PK(l0, h0), od, 0, 0, 0);
    od = __builtin_amdgcn_mfma_f32_32x32x16_bf16(pa1, PK(l1, h1), od, 0, 0, 0);
    od = __builtin_amdgcn_mfma_f32_32x32x16_bf16(pa2, PK(l2, h2), od, 0, 0, 0);
    od = __builtin_amdgcn_mfma_f32_32x32x16_bf16(pa3, PK(l3, h3), od, 0, 0, 0);
#undef PK
}
__device__ __forceinline__ void pv_d0(f32x16* o, int vb, bf16x8 pa0, bf16x8 pa1, bf16x8 pa2, bf16x8 pa3) {
    pv_one<0>(o[0], vb, pa0, pa1, pa2, pa3); pv_one<1>(o[1], vb, pa0, pa1, pa2, pa3); pv_one<2>(o[2], vb, pa0, pa1, pa2, pa3); pv_one<3>(o[3], vb, pa0, pa1, pa2, pa3);
}
__device__ __forceinline__ void attn_item(const bf16* PB, bf16* Y, const float* subg, const float* SC, const bool cx, int b, int h, int q0, char* lds, const int tid) {
    const int wid = tid >> 6, lane = tid & 63, r32 = lane & 31, hi = lane >> 5, wq = wid & 3, map = wid >> 2;
    char* V_lds = lds; char* K_lds = lds + 2 * SHM_V;
    const float negM = __builtin_bit_cast(float, __builtin_amdgcn_readfirstlane(__builtin_bit_cast(int, -SC[1] * LOG2E)));
    float l_reg = 0; f32x16 o[4] = {}; bf16x8 qr[4];
    const int rowq0 = (cx ? M + b * CL : b * L) + q0;
    const bf16* Qw = PB + (size_t)(rowq0 + wq * QBLK + r32) * IN_W + Q_OFF + h * 128 + map * 64 + hi * 8;
#pragma unroll
    for (int d0 = 0; d0 < 4; ++d0) qr[d0] = *reinterpret_cast<const bf16x8*>(Qw + d0 * 16);
    const int sr = tid >> 4, sc = (tid & 15) * 8, vst0 = v_st(sr, sc), vst1 = v_st(32 + sr, sc);
    const int vb0 = (int)(uintptr_t)V_lds + v_rd_base(lane);
    const int kbase = r32 * 256 + ((map * 128 + hi * 16) ^ ((r32 & 7) << 4));
    const int NT = cx ? CL / KVBLK : (CL + L) / KVBLK;
    struct { bf16x8 vs0, vs1, ks0, ks1; } sr_[2];
    const __amdgpu_buffer_rsrc_t rs = __builtin_amdgcn_make_buffer_rsrc((void*)PB, (short)0, (int)((size_t)MT * IN_W * 2), 0x00020000);
    const unsigned voff = (unsigned)(sr * IN_W + sc) * 2u;
    const unsigned so_ctx = (unsigned)((M + b * CL) * IN_W + h * 128) * 2u, so_lat = (unsigned)((b * L - CL) * IN_W + h * 128) * 2u;
#define LD16(so) __builtin_bit_cast(bf16x8, __builtin_amdgcn_raw_buffer_load_b128(rs, voff, (so), 0))
#define SLOAD(i, t) do { const int t_ = (t); const unsigned so_ = (t_ < CL / KVBLK ? so_ctx : so_lat) + (unsigned)(t_ * KVBLK) * (unsigned)(IN_W * 2); \
        sr_[i].vs0 = LD16(so_ + V_OFF * 2); sr_[i].vs1 = LD16(so_ + V_OFF * 2 + 32 * IN_W * 2); sr_[i].ks0 = LD16(so_ + K_OFF * 2); sr_[i].ks1 = LD16(so_ + K_OFF * 2 + 32 * IN_W * 2); } while (0)
#define SWRITE(bb, i) do { *(bf16x8*)(V_lds + (bb) * SHM_V + vst0) = sr_[i].vs0; *(bf16x8*)(V_lds + (bb) * SHM_V + vst1) = sr_[i].vs1; const int kc = sc * 2; \
    *(bf16x8*)(K_lds + (bb) * SHM_K + KSWZ(sr, kc)) = sr_[i].ks0; *(bf16x8*)(K_lds + (bb) * SHM_K + KSWZ(32 + sr, kc)) = sr_[i].ks1; } while (0)
#define SWAIT() asm volatile("s_waitcnt vmcnt(4)" ::: "memory")
    f32x16 pA0, pA1, pB0, pB1; bf16x8 pa0, pa1, pa2, pa3;
    constexpr int SE = 0, SO = 1;
    SLOAD(SE, 0); asm volatile("s_waitcnt vmcnt(0)" ::: "memory"); SWRITE(0, SE); __syncthreads();
    qkt(pA0, pA1, K_lds, qr, kbase, negM); expA(pA0);
    SLOAD(SO, 1); if (2 < NT) SLOAD(SE, 2);
    SWAIT(); SWRITE(1, SO); __syncthreads();
    for (int j = 1; j + 1 < NT; j += 2) {
        SBAR(); qkt(pB0, pB1, K_lds + SHM_K, qr, kbase, negM);
        finishSM(pA0, pA1, l_reg, pa0, pa1, pa2, pa3); SBAR();
        SLOAD(SO, j + 2); SBAR();
        pv_d0(o, vb0, pa0, pa1, pa2, pa3); expA(pB0);
        __syncthreads(); SWAIT(); SWRITE(0, SE);
        __syncthreads();
        SBAR(); qkt(pA0, pA1, K_lds, qr, kbase, negM);
        finishSM(pB0, pB1, l_reg, pa0, pa1, pa2, pa3); SBAR();
        if (j + 3 < NT) SLOAD(SE, j + 3); SBAR();
        pv_d0(o, vb0 + (int)SHM_V, pa0, pa1, pa2, pa3); expA(pA0);
        __syncthreads(); SWAIT(); SWRITE(1, SO);
        __syncthreads();
    }
    SBAR(); qkt(pB0, pB1, K_lds + SHM_K, qr, kbase, negM);
    finishSM(pA0, pA1, l_reg, pa0, pa1, pa2, pa3); SBAR();
    pv_d0(o, vb0, pa0, pa1, pa2, pa3); expA(pB0);
    finishSM(pB0, pB1, l_reg, pa0, pa1, pa2, pa3); SBAR();
    pv_d0(o, vb0 + (int)SHM_V, pa0, pa1, pa2, pa3);
#undef SLOAD
#undef LD16
#undef SWRITE
#undef SWAIT
    int tid2 = tid; asm volatile("" : "+v"(tid2));
    { const int wid = tid2 >> 6, lane = tid2 & 63, r32 = lane & 31, hi = lane >> 5, wq = wid & 3, map = wid >> 2;
    float* li_l = (float*)(lds + 2 * SHM_V + 2 * SHM_K) + wid * 64;
    const float* SC2 = SC; asm volatile("" : "+s"(SC2));
    const float lam = SC2[0], lam_init = SC2[2];
    l_reg = half_swap_sum(l_reg);
    if (hi == 0) li_l[r32] = l_reg;
    asm volatile("s_waitcnt lgkmcnt(0)" ::: "memory");
    float rli[16];
#pragma unroll
    for (int r = 0; r < 16; ++r) rli[r] = __builtin_amdgcn_rcpf(li_l[crow(r, hi)]);
    __syncthreads();
    float* X = (float*)lds + wq * 4096;
    if (map == 1) {
#pragma unroll
        for (int r = 0; r < 16; ++r)
#pragma unroll
            for (int d0 = 0; d0 < 4; ++d0) X[crow(r, hi) * 128 + d0 * 32 + r32] = o[d0][r] * rli[r];
    }
    __syncthreads();
    if (map == 0) {
        const float oml = 1.f - lam_init;
        float sg[4];
#pragma unroll
        for (int d0 = 0; d0 < 4; ++d0) sg[d0] = subg[d0 * 32 + r32] * oml;
        const size_t rowb = (size_t)((cx ? M + b * CL : b * L) + q0 + wq * QBLK);
#pragma unroll
        for (int r = 0; r < 16; ++r) {
            const int qrow = crow(r, hi);
            float v[4], ss = 0.f;
#pragma unroll
            for (int d0 = 0; d0 < 4; ++d0) { v[d0] = o[d0][r] * rli[r] - lam * X[qrow * 128 + d0 * 32 + r32]; ss += v[d0] * v[d0]; }
            ss += sxor<1>(ss); ss += sxor<2>(ss); ss += sxor<4>(ss); ss += sxor<8>(ss); ss += sxor<16>(ss);
            const float rs = 1.0f / sqrtf(ss * (1.f / 128.f) + EPS);
            const bf16* grow = PB + (rowb + qrow) * IN_W + G_OFF + 512 + h * 128 + r32;
            bf16* yrow = Y + (rowb + qrow) * 1024 + 512 + h * 128 + r32;
#pragma unroll
            for (int d0 = 0; d0 < 4; ++d0) yrow[d0 * 32] = (bf16)f2bf(v[d0] * rs * sg[d0] * silu_f(bf2f(grow[d0 * 32])));
        }
    }
    }
    __syncthreads();
}
#undef KSWZ
#undef SBAR
}


namespace att2 {
constexpr int NW = 8, QBLK = 32, KVBLK = 64, NSLOT = 4, KSLOT = 16384, VSLOT = 16384;
constexpr int LDS_K = 0, LDS_V = NSLOT * KSLOT, LDS_WS = 132096, LDS_END = LDS_WS + NW * 256;
#define SBAR() __builtin_amdgcn_sched_barrier(0)
__device__ __forceinline__ int crow(int r, int hi) { return (r & 3) + 8 * (r >> 2) + 4 * hi; }
typedef __attribute__((address_space(3))) const char* lds_cptr;
typedef short v4i16_t __attribute__((ext_vector_type(4)));
typedef float f32x2_t __attribute__((ext_vector_type(2))); typedef __bf16 bf16x2_t __attribute__((ext_vector_type(2)));
__device__ __forceinline__ unsigned cvtpk_s(float lo, float hi) { f32x2_t v = {lo, hi}; bf16x2_t b = __builtin_convertvector(v, bf16x2_t); return __builtin_bit_cast(unsigned, b); }
__device__ __forceinline__ s16x4 vtr(lds_cptr p) { return __builtin_bit_cast(s16x4, __builtin_amdgcn_ds_read_tr16_b64_v4i16((__attribute__((address_space(3))) v4i16_t*)p)); }
__device__ __forceinline__ void glds16s(const void* sbase, unsigned voff, unsigned lds_dst) { unsigned keep;
    asm volatile("s_mov_b32 %0, m0\n\ts_mov_b32 m0, %3\n\ts_nop 0\n\tglobal_load_lds_dwordx4 %1, %2\n\ts_mov_b32 m0, %0" : "=&s"(keep) : "v"(voff), "s"(sbase), "s"(lds_dst) : "memory"); }
#define WAIT_BAR(N) asm volatile("s_waitcnt vmcnt(" #N ") lgkmcnt(0)\n\ts_barrier" ::: "memory")
__device__ __forceinline__ void kload2(bf16x8* kf, lds_cptr kp, int j) { kf[2 * j] = *(const __attribute__((address_space(3))) bf16x8*)(kp + j * 2048); kf[2 * j + 1] = *(const __attribute__((address_space(3))) bf16x8*)(kp + j * 2048 + 512); }

__device__ __forceinline__ void attn_item(const bf16* PB, const unsigned char* KT, const unsigned char* VT, bf16* Y, const float* subg, const float* SC, const bool cx, int b, int h, int q0, char* shm, const int tid) {
    const int lane = tid & 63, r32 = lane & 31, hi = lane >> 5; const int wid = __builtin_amdgcn_readfirstlane(tid >> 6); const int wq = wid & 3, map = wid >> 2;
    const int rowq0 = (cx ? M + b * CL : b * L) + q0;
    const unsigned lds0 = (unsigned)(uintptr_t)shm;
    const unsigned koff = (unsigned)(wid * 1024 + lane * 16);
    const unsigned voff = (unsigned)(((wid >> 2) * 4 + (wid & 3)) * 1024 + lane * 16);
    const unsigned kdst = lds0 + LDS_K + wid * 1024, vdst = lds0 + LDS_V + ((wid >> 2) * 4 + (wid & 3)) * 1024;
    const char* ktb = (const char*)KT + (size_t)((b * 4 + h) * NTILE) * 16384; const char* vtb = (const char*)VT + (size_t)((b * 4 + h) * NTILE) * 16384;
#define DMA_K(t, slot) do { const char* tb_ = ktb + (size_t)(t) * 16384; const unsigned d_ = (unsigned)__builtin_amdgcn_readfirstlane(kdst + (slot)); glds16s(tb_, koff, d_); glds16s(tb_, koff + 8192u, d_ + 8192u); } while (0)
#define DMA_V(t, slot) do { const char* tb_ = vtb + (size_t)(t) * 16384; const unsigned d_ = (unsigned)__builtin_amdgcn_readfirstlane(vdst + (slot)); glds16s(tb_, voff, d_); glds16s(tb_, voff + 8192u, d_ + 8192u); } while (0)
    const lds_cptr shm3 = (lds_cptr)shm;
    const lds_cptr kp0 = shm3 + LDS_K + map * 8192 + hi * 1024 + r32 * 16;
    const lds_cptr vp0 = shm3 + LDS_V + ((lane >> 4) & 1) * 32 + (lane & 3) * 8 + (4 * hi + ((lane & 15) >> 2)) * 64;
    const int NT = cx ? CL / KVBLK : (CL + L) / KVBLK;
    DMA_K(0, 0); DMA_V(0, 0); DMA_K(1, KSLOT);
    bf16x8 qr[4];
    { const bf16* Qw = PB + (size_t)(rowq0 + wq * QBLK + r32) * IN_W + Q_OFF + h * 128 + map * 64 + hi * 8;
#pragma unroll
      for (int d0 = 0; d0 < 4; ++d0) qr[d0] = *reinterpret_cast<const bf16x8*>(Qw + d0 * 16); }
    float l_reg = 0.f; f32x16 o[4]; o[0] = f32x16{}; o[1] = f32x16{}; o[2] = f32x16{}; o[3] = f32x16{};
    const f32x16 zero = f32x16{};
    f32x16 pA0, pA1, pB0, pB1; bf16x8 kf[8];
    int s_m2 = 3 * KSLOT, s_m1 = 0, s_0 = KSLOT, s_p1 = 2 * KSLOT;
#define ROT4() do { const int x_ = s_m2; s_m2 = s_m1; s_m1 = s_0; s_0 = s_p1; s_p1 = x_; } while (0)
    DMA_K(2, 2 * KSLOT);
    WAIT_BAR(6);
    {
      const lds_cptr kb = kp0;
#pragma unroll
      for (int d0 = 0; d0 < 4; ++d0) { const bf16x8 b0 = *(const __attribute__((address_space(3))) bf16x8*)(kb + d0 * 2048), b1 = *(const __attribute__((address_space(3))) bf16x8*)(kb + d0 * 2048 + 512);
          if (d0 == 0) { pA0 = __builtin_amdgcn_mfma_f32_32x32x16_bf16(b0, qr[0], zero, 0, 0, 0); pA1 = __builtin_amdgcn_mfma_f32_32x32x16_bf16(b1, qr[0], zero, 0, 0, 0); }
          else { pA0 = __builtin_amdgcn_mfma_f32_32x32x16_bf16(b0, qr[d0], pA0, 0, 0, 0); pA1 = __builtin_amdgcn_mfma_f32_32x32x16_bf16(b1, qr[d0], pA1, 0, 0, 0); } }
#pragma unroll
      for (int r = 0; r < 16; ++r) { pA0[r] = __builtin_amdgcn_exp2f(pA0[r]); pA1[r] = __builtin_amdgcn_exp2f(pA1[r]); } }
    WAIT_BAR(0);
    DMA_K(3, 3 * KSLOT); DMA_V(1, VSLOT);
    WAIT_BAR(4);
    s16x4 vlo[8], vhi[8]; u32x4 pw0, pw1, pw2, pw3;
#define PATH_ENTRY() int ln_; asm volatile("v_mbcnt_lo_u32_b32 %0, -1, 0\n\tv_mbcnt_hi_u32_b32 %0, -1, %0" : "=v"(ln_)); \
    const unsigned koff = (unsigned)(wid * 1024 + ln_ * 16); \
    const unsigned voff = (unsigned)(((wid >> 2) * 4 + (wid & 3)) * 1024 + ln_ * 16); \
    kload2(kf, kp0 + s_0, 0); kload2(kf, kp0 + s_0, 1); kload2(kf, kp0 + s_0, 2); kload2(kf, kp0 + s_0, 3);
#define PKW(P, B) cvtpk_s(P[B], P[B + 1])
#define PAF(k) __builtin_bit_cast(bf16x8, pw##k)
#define VFR(i) (bf16x8){vlo[i][0], vlo[i][1], vlo[i][2], vlo[i][3], vhi[i][0], vhi[i][1], vhi[i][2], vhi[i][3]}
#define PIN(x) asm volatile("" : "+v"(x))
#define EX(v) __builtin_amdgcn_exp2f(v)
#define VRD(s, d0, ks) do { vlo[s] = vtr(vp_ + ((d0) * 4096 + (ks) * 1024)); vhi[s] = vtr(vp_ + ((d0) * 4096 + (ks) * 1024 + 512)); } while (0)
#define GAPA(MF, A0, A1, A2, A3, W0, W1, PW) do { MF; W0; W1; PIN(PW); SBAR(); } while (0)
#define GAPB(MF, X, B, S) do { MF; X[B] = EX(X[B]); X[B + 1] = EX(X[B + 1]); PIN(X); sacc += S[B]; sacc += S[B + 1]; PIN(sacc); SBAR(); } while (0)
#define KRD(G, KS, j) do { if (G) { kload2(kf, kp0 + (KS), j); SBAR(); } } while (0)
#define MF32(a, b, c) __builtin_amdgcn_mfma_f32_32x32x16_bf16(a, b, c, 0, 0, 0)
#define PHASE_A(C0, C1, P0, P1, VS) do { SBAR(); \
    const lds_cptr vp_ = vp0 + (VS); \
    VRD(0, 0, 0); SBAR(); \
    GAPA(C0 = MF32(kf[0], qr[0], zero), P0[2], P0[3], P0[4], P0[5],     pw0[0] = PKW(P0, 0),  pw0[1] = PKW(P0, 2),  pw0); \
    VRD(1, 1, 0); SBAR(); GAPA(C1 = MF32(kf[1], qr[0], zero), P0[6], P0[7], P0[8], P0[9],     pw0[2] = PKW(P0, 4),  pw0[3] = PKW(P0, 6),  pw0); \
    VRD(2, 2, 0); SBAR(); GAPA(C0 = MF32(kf[2], qr[1], C0),   P0[10], P0[11], P0[12], P0[13], pw1[0] = PKW(P0, 8),  pw1[1] = PKW(P0, 10), pw1); \
    VRD(3, 3, 0); SBAR(); GAPA(C1 = MF32(kf[3], qr[1], C1),   P0[14], P0[15], P1[0], P1[1],   pw1[2] = PKW(P0, 12), pw1[3] = PKW(P0, 14), pw1); \
    VRD(4, 0, 1); SBAR(); GAPA(C0 = MF32(kf[4], qr[2], C0),   P1[2], P1[3], P1[4], P1[5],     pw2[0] = PKW(P1, 0),  pw2[1] = PKW(P1, 2),  pw2); \
    VRD(5, 1, 1); SBAR(); GAPA(C1 = MF32(kf[5], qr[2], C1),   P1[6], P1[7], P1[8], P1[9],     pw2[2] = PKW(P1, 4),  pw2[3] = PKW(P1, 6),  pw2); \
    VRD(6, 2, 1); SBAR(); GAPA(C0 = MF32(kf[6], qr[3], C0),   P1[10], P1[11], P1[12], P1[13], pw3[0] = PKW(P1, 8),  pw3[1] = PKW(P1, 10), pw3); \
    VRD(7, 3, 1); SBAR(); GAPA(C1 = MF32(kf[7], qr[3], C1),   P1[14], P1[15], 0.f, 0.f,       pw3[2] = PKW(P1, 12), pw3[3] = PKW(P1, 14), pw3); \
    SBAR(); } while (0)
#define PHASE_B(X0, X1, S0, S1, VS, KS, GL) do { SBAR(); \
    const lds_cptr vp_ = vp0 + (VS); float sacc = 0.f; \
    GAPB(o[0] = MF32(PAF(0), VFR(0), o[0]), X0, 0, S0);  VRD(0, 0, 2); SBAR(); \
    GAPB(o[1] = MF32(PAF(0), VFR(1), o[1]), X0, 2, S0);  VRD(1, 1, 2); SBAR(); \
    GAPB(o[2] = MF32(PAF(0), VFR(2), o[2]), X0, 4, S0);  VRD(2, 2, 2); SBAR(); \
    GAPB(o[3] = MF32(PAF(0), VFR(3), o[3]), X0, 6, S0);  VRD(3, 3, 2); SBAR(); KRD(GL, KS, 0); \
    GAPB(o[0] = MF32(PAF(1), VFR(4), o[0]), X0, 8, S0);  VRD(4, 0, 3); SBAR(); KRD(GL, KS, 1); \
    GAPB(o[1] = MF32(PAF(1), VFR(5), o[1]), X0, 10, S0); VRD(5, 1, 3); SBAR(); KRD(GL, KS, 2); \
    GAPB(o[2] = MF32(PAF(1), VFR(6), o[2]), X0, 12, S0); VRD(6, 2, 3); SBAR(); KRD(GL, KS, 3); \
    GAPB(o[3] = MF32(PAF(1), VFR(7), o[3]), X0, 14, S0); VRD(7, 3, 3); SBAR(); \
    GAPB(o[0] = MF32(PAF(2), VFR(0), o[0]), X1, 0, S1); \
    GAPB(o[1] = MF32(PAF(2), VFR(1), o[1]), X1, 2, S1); \
    GAPB(o[2] = MF32(PAF(2), VFR(2), o[2]), X1, 4, S1); \
    GAPB(o[3] = MF32(PAF(2), VFR(3), o[3]), X1, 6, S1); \
    GAPB(o[0] = MF32(PAF(3), VFR(4), o[0]), X1, 8, S1); \
    GAPB(o[1] = MF32(PAF(3), VFR(5), o[1]), X1, 10, S1); \
    GAPB(o[2] = MF32(PAF(3), VFR(6), o[2]), X1, 12, S1); \
    GAPB(o[3] = MF32(PAF(3), VFR(7), o[3]), X1, 14, S1); \
    l_reg += sacc; } while (0)
#define DMA_T(t) do { if ((t) + 3 < NT) { DMA_K((t) + 3, s_m1); } if ((t) + 1 < NT) { DMA_V((t) + 1, s_p1); } } while (0)
#define ENDW(tt) do { if ((tt) + 3 < NT) { WAIT_BAR(4); } else if ((tt) + 1 < NT) { WAIT_BAR(2); } else { WAIT_BAR(0); } } while (0)
#define DMA_F(t) do { DMA_K((t) + 3, s_m1); DMA_V((t) + 1, s_p1); } while (0)
    if (map == 0) {
        __builtin_amdgcn_s_setprio(1);
        PATH_ENTRY();
        int t = 1;
#pragma clang loop unroll(disable)
        for (; t + 5 < NT; t += 2) {
            PHASE_A(pB0, pB1, pA0, pA1, s_m1); DMA_F(t);     PHASE_B(pB0, pB1, pA0, pA1, s_m1, s_p1, true); WAIT_BAR(4); ROT4();
            PHASE_A(pA0, pA1, pB0, pB1, s_m1); DMA_F(t + 1); PHASE_B(pA0, pA1, pB0, pB1, s_m1, s_p1, true); WAIT_BAR(4); ROT4();
        }
#pragma clang loop unroll(disable)
        for (; t + 1 < NT; t += 2) {
            PHASE_A(pB0, pB1, pA0, pA1, s_m1); DMA_T(t);     PHASE_B(pB0, pB1, pA0, pA1, s_m1, s_p1, true); ENDW(t);     ROT4();
            PHASE_A(pA0, pA1, pB0, pB1, s_m1); DMA_T(t + 1); PHASE_B(pA0, pA1, pB0, pB1, s_m1, s_p1, true); ENDW(t + 1); ROT4();
        }
        PHASE_A(pB0, pB1, pA0, pA1, s_m1); PHASE_B(pB0, pB1, pA0, pA1, s_m1, s_p1, false); WAIT_BAR(0);
        __builtin_amdgcn_s_setprio(0);
    } else {
        PATH_ENTRY();
        DMA_T(1); PHASE_A(pB0, pB1, pA0, pA1, s_m1); ENDW(1); ROT4();
        int t = 2;
#pragma clang loop unroll(disable)
        for (; t + 5 < NT; t += 2) {
            PHASE_B(pB0, pB1, pA0, pA1, s_m2, s_0, true); DMA_F(t);     PHASE_A(pA0, pA1, pB0, pB1, s_m1); WAIT_BAR(4); ROT4();
            PHASE_B(pA0, pA1, pB0, pB1, s_m2, s_0, true); DMA_F(t + 1); PHASE_A(pB0, pB1, pA0, pA1, s_m1); WAIT_BAR(4); ROT4();
        }
#pragma clang loop unroll(disable)
        for (; t + 1 < NT; t += 2) {
            PHASE_B(pB0, pB1, pA0, pA1, s_m2, s_0, true); DMA_T(t);     PHASE_A(pA0, pA1, pB0, pB1, s_m1); ENDW(t);     ROT4();
            PHASE_B(pA0, pA1, pB0, pB1, s_m2, s_0, true); DMA_T(t + 1); PHASE_A(pB0, pB1, pA0, pA1, s_m1); ENDW(t + 1); ROT4();
        }
        PHASE_B(pB0, pB1, pA0, pA1, s_m2, s_0, false);
        s_0 = s_m1;
    }
#undef DMA_F
#undef PATH_ENTRY
    WAIT_BAR(0);
    { float sacc = pB0[0] + pB0[1];
#pragma unroll
      for (int r = 2; r < 16; ++r) sacc += pB0[r];
#pragma unroll
      for (int r = 0; r < 16; ++r) sacc += pB1[r];
      l_reg += sacc;
      pw0 = (u32x4){PKW(pB0, 0), PKW(pB0, 2), PKW(pB0, 4), PKW(pB0, 6)}; pw1 = (u32x4){PKW(pB0, 8), PKW(pB0, 10), PKW(pB0, 12), PKW(pB0, 14)};
      pw2 = (u32x4){PKW(pB1, 0), PKW(pB1, 2), PKW(pB1, 4), PKW(pB1, 6)}; pw3 = (u32x4){PKW(pB1, 8), PKW(pB1, 10), PKW(pB1, 12), PKW(pB1, 14)};
      SBAR();
      const lds_cptr vp_ = vp0 + s_0;
#pragma unroll
      for (int d0 = 0; d0 < 4; ++d0) {
          VRD(0, d0, 0); VRD(1, d0, 1); VRD(2, d0, 2); VRD(3, d0, 3);
          o[d0] = MF32(PAF(0), VFR(0), o[d0]); o[d0] = MF32(PAF(1), VFR(1), o[d0]); o[d0] = MF32(PAF(2), VFR(2), o[d0]); o[d0] = MF32(PAF(3), VFR(3), o[d0]); } }
#undef PKW
#undef PAF
#undef VFR
#undef PIN
#undef EX
#undef VRD
#undef GAPA
#undef GAPB
#undef KRD
#undef MF32
#undef PHASE_A
#undef PHASE_B
#undef DMA_T
#undef ENDW
#undef ROT4
#undef DMA_K
#undef DMA_V
    int tid2; asm volatile("v_mbcnt_lo_u32_b32 %0, -1, 0\n\tv_mbcnt_hi_u32_b32 %0, -1, %0" : "=v"(tid2)); tid2 += wid * 64;
    { const int wid = tid2 >> 6, lane = tid2 & 63, r32 = lane & 31, hi = lane >> 5, wq = wid & 3, map = wid >> 2;
    float* li_l = (float*)(shm + LDS_WS) + wid * 64;
    const float* SC2 = SC; asm volatile("" : "+s"(SC2));
    const float lam = SC2[0], lam_init = SC2[2];
    const size_t rowb = (size_t)((cx ? M + b * CL : b * L) + q0 + wq * QBLK);
    u32x4 gt[8];
    if (map == 0) {
        const bf16* gp = PB + (rowb + (lane >> 4)) * IN_W + G_OFF + 512 + h * 128 + (lane & 15) * 8;
#pragma unroll
        for (int i = 0; i < 8; ++i) gt[i] = *(const u32x4*)(gp + (size_t)(4 * i) * IN_W);
    }
    l_reg = half_swap_sum(l_reg);
    if (hi == 0) li_l[r32] = l_reg;
    asm volatile("s_waitcnt lgkmcnt(0)" ::: "memory");
    float rli[16];
#pragma unroll
    for (int r = 0; r < 16; ++r) rli[r] = __builtin_amdgcn_rcpf(li_l[crow(r, hi)]);
    __syncthreads();
    float* X = (float*)shm + wq * 4096;
    bf16* GY = (bf16*)(shm + LDS_V) + wq * 4096;
    if (map == 1) {
#pragma unroll
        for (int r = 0; r < 16; ++r)
#pragma unroll
            for (int d0 = 0; d0 < 4; ++d0) X[crow(r, hi) * 128 + d0 * 32 + r32] = o[d0][r] * rli[r];
    } else {
#pragma unroll
        for (int i = 0; i < 8; ++i) *(u32x4*)(GY + ((lane >> 4) + 4 * i) * 128 + (lane & 15) * 8) = gt[i];
    }
    __syncthreads();
    if (map == 0) {
        const float oml = 1.f - lam_init;
        float sg[4];
#pragma unroll
        for (int d0 = 0; d0 < 4; ++d0) sg[d0] = subg[d0 * 32 + r32] * oml;
#pragma unroll
        for (int r = 0; r < 16; ++r) {
            const int qrow = crow(r, hi);
            float v[4], ss = 0.f;
#pragma unroll
            for (int d0 = 0; d0 < 4; ++d0) { v[d0] = o[d0][r] * rli[r] - lam * X[qrow * 128 + d0 * 32 + r32]; ss += v[d0] * v[d0]; }
            ss += sxor<1>(ss); ss += sxor<2>(ss); ss += sxor<4>(ss); ss += sxor<8>(ss); ss += sxor<16>(ss);
            const float rs = __builtin_amdgcn_rsqf(ss * (1.f / 128.f) + EPS);
            bf16* gy = GY + qrow * 128 + r32;
#pragma unroll
            for (int d0 = 0; d0 < 4; ++d0) gy[d0 * 32] = (bf16)f2bf(v[d0] * rs * sg[d0] * silu_f(bf2f(gy[d0 * 32])));
        }
        asm volatile("s_waitcnt lgkmcnt(0)" ::: "memory");
        bf16* yp = Y + (rowb + (lane >> 4)) * 1024 + 512 + h * 128 + (lane & 15) * 8;
#pragma unroll
        for (int i = 0; i < 8; ++i) st_wt16(yp + (size_t)(4 * i) * 1024, *(const u32x4*)(GY + ((lane >> 4) + 4 * i) * 128 + (lane & 15) * 8));
    }
    }
    __syncthreads();
}
#undef SBAR
#undef WAIT_BAR
}

constexpr int NWAVES = 8;
constexpr int RING_OFF = 0, RING_BYTES = 131072;
constexpr int LDSCTL_OFF = RING_BYTES, MISC_OFF = LDSCTL_OFF + 320;
constexpr int LDS_BYTES = 147456;
constexpr int CW_BAR = 1024;
constexpr int CW_FFT = 8192;
constexpr int CW_SEAM = 4608;
#define SEAM_HCNT(i) (CW_SEAM + 16 * (i))
#define SEAM_CCNT    (CW_SEAM + 16 * 64)
#define SEAM_MODCNT  (CW_SEAM + 16 * 130)
#define SEAM_PREPCNT (CW_SEAM + 16 * 131)
constexpr int CW_Q = 8192 + 1024;
constexpr int CW_YCNT = 10240;
#define SEAM_YCNT(l, blk) (CW_YCNT + 16 * (66 * (l) + (blk)))
#define SEAM_XCNT(i) (CW_YCNT + 16 * (132 + (i)))
#define SEAM_CXCNT   (CW_YCNT + 16 * 196)
#define SEAM_MIXDONE (CW_YCNT + 16 * 197)
#define SEAM_NQ      (CW_YCNT + 16 * 198)

typedef GAS unsigned gu32;
#define RLX_AGENT __ATOMIC_RELAXED, __HIP_MEMORY_SCOPE_AGENT
#define LDS_WAIT() asm volatile("s_waitcnt lgkmcnt(0)" ::: "memory")
#define VM_WAIT() asm volatile("s_waitcnt vmcnt(0)" ::: "memory")

#define XB_TMO      128
#define XB_XCNT(j)  (256  + 64 * (j))
#define XB_XSUB(j)  (1280 + 64 * (j))
#define XB_XGEN(j)  (2304 + 64 * (j))
#define XB_TOP      3328
#define XB_TOPGEN   3392
#define XCD_BAR_WORDS 3456
#define XB_SPIN_CAP (1u << 18)
__device__ __forceinline__ unsigned xb_ld(unsigned* p)              { return __hip_atomic_load(p, __ATOMIC_RELAXED, __HIP_MEMORY_SCOPE_AGENT); }
__device__ __forceinline__ unsigned xb_add(unsigned* p, unsigned v) { return __hip_atomic_fetch_add(p, v, __ATOMIC_RELAXED, __HIP_MEMORY_SCOPE_AGENT); }
__device__ __forceinline__ unsigned xb_xcc_id() { return (unsigned)__builtin_amdgcn_s_getreg((3 << 11) | 20) & 0xFu; }
#define XB_SPIN(cond, bar) do { unsigned _sp = 0; while (cond) { __builtin_amdgcn_s_sleep(1); \
    if ((++_sp & 255u) == 0u) { if (xb_ld(&(bar)[XB_TMO])) break; if (_sp > XB_SPIN_CAP) { atomicAdd(&(bar)[XB_TMO], 1u); break; } } } } while (0)
struct XcdBarrier { unsigned* bar; unsigned x; volatile LAS unsigned* st; };
__device__ __forceinline__ XcdBarrier xcd_barrier_post(unsigned* bar, volatile LAS unsigned* st) {
    XcdBarrier b; b.bar = bar; b.x = xb_xcc_id(); b.st = st;
    if (threadIdx.x == 0) (void)xb_add(&bar[XB_XCNT(b.x)], 1u);
    return b;
}
__device__ __forceinline__ void xcd_barrier_complete(unsigned* bar, unsigned x, unsigned& nloc, unsigned& nx) {
    const unsigned G = gridDim.x * gridDim.y * gridDim.z;
    unsigned sum, cnt, mine, sp = 0u;
    for (;;) {
        sum = 0u; cnt = 0u; mine = 0u;
#pragma unroll 1
        for (unsigned j = 0; j < 16; ++j) { const unsigned c = xb_ld(&bar[XB_XCNT(j)]); sum += c; cnt += (c > 0u) ? 1u : 0u; mine = (j == x) ? c : mine; }
        if (sum == G) break;
        __builtin_amdgcn_s_sleep(1);
        if ((++sp & 255u) == 0u) { if (xb_ld(&bar[XB_TMO])) break; if (sp > XB_SPIN_CAP) { atomicAdd(&bar[XB_TMO], 1u); break; } }
    }
    nloc = mine > 0u ? mine : 1u; nx = cnt > 0u ? cnt : 1u;
}
__device__ __forceinline__ void xcd_barrier(const XcdBarrier& b) {
    asm volatile("s_waitcnt vmcnt(0)" ::: "memory");
    __syncthreads();
    if (threadIdx.x == 0) {
        unsigned* bar = b.bar;
        __builtin_amdgcn_s_waitcnt(0);
        unsigned nloc = b.st[0], nx = b.st[1];
        if (nloc == 0u) { xcd_barrier_complete(bar, b.x, nloc, nx); b.st[0] = nloc; b.st[1] = nx; }
        const unsigned old = xb_add(&bar[XB_XSUB(b.x)], 1u);
        const unsigned gen = old / nloc;
        if (old + 1u == (gen + 1u) * nloc) {
            __builtin_amdgcn_fence(__ATOMIC_RELEASE, "agent");
            asm volatile("s_waitcnt vmcnt(0)" ::: "memory");
            const unsigned og = xb_add(&bar[XB_TOP], 1u);
            const unsigned tg = og / nx;
            if (og + 1u == (tg + 1u) * nx) xb_add(&bar[XB_TOPGEN], 1u);
            else XB_SPIN(xb_ld(&bar[XB_TOPGEN]) == tg, bar);
            __builtin_amdgcn_fence(__ATOMIC_ACQUIRE, "agent");
            xb_add(&bar[XB_XGEN(b.x)], 1u);
            asm volatile("s_waitcnt vmcnt(0)" ::: "memory");
        } else {
            XB_SPIN(xb_ld(&bar[XB_XGEN(b.x)]) == gen, bar);
            __builtin_amdgcn_fence(__ATOMIC_ACQUIRE, "agent");
            asm volatile("s_waitcnt vmcnt(0)" ::: "memory");
        }
    }
    __syncthreads();
}

struct Args {
    const float* in[15]; float* out; unsigned char* ws; int ph_lo, ph_hi, skip, pad;
};

struct Frame {
    LAS unsigned char* lds;
    int tid, lane, wave, vcu, G;
};

__device__ __forceinline__ void p0_transpose_item(const float* W, int K, int N, bf16* WT, LAS float* scr, int item, int lane) {
    const int nblk = N / 32, kb = item / nblk, nb = item % nblk, k0 = 64 * kb, n0 = 32 * nb;
    float tv[32];
#pragma unroll
    for (int i = 0; i < 32; ++i) { const int kk = 2 * i + (lane >> 5); tv[i] = W[(size_t)(k0 + kk) * N + n0 + (lane & 31)]; }
#pragma unroll
    for (int i = 0; i < 32; ++i) { const int kk = 2 * i + (lane >> 5); scr[kk * 33 + (lane & 31)] = tv[i]; }
    LDS_WAIT(); asm volatile("" ::: "memory");
    const int c = lane & 7;
#pragma unroll
    for (int j = 0; j < 4; ++j) { const int n = (lane >> 3) + 8 * j; const LAS float* s = scr + (8 * c) * 33 + n;
        u32x4 o; o.x = pk2(s[0 * 33], s[1 * 33]); o.y = pk2(s[2 * 33], s[3 * 33]); o.z = pk2(s[4 * 33], s[5 * 33]); o.w = pk2(s[6 * 33], s[7 * 33]);
        st_wt16(WT + (size_t)(n0 + n) * K + k0 + 8 * c, o); }
    LDS_WAIT(); asm volatile("" ::: "memory");
}

__device__ __forceinline__ void phase_mod(Frame& F, const __attribute__((address_space(4))) Args* ap, unsigned char* ws) {
    const float* c = ap->in[1]; const float* c_ctx = ap->in[3]; const float* w_mod = ap->in[5]; const float* b_mod = ap->in[6]; const float* qk_norm_g = ap->in[11]; const float* lam_vecs = ap->in[12];
    float* MODP = (float*)(ws + WS_MOD); float* SC = (float*)(ws + WS_SC);
    LAS float* red = (LAS float*)F.lds;
    LAS float* scl = (LAS float*)(F.lds + 8192);
    if ((int)blockIdx.x * 2 < DEPTH * 48 * 4) {
#pragma unroll
        for (int i = 0; i < 6; ++i) { const int idx = F.tid + 512 * i, v = idx >> 10, k = idx & 1023; scl[idx] = silu_f(v == 2 ? c_ctx[k] : c[v * 1024 + k]); }
    }
    __syncthreads();
    const int half = F.wave >> 2, w4 = F.wave & 3;
    for (int t0 = blockIdx.x * 2; t0 < DEPTH * 48 * 4; t0 += 2 * F.G) {
        const int task = t0 + half;
        const int kq = task & 3, lc = task >> 2, l = lc / 48, chunk = lc % 48, j = chunk * 64 + F.lane;
        const float* W = w_mod + (size_t)l * 1024 * 3072 + j;
        float a0 = 0.f, a1 = 0.f, a2 = 0.f;
        const int k0 = kq * 256 + w4 * 64;
        float wv[64];
#pragma unroll
        for (int i = 0; i < 64; ++i) wv[i] = W[(size_t)(k0 + i) * 3072];
#pragma unroll
        for (int i = 0; i < 64; i += 4) {
            const f32x4 s0 = *(const LAS f32x4*)(scl + k0 + i), s1 = *(const LAS f32x4*)(scl + 1024 + k0 + i), s2 = *(const LAS f32x4*)(scl + 2048 + k0 + i);
            a0 += s0.x * wv[i] + s0.y * wv[i + 1] + s0.z * wv[i + 2] + s0.w * wv[i + 3];
            a1 += s1.x * wv[i] + s1.y * wv[i + 1] + s1.z * wv[i + 2] + s1.w * wv[i + 3];
            a2 += s2.x * wv[i] + s2.y * wv[i + 1] + s2.z * wv[i + 2] + s2.w * wv[i + 3]; }
        __syncthreads();
        red[(F.wave * 3 + 0) * 64 + F.lane] = a0; red[(F.wave * 3 + 1) * 64 + F.lane] = a1; red[(F.wave * 3 + 2) * 64 + F.lane] = a2;
        __syncthreads();
        { const int t = F.tid & 255;
          if (t < 192) { const int v = t >> 6, ln = t & 63; float s = 0.f;
#pragma unroll
            for (int w = 0; w < 4; ++w) s += red[((half * 4 + w) * 3 + v) * 64 + ln];
            const int jj = chunk * 64 + ln;
            __hip_atomic_store(MODP + kq * MODQ + (l * 3 + v) * 3072 + jj, s + (kq == 0 ? b_mod[l * 3072 + jj] : 0.f), __ATOMIC_RELAXED, __HIP_MEMORY_SCOPE_AGENT); } }
        asm volatile("s_waitcnt vmcnt(0)" ::: "memory");
        __syncthreads();
        if (F.tid == 0) (void)__hip_atomic_fetch_add((gu32*)(ws + WS_CTL) + SEAM_MODCNT, 2u, __ATOMIC_RELAXED, __HIP_MEMORY_SCOPE_AGENT);
    }
    __syncthreads();
    if (blockIdx.x == 0 && F.wave < DEPTH) {
        int l = F.wave; asm volatile("" : "+s"(l)); const int lane = F.lane; const float* lv = lam_vecs + l * 256;
        const float sa = wave_sum(lv[lane] * lv[64 + lane]), sb = wave_sum(lv[128 + lane] * lv[192 + lane]);
        const float lam_init = l == 0 ? 0.2f : 0.8f - 0.6f * 0.7408182206817179f;
        float gq = fabsf(qk_norm_g[l * 128 + lane]), gk = fabsf(qk_norm_g[l * 128 + 64 + lane]);
        gq = wave_max(gq); gk = wave_max(gk);
        if (lane == 0) { SC[l * 4 + 0] = expf(sa) - expf(sb) + lam_init; SC[l * 4 + 1] = 8.f * gq * gk; SC[l * 4 + 2] = lam_init; }
    }
}
__device__ __forceinline__ void phase_prep(Frame& F, const __attribute__((address_space(4))) Args* ap, unsigned char* ws) {
    const float* w_in = ap->in[7]; const float* w_fourier = ap->in[8]; const float* w_pool = ap->in[9]; const float* w_out = ap->in[14];
    float* ROPE = (float*)(ws + WS_ROPE); float* TW = (float*)(ws + WS_TW);
    bf16* WF = (bf16*)(ws + WS_WF); bf16* WP = (bf16*)(ws + WS_WP); bf16* WIN = (bf16*)(ws + WS_WIN); bf16* WOUT = (bf16*)(ws + WS_WOUT);
    {
        LAS float* scr = (LAS float*)(F.lds + F.wave * 12288);
        const int gw = F.vcu * NWAVES + F.wave, NGW = F.G * NWAVES;
        constexpr int I_IN = (D / 64) * (IN_W / 32), I_OUT = (D / 64) * (D / 32);
        constexpr int NITEMS = DEPTH * (I_IN + I_OUT);
        for (int it = gw; it < NITEMS; it += NGW) {
            int r = it;
            if (r < DEPTH * I_IN) { const int l = r / I_IN; p0_transpose_item(w_in + (size_t)l * D * IN_W, D, IN_W, WIN + (size_t)l * IN_W * D, scr, r % I_IN, F.lane); continue; }
            r -= DEPTH * I_IN;
            { const int l = r / I_OUT; p0_transpose_item(w_out + (size_t)l * D * D, D, D, WOUT + (size_t)l * D * D, scr, r % I_OUT, F.lane); }
        }
    }
    {
        const int gt = blockIdx.x * 512 + F.tid, NGT = F.G * 512;
        LAS float* cst = (LAS float*)(F.lds + 98304);
        __syncthreads();
        if (F.tid < 64) { float sv, cv; sincospif((float)F.tid / 32.f, &sv, &cv); cst[2 * F.tid] = cv; cst[2 * F.tid + 1] = sv; }
        __syncthreads();
        for (int i = gt; i < DEPTH * 4 * 64 * 128; i += NGT) {
            const int k = i & 127, n = (i >> 7) & 63, lg = i >> 13; const int cc = k >> 1; const int sn = k & 1;
            const float* wf = w_fourier + (size_t)lg * 64 * 64 + n;
            float s = 0.f;
#pragma unroll 16
            for (int m = 0; m < 64; ++m) s += cst[2 * ((cc * m) & 63) + sn] * wf[m * 64];
            WF[i] = (bf16)f2bf(s);
        }
        for (int i = gt; i < DEPTH * 4 * 64 * 64; i += NGT) { const int k = i & 63, n = (i >> 6) & 63, lg = i >> 12; WP[i] = (bf16)f2bf(w_pool[(size_t)lg * 4096 + k * 64 + n]); }
        for (int i = gt; i < 128 * 16; i += NGT) { const int pos = i >> 4, j = i & 15; const float inv = powf(10000.f, -(float)j / 16.f), ang = (float)pos * inv; __hip_atomic_store((unsigned long long*)(ROPE + 2 * i), (unsigned long long)__builtin_bit_cast(unsigned, cosf(ang)) | ((unsigned long long)__builtin_bit_cast(unsigned, sinf(ang)) << 32), __ATOMIC_RELAXED, __HIP_MEMORY_SCOPE_AGENT); }
        for (int i = gt; i < 8191; i += NGT) { const int half = 1 << (31 - __clz(i + 1)), pos = i + 1 - half; float sv, cv; sincospif(-(float)pos / (float)half, &sv, &cv); TW[2 * i] = cv; TW[2 * i + 1] = sv; }
    }
}

template <int NR, bool WT>
__device__ __forceinline__ void nm_rows(const float* x0, bf16* h0, const float* ng, const float* md, int lane) {
    f32x4 v[NR][4];
#pragma unroll
    for (int q = 0; q < NR; ++q) { const float* xr = x0 + (size_t)q * D + 4 * lane;
#pragma unroll
        for (int j = 0; j < 4; ++j) v[q][j] = *(const f32x4*)(xr + 256 * j); }
    f32x4 a[4], c[4];
#pragma unroll
    for (int j = 0; j < 4; ++j) { const int k = 4 * lane + 256 * j; a[j] = *(const f32x4*)(ng + k) * (mod4(md + 1024 + k) + 1.f); c[j] = mod4(md + k); }
    asm volatile("" ::: "memory");
#pragma unroll
    for (int q = 0; q < NR; ++q) {
        float s = 0.f;
#pragma unroll
        for (int j = 0; j < 4; ++j) s += (v[q][j].x * v[q][j].x + v[q][j].y * v[q][j].y) + (v[q][j].z * v[q][j].z + v[q][j].w * v[q][j].w);
        const float rstd = 1.0f / sqrtf(wave_sum(s) * (1.f / D) + EPS);
        unsigned long long* o8 = (unsigned long long*)(h0 + (size_t)q * D) + lane;
#pragma unroll
        for (int j = 0; j < 4; ++j) { const f32x4 y = v[q][j] * rstd * a[j] + c[j];
            const unsigned long long w = (unsigned long long)pk2(y.x, y.y) | ((unsigned long long)pk2(y.z, y.w) << 32);
            if (WT) __hip_atomic_store(o8 + 64 * j, w, __ATOMIC_RELAXED, __HIP_MEMORY_SCOPE_AGENT); else o8[64 * j] = w; } }
}
template <bool SEAM>
__device__ __forceinline__ void phase_normmod(Frame& F, const float* xin, const float* cin, const float* ng, const float* mod, bf16* H, gu32* ctl) {
    const int gw = F.vcu * NWAVES + F.wave, NGW = F.G * NWAVES;
    for (int blk = gw; blk < M / 8; blk += NGW) {
        const int r0 = blk * 8;
        nm_rows<8, SEAM>(xin + (size_t)r0 * D, H + (size_t)r0 * D, ng, mod + (r0 / L) * 3072, F.lane);
        if (SEAM) { asm volatile("s_waitcnt vmcnt(0)" ::: "memory"); if (F.lane == 0) (void)__hip_atomic_fetch_add(ctl + SEAM_HCNT(r0 >> 8), 1u, __ATOMIC_RELAXED, __HIP_MEMORY_SCOPE_AGENT); }
    }
    for (int r = M + gw; r < MT; r += NGW) {
        nm_rows<1, SEAM>(cin + (size_t)(r - M) * D, H + (size_t)r * D, ng, mod + 2 * 3072, F.lane);
        if (SEAM) { asm volatile("s_waitcnt vmcnt(0)" ::: "memory"); if (F.lane == 0) (void)__hip_atomic_fetch_add(ctl + SEAM_CCNT, 1u, __ATOMIC_RELAXED, __HIP_MEMORY_SCOPE_AGENT); }
    }
}
__device__ __forceinline__ void seam_wait_ge(gu32* cnt, unsigned want);
__device__ __forceinline__ void phase_normmod_jobs(Frame& F, volatile LAS unsigned* MISC, const float* x1, const float* c1, const float* ng, const float* mod, bf16* H, gu32* ctl_seam, gu32* ctlbase) {
#pragma unroll 1
    for (;;) {
        if (F.tid == 0) MISC[46] = __hip_atomic_fetch_add(ctlbase + SEAM_NQ, 1u, __ATOMIC_RELAXED, __HIP_MEMORY_SCOPE_AGENT);
        __syncthreads();
        const int j = __builtin_amdgcn_readfirstlane((int)MISC[46]);
        __syncthreads();
        if (j >= 256 + 8) break;
        if (F.tid == 0) { if (j < 256) seam_wait_ge(ctlbase + SEAM_XCNT(j >> 2), 4u); else seam_wait_ge(ctlbase + SEAM_CXCNT, 256u); }
        asm volatile("" ::: "memory");
        __syncthreads();
        const bool lat = j < 256; const int r0 = 64 * (lat ? j : j - 256) + 8 * F.wave;
        const float* xs = (lat ? x1 : c1) + (size_t)r0 * D; bf16* hs = H + (size_t)(lat ? r0 : M + r0) * D;
        const float* md = mod + (lat ? r0 / L : 2) * 3072; gu32* cnt = ctl_seam + (lat ? SEAM_HCNT(r0 >> 8) : SEAM_CCNT);
        nm_rows<8, true>(xs, hs, ng, md, F.lane);
        asm volatile("s_waitcnt vmcnt(0)" ::: "memory"); if (F.lane == 0) (void)__hip_atomic_fetch_add(cnt, lat ? 1u : 8u, __ATOMIC_RELAXED, __HIP_MEMORY_SCOPE_AGENT);
    }
}
__device__ __forceinline__ void seam_wait_ge(gu32* cnt, unsigned want) { unsigned sp = 0; while (__hip_atomic_load(cnt, __ATOMIC_RELAXED, __HIP_MEMORY_SCOPE_AGENT) < want) { __builtin_amdgcn_s_sleep(8); if (++sp > (1u << 20)) break; } }

__device__ __forceinline__ void phase_qkprep(Frame& F, bf16* PB, const float* qkg, const float* ROPE, int nrows) {
    const int gw = F.vcu * NWAVES + F.wave, NGW = F.G * NWAVES;
    const int g8 = F.lane & 7;
    for (int r = gw; r < nrows; r += NGW) {
        const bool isc = r >= M; const int t = r & (L - 1), pr = t >> 6, pc = t & 63;
#pragma unroll
        for (int part = 0; part < 2; ++part) {
            bf16* p = PB + (size_t)r * IN_W + (part ? K_OFF : Q_OFF) + F.lane * 8;
            const u32x4 w = *(const u32x4*)p;
            float x[8] = {bflo(w.x), bfhi(w.x), bflo(w.y), bfhi(w.y), bflo(w.z), bfhi(w.z), bflo(w.w), bfhi(w.w)};
            float ss = 0.f;
#pragma unroll
            for (int e = 0; e < 8; ++e) ss += x[e] * x[e];
            ss += sxor<1>(ss); ss += sxor<2>(ss); ss += sxor<4>(ss);
            const float rs = 1.0f / sqrtf(ss * (1.f / 64.f) + EPS);
            const f32x4 ga = *(const f32x4*)(qkg + part * 64 + g8 * 8), gb = *(const f32x4*)(qkg + part * 64 + g8 * 8 + 4);
            const float gg[8] = {ga.x, ga.y, ga.z, ga.w, gb.x, gb.y, gb.z, gb.w};
            float y[8];
#pragma unroll
            for (int e = 0; e < 8; ++e) y[e] = x[e] * rs * gg[e];
            if (!isc) {
                const int ax = g8 >> 2, ph = (g8 >> 1) & 1, jb = 8 * (g8 & 1);
                const float* rp = ROPE + ((ax ? pc : pr) * 16 + jb) * 2;
                const f32x4 c0 = *(const f32x4*)(rp), c1 = *(const f32x4*)(rp + 4), c2 = *(const f32x4*)(rp + 8), c3 = *(const f32x4*)(rp + 12);
                const float cs[8] = {c0.x, c0.z, c1.x, c1.z, c2.x, c2.z, c3.x, c3.z}, sn[8] = {c0.y, c0.w, c1.y, c1.w, c2.y, c2.w, c3.y, c3.w};
#pragma unroll
                for (int e = 0; e < 8; ++e) { const float other = sxor<2>(y[e]); y[e] = ph ? (y[e] * cs[e] + other * sn[e]) : (y[e] * cs[e] - other * sn[e]); }
            }
            if (part == 0) {
#pragma unroll
                for (int e = 0; e < 8; ++e) y[e] *= 0.125f * LOG2E;
            }
            u32x4 o; o.x = pk2(y[0], y[1]); o.y = pk2(y[2], y[3]); o.z = pk2(y[4], y[5]); o.w = pk2(y[6], y[7]);
            *(u32x4*)p = o;
        }
    }
}

#define FSW(j) ((j) ^ (((j) >> 7) & 31))
__device__ __forceinline__ void fft13_item(Frame& F, const unsigned* at, u32x2* ut, const float* TW) {
    int tid = F.tid; asm volatile("" : "+v"(tid));
    typedef float f32x2v __attribute__((ext_vector_type(2)));
    LAS f32x2v* z = (LAS f32x2v*)F.lds;
    unsigned v[16]; f32x2v wp[3][2], wf[4];
#pragma unroll
    for (int k = 0; k < 16; ++k) v[k] = at[tid + 512 * k];
#pragma unroll
    for (int pi = 0; pi < 3; ++pi) { const int h = 8 << (3 * pi);
#pragma unroll
        for (int q = 0; q < 2; ++q) wp[pi][q] = *(const f32x2v*)(TW + 2 * (4 * h - 1 + ((tid + 512 * q) & (h - 1)))); }
    asm volatile("" ::: "memory");
#define BF1(p, r)  do { const f32x2v t_ = x[r]; x[r] = x[p] - t_; x[p] = x[p] + t_; } while (0)
#define BFMI(p, r) do { const f32x2v t_ = {x[r].y, -x[r].x}; x[r] = x[p] - t_; x[p] = x[p] + t_; } while (0)
#define BFW1(p, r) do { const f32x2v t_ = {(x[r].x + x[r].y) * 0.70710678118654752f, (x[r].y - x[r].x) * 0.70710678118654752f}; x[r] = x[p] - t_; x[p] = x[p] + t_; } while (0)
#define BFW3(p, r) do { const f32x2v t_ = {(x[r].y - x[r].x) * 0.70710678118654752f, -(x[r].x + x[r].y) * 0.70710678118654752f}; x[r] = x[p] - t_; x[p] = x[p] + t_; } while (0)
#define CMUL(w, b) ((f32x2v){(w).x * (b).x - (w).y * (b).y, (w).x * (b).y + (w).y * (b).x})
#define BFLY(p, r, w) do { const f32x2v t_ = CMUL(w, x[r]); x[r] = x[p] - t_; x[p] = x[p] + t_; } while (0)
#pragma unroll
    for (int g = 0; g < 2; ++g) {
        f32x2v x[8];
#pragma unroll
        for (int j = 0; j < 8; ++j) { const int q = ((j & 1) << 2) | (j & 2) | (j >> 2); x[j] = (f32x2v){bflo(v[2 * q + g]), bfhi(v[2 * q + g])}; }
        BF1(0, 1); BF1(2, 3); BF1(4, 5); BF1(6, 7);
        BF1(0, 2); BF1(4, 6); BFMI(1, 3); BFMI(5, 7);
        BF1(0, 4); BFW1(1, 5); BFMI(2, 6); BFW3(3, 7);
        const int m8 = (int)(__brev((unsigned)(tid + 512 * g)) >> 22) << 3;
#pragma unroll
        for (int j = 0; j < 8; ++j) z[FSW(m8 + j)] = x[j];
    }
    __syncthreads();
#pragma unroll
    for (int pi = 0; pi < 3; ++pi) {
        const int s = 4 + 3 * pi, h = 1 << (s - 1);
        if (pi == 2) {
#pragma unroll
            for (int q = 0; q < 4; ++q) wf[q] = *(const f32x2v*)(TW + 2 * (4095 + tid + 512 * q)); }
#pragma unroll
        for (int q = 0; q < 2; ++q) { const int t = tid + 512 * q;
            const int pos = t & (h - 1), base = ((t >> (s - 1)) << (s + 2)) + pos;
            const f32x2v w3 = wp[pi][q];
            const f32x2v w2 = {w3.x * w3.x - w3.y * w3.y, (w3.x + w3.x) * w3.y};
            const f32x2v w1 = {w2.x * w2.x - w2.y * w2.y, (w2.x + w2.x) * w2.y};
            int e[8]; f32x2v x[8];
#pragma unroll
            for (int j = 0; j < 8; ++j) { e[j] = FSW(base + j * h); x[j] = z[e[j]]; }
            BFLY(0, 1, w1); BFLY(2, 3, w1); BFLY(4, 5, w1); BFLY(6, 7, w1);
            const f32x2v w2b = {w2.y, -w2.x};
            BFLY(0, 2, w2); BFLY(4, 6, w2); BFLY(1, 3, w2b); BFLY(5, 7, w2b);
            const float r2 = 0.70710678118654752f;
            const f32x2v w3a = {(w3.x + w3.y) * r2, (w3.y - w3.x) * r2}, w3b = {w3.y, -w3.x}, w3c = {(w3.y - w3.x) * r2, -(w3.x + w3.y) * r2};
            BFLY(0, 4, w3); BFLY(1, 5, w3a); BFLY(2, 6, w3b); BFLY(3, 7, w3c);
#pragma unroll
            for (int j = 0; j < 8; ++j) z[e[j]] = x[j]; }
        __syncthreads();
    }
#undef BF1
#undef BFMI
#undef BFW1
#undef BFW3
#undef BFLY
    const float sc = 0.5f / sqrtf(8192.f * 64.f);
#define UNPK(kk, za, zb) do { const float ar = ((za).x + (zb).x) * sc, ai = ((za).y - (zb).y) * sc, br = ((za).y + (zb).y) * sc, bi = ((zb).x - (za).x) * sc; \
        __hip_atomic_store((unsigned long long*)(ut + (kk)), (unsigned long long)pk2(ar, ai) | ((unsigned long long)pk2(br, bi) << 32), __ATOMIC_RELAXED, __HIP_MEMORY_SCOPE_AGENT); } while (0)
#pragma unroll
    for (int q = 0; q < 4; ++q) { const int p = tid + 512 * q;
        const int x2 = (4096 - p) & 4095;
        const f32x2v wv = wf[q];
        const f32x2v a1 = z[FSW(p)], b1 = z[FSW(p + 4096)], a2 = z[FSW(x2)], b2 = z[FSW(x2 + 4096)];
        const f32x2v t1 = CMUL(wv, b1);
        const f32x2v w2 = {-wv.x, wv.y};
        const f32x2v t2 = CMUL(w2, b2);
        const f32x2v ZA = a1 + t1, ZB = a1 - t1;
        if (p == 0) { UNPK(0, ZA, ZA); UNPK(4096, ZB, ZB); }
        else {
            const f32x2v ZC = a2 + t2, ZD = a2 - t2;
            UNPK(p, ZA, ZD); UNPK(p + 4096, ZB, ZC); UNPK(x2, ZC, ZB); UNPK(x2 + 4096, ZD, ZA);
        }
    }
    if (tid == 0) {
        const f32x2v a1 = z[FSW(2048)], b1 = z[FSW(6144)];
        const f32x2v t1 = {b1.y, -b1.x};
        const f32x2v ZA = a1 + t1, ZB = a1 - t1;
        UNPK(2048, ZA, ZB); UNPK(6144, ZB, ZA);
    }
#undef UNPK
#undef CMUL
    asm volatile("s_waitcnt vmcnt(0)" ::: "memory");
    __syncthreads();
}

__device__ __forceinline__ void fft_item(Frame& F, const unsigned* at, int logn, u32x2* ut, const float* TW) {
    const int n = 1 << logn, tid = F.tid;
    typedef float f32x2v __attribute__((ext_vector_type(2)));
    LAS f32x2v* z = (LAS f32x2v*)F.lds; LAS float* tw = (LAS float*)(z + 8192);
    for (int i = tid; i < n - 1; i += 512) { const float2 w = *(const float2*)(TW + 2 * i); tw[2 * i] = w.x; tw[2 * i + 1] = w.y; }
    for (int i = tid; i < n; i += 512) { const unsigned v = at[i]; const int j = FSW((int)(__brev((unsigned)i) >> (32 - logn))); z[j] = (f32x2v){bflo(v), bfhi(v)}; }
    __syncthreads();
    int s = 1;
    if (logn & 1) {
        for (int t = tid; t < n / 2; t += 512) { const int i0 = FSW(2 * t), i1 = FSW(2 * t + 1); const f32x2v u_ = z[i0], x_ = z[i1]; z[i0] = u_ + x_; z[i1] = u_ - x_; }
        __syncthreads(); s = 2;
    }
    for (; s <= logn; s += 2) {
        const int h = 1 << (s - 1);
        for (int t = tid; t < n / 4; t += 512) {
            const int pos = t & (h - 1), base = ((t >> (s - 1)) << (s + 1)) + pos;
            const float c1 = tw[2 * (h - 1 + pos)], s1 = tw[2 * (h - 1 + pos) + 1];
            const float c2 = tw[2 * (2 * h - 1 + pos)], s2 = tw[2 * (2 * h - 1 + pos) + 1];
            const int e0 = FSW(base), e1 = FSW(base + h), e2 = FSW(base + 2 * h), e3 = FSW(base + 3 * h);
            const f32x2v z0 = z[e0], z1 = z[e1], z2 = z[e2], z3 = z[e3];
            const float a0r = z0.x, a0i = z0.y, a1r = z1.x, a1i = z1.y, a2r = z2.x, a2i = z2.y, a3r = z3.x, a3i = z3.y;
            const float t1r = a1r * c1 - a1i * s1, t1i = a1r * s1 + a1i * c1, t3r = a3r * c1 - a3i * s1, t3i = a3r * s1 + a3i * c1;
            const float b0r = a0r + t1r, b0i = a0i + t1i, b1r = a0r - t1r, b1i = a0i - t1i, b2r = a2r + t3r, b2i = a2i + t3i, b3r = a2r - t3r, b3i = a2i - t3i;
            const float u2r = b2r * c2 - b2i * s2, u2i = b2r * s2 + b2i * c2;
            const float w3r = b3r * c2 - b3i * s2, w3i = b3r * s2 + b3i * c2;
            z[e0] = (f32x2v){b0r + u2r, b0i + u2i}; z[e2] = (f32x2v){b0r - u2r, b0i - u2i};
            z[e1] = (f32x2v){b1r + w3i, b1i - w3r}; z[e3] = (f32x2v){b1r - w3i, b1i + w3r};
        }
        __syncthreads();
    }
    const float sc = 0.5f / sqrtf((float)n * 64.f);
    for (int k = tid; k < n; k += 512) {
        const int k2 = (n - k) & (n - 1);
        const f32x2v za = z[FSW(k)], zb = z[FSW(k2)]; const float zr = za.x, zi = za.y, wr_ = zb.x, wi_ = zb.y;
        const float ar = (zr + wr_) * sc, ai = (zi - wi_) * sc, br = (zi + wi_) * sc, bi = (wr_ - zr) * sc;
        __hip_atomic_store((unsigned long long*)(ut + k), (unsigned long long)pk2(ar, ai) | ((unsigned long long)pk2(br, bi) << 32), __ATOMIC_RELAXED, __HIP_MEMORY_SCOPE_AGENT);
    }
    asm volatile("s_waitcnt vmcnt(0)" ::: "memory");
    __syncthreads();
}

template <int KG>
__device__ __forceinline__ void group_linear(const LAS bf16* At, int lda, const bf16* W, int g, int rh, int lane, f32x16& acc0, f32x16& acc1) {
    const int r32 = lane & 31, hi = lane >> 5;
    acc0 = f32x16{}; acc1 = f32x16{};
    const LAS bf16* ap = At + (rh * 32 + r32) * lda + g * KG + hi * 8;
    const bf16* wp = W + (size_t)g * 64 * KG + (size_t)r32 * KG + hi * 8;
#pragma unroll
    for (int ks = 0; ks < KG / 16; ++ks) {
        const bf16x8 af = *(const LAS bf16x8*)(ap + ks * 16);
        const bf16x8 b0 = *(const bf16x8*)(wp + ks * 16), b1 = *(const bf16x8*)(wp + 32 * KG + ks * 16);
        acc0 = __builtin_amdgcn_mfma_f32_32x32x16_bf16(af, b0, acc0, 0, 0, 0);
        acc1 = __builtin_amdgcn_mfma_f32_32x32x16_bf16(af, b1, acc1, 0, 0, 0);
    }
}

__device__ __forceinline__ void gated_store_tile(LAS float* X, const f32x16& a0, const f32x16& a1, const bf16* gate, int gstride, bf16* yout, const float* sc, int lane) {
    const int r32 = lane & 31, hi = lane >> 5, ch = lane & 7, rl = lane >> 3;
    u32x4 gt[4];
#pragma unroll
    for (int i = 0; i < 4; ++i) gt[i] = *(const u32x4*)(gate + (size_t)(rl + 8 * i) * gstride + ch * 8);
#pragma unroll
    for (int r = 0; r < 16; ++r) { const int row = att::crow(r, hi); X[row * 64 + r32] = a0[r]; X[row * 64 + 32 + r32] = a1[r]; }
    f32x4 sa = {1.f, 1.f, 1.f, 1.f}, sb = {1.f, 1.f, 1.f, 1.f};
    if (sc) { sa = *(const f32x4*)(sc + ch * 8); sb = *(const f32x4*)(sc + ch * 8 + 4); }
#pragma unroll
    for (int i = 0; i < 4; ++i) {
        const LAS float* xp = X + (rl + 8 * i) * 64 + ch * 8;
        const f32x4 xa = *(const LAS f32x4*)xp * sa, xb = *(const LAS f32x4*)(xp + 4) * sb;
        const u32x4 gq = gt[i];
        u32x4 w;
        w.x = pk2(xa[0] * silu_f(bflo(gq.x)), xa[1] * silu_f(bfhi(gq.x))); w.y = pk2(xa[2] * silu_f(bflo(gq.y)), xa[3] * silu_f(bfhi(gq.y)));
        w.z = pk2(xb[0] * silu_f(bflo(gq.z)), xb[1] * silu_f(bfhi(gq.z))); w.w = pk2(xb[2] * silu_f(bflo(gq.w)), xb[3] * silu_f(bfhi(gq.w)));
        st_wt16(yout + (size_t)(rl + 8 * i) * 1024 + ch * 8, w);
    }
}

template <int W>
__device__ __forceinline__ void pool_strip(const LAS unsigned* B2, LAS bf16* Ao, int tb, int Lr) {
    constexpr int LO = W / 2, HI = W - LO - 1, K0 = 8 - LO, NV = 16 + W - 1;
    unsigned v[NV];
#pragma unroll
    for (int k = 0; k < NV; ++k) v[k] = B2[(K0 + k) * 128];
    float s0 = 0.f, s1 = 0.f;
#pragma unroll
    for (int k = 0; k < W; ++k) { s0 += bflo(v[k]); s1 += bfhi(v[k]); }
#pragma unroll
    for (int i = 0; i < 16; ++i) { const int t = tb + i;
        const int a = max(t - LO, 0), e = min(t + HI, Lr - 1);
        const unsigned c = v[LO + i];
        const float inv = __builtin_amdgcn_rcpf((float)(e - a + 1));
        *(LAS unsigned*)(Ao + i * 264) = pk2(s0 * inv - bflo(c), s1 * inv - bfhi(c));
        if (i < 15) { s0 += bflo(v[i + W]) - bflo(v[i]); s1 += bfhi(v[i + W]) - bfhi(v[i]); } }
}
__device__ __forceinline__ unsigned pool_item(Frame& F, const bf16* PB, bf16* Y, int rb, int Lr, int t0, const bf16* WPl, const float* pscale, gu32* tkq, gu32* pub) {
    LAS bf16* Braw = (LAS bf16*)F.lds;
    LAS bf16* At = (LAS bf16*)(F.lds + 40960);
    const int tid = F.tid;
    for (int i = tid; i < 80 * 32; i += 512) { const int rr = i >> 5, ch = i & 31; const int t = t0 - 8 + rr;
        u32x4 v = {0u, 0u, 0u, 0u}; if (t >= 0 && t < Lr) v = *(const u32x4*)(PB + (size_t)(rb + t) * IN_W + B_OFF + ch * 8);
        *(LAS u32x4*)(Braw + rr * 256 + ch * 8) = v; }
    asm volatile("s_waitcnt vmcnt(0)" ::: "memory");
    __syncthreads();
    if (pub && F.tid == 0) (void)__hip_atomic_fetch_add(pub, 1u, __ATOMIC_RELAXED, __HIP_MEMORY_SCOPE_AGENT);
    {
      const int cp = (F.wave >> 1) * 32 + (F.lane & 31), rq = (F.wave & 1) * 2 + (F.lane >> 5), col = 2 * cp;
      const LAS unsigned* B2 = (const LAS unsigned*)Braw + cp + (rq * 16) * 128;
      LAS bf16* Ao = At + (rq * 16) * 264 + col;
      const int tb = t0 + rq * 16;
      switch (F.wave >> 1) {
        case 0: pool_strip<2>(B2, Ao, tb, Lr); break;
        case 1: pool_strip<4>(B2, Ao, tb, Lr); break;
        case 2: pool_strip<8>(B2, Ao, tb, Lr); break;
        default: pool_strip<16>(B2, Ao, tb, Lr); break;
      } }
    __syncthreads();
    const int g = F.wave >> 1, rh = F.wave & 1, r32 = F.lane & 31, hi = F.lane >> 5;
    f32x16 a0, a1; group_linear<64>(At, 264, WPl, g, rh, F.lane, a0, a1);
    (void)r32; (void)hi;
    __syncthreads();
    unsigned nxt_ = 0u; if (F.tid == 0) nxt_ = __hip_atomic_fetch_add(tkq, 1u, __ATOMIC_RELAXED, __HIP_MEMORY_SCOPE_AGENT);
    { const size_t r0 = (size_t)(rb + t0 + rh * 32);
      gated_store_tile((LAS float*)F.lds + F.wave * 2048, a0, a1, PB + r0 * IN_W + G_OFF + 256 + g * 64, IN_W, Y + r0 * 1024 + 256 + g * 64, pscale + g * 64, F.lane); }
    __syncthreads();
    return nxt_;
}

__device__ __forceinline__ unsigned flin_item(Frame& F, const bf16* PB, const bf16* U, bf16* Y, int row0, const bf16* WFl, gu32* tkq, gu32* pub) {
    LAS bf16* At = (LAS bf16*)F.lds;
    const int tid = F.tid;
    {
      const bool cxs = row0 >= M; const int rr0 = cxs ? row0 - M : row0;
      const int bseg = cxs ? (rr0 >> 8) : (rr0 >> 13), k0 = cxs ? (rr0 & 255) : (rr0 & (L - 1)), nseg = cxs ? CL : L;
      const int p = tid >> 2, q = tid & 3;
      const u32x2* up = (const u32x2*)U + (cxs ? AT_CTX : 0) + ((size_t)(bseg * 128 + p)) * nseg + k0 + q * 16;
      u32x4 v[8];
#pragma unroll
      for (int i = 0; i < 8; ++i) v[i] = *(const u32x4*)(up + 2 * i);
#pragma unroll
      for (int i = 0; i < 8; ++i) { *(LAS u32x2*)(At + (q * 16 + 2 * i) * 520 + p * 4) = (u32x2){v[i].x, v[i].y}; *(LAS u32x2*)(At + (q * 16 + 2 * i + 1) * 520 + p * 4) = (u32x2){v[i].z, v[i].w}; } }
    asm volatile("s_waitcnt vmcnt(0)" ::: "memory");
    __syncthreads();
    if (pub && F.tid == 0) (void)__hip_atomic_fetch_add(pub, 1u, __ATOMIC_RELAXED, __HIP_MEMORY_SCOPE_AGENT);
    const int g = F.wave >> 1, rh = F.wave & 1, r32 = F.lane & 31, hi = F.lane >> 5;
    f32x16 a0, a1; group_linear<128>(At, 520, WFl, g, rh, F.lane, a0, a1);
    (void)r32; (void)hi;
    __syncthreads();
    unsigned nxt_ = 0u; if (F.tid == 0) nxt_ = __hip_atomic_fetch_add(tkq, 1u, __ATOMIC_RELAXED, __HIP_MEMORY_SCOPE_AGENT);
    { const size_t r0 = (size_t)(row0 + rh * 32);
      gated_store_tile((LAS float*)F.lds + F.wave * 2048, a0, a1, PB + r0 * IN_W + G_OFF + g * 64, IN_W, Y + r0 * 1024 + g * 64, nullptr, F.lane); }
    __syncthreads();
    return nxt_;
}


__device__ __forceinline__ void ctx_load(Frame& F, const bf16* A, const bf16* Bt, int rb, int cg, bf16x8 (&a)[8], bf16x8 (&b0)[8], bf16x8 (&b1)[8]) {
    const int lane = F.lane, r32 = lane & 31, hi = lane >> 5, k0 = F.wave * 128;
    const bf16* ap = A + (size_t)(rb * 32 + r32) * D + k0 + hi * 8;
    const bf16* bp = Bt + (size_t)(cg * 64 + r32) * D + k0 + hi * 8;
#pragma unroll
    for (int ks = 0; ks < 8; ++ks) { a[ks] = *(const bf16x8*)(ap + ks * 16); b0[ks] = *(const bf16x8*)(bp + ks * 16); b1[ks] = *(const bf16x8*)(bp + 32 * D + ks * 16); }
}
__device__ __forceinline__ void ctx_mma(const bf16x8 (&a)[8], const bf16x8 (&b0)[8], const bf16x8 (&b1)[8], f32x16& c0, f32x16& c1) {
    c0 = f32x16{}; c1 = f32x16{};
#pragma unroll
    for (int ks = 0; ks < 8; ++ks) { c0 = __builtin_amdgcn_mfma_f32_32x32x16_bf16(a[ks], b0[ks], c0, 0, 0, 0); c1 = __builtin_amdgcn_mfma_f32_32x32x16_bf16(a[ks], b1[ks], c1, 0, 0, 0); }
}
template <int MODE>
__device__ __forceinline__ void ctx_tail(Frame& F, const f32x16& c0, const f32x16& c1, int rb, int cg, bf16* PBc, const float* qkg, const float* res, float* outp, const float* gate, unsigned char* KTp, unsigned char* VTp, unsigned* ATp);
template <int MODE>
__device__ __forceinline__ void ctx_tile(Frame& F, const bf16* A, const bf16* Bt, int rb, int cg, bf16* PBc, const float* qkg, const float* res, float* outp, const float* gate, unsigned char* KTp = nullptr, unsigned char* VTp = nullptr, unsigned* ATp = nullptr) {
    bf16x8 a[8], b0[8], b1[8];
    ctx_load(F, A, Bt, rb, cg, a, b0, b1);
    f32x16 c0, c1; ctx_mma(a, b0, b1, c0, c1);
    ctx_tail<MODE>(F, c0, c1, rb, cg, PBc, qkg, res, outp, gate, KTp, VTp, ATp);
}
template <int MODE>
__device__ __forceinline__ void ctx_tail(Frame& F, const f32x16& c0, const f32x16& c1, int rb, int cg, bf16* PBc, const float* qkg, const float* res, float* outp, const float* gate, unsigned char* KTp, unsigned char* VTp, unsigned* ATp) {
    const int lane = F.lane, r32 = lane & 31, hi = lane >> 5;
    LAS float* red = (LAS float*)F.lds + F.wave * 2048;
#pragma unroll
    for (int r = 0; r < 16; ++r) { const int row = att2::crow(r, hi); red[row * 64 + r32] = c0[r]; red[row * 64 + 32 + r32] = c1[r]; }
    __syncthreads();
    const int row = F.tid >> 4, c4 = (F.tid & 15) * 4;
    f32x4 v = {0.f, 0.f, 0.f, 0.f};
#pragma unroll
    for (int w = 0; w < 8; ++w) v += *(const LAS f32x4*)((LAS float*)F.lds + w * 2048 + row * 64 + c4);
    const int grow = rb * 32 + row;
    if (MODE == 0) {
        if (cg >= 8 && cg < 24) {
            const int part = cg >= 16 ? 1 : 0;
            float ss = (v[0] * v[0] + v[1] * v[1]) + (v[2] * v[2] + v[3] * v[3]);
            ss += sxor<1>(ss); ss += sxor<2>(ss); ss += sxor<4>(ss); ss += sxor<8>(ss);
            const float rs = __builtin_amdgcn_rsqf(ss * (1.f / 64.f) + EPS) * (part ? 1.f : 0.125f * LOG2E);
            const f32x4 g = *(const f32x4*)(qkg + part * 64 + c4);
            v = v * rs * g;
        }
        const u32x2 w2 = (u32x2){pk2(v[0], v[1]), pk2(v[2], v[3])};
        if (cg >= 16 && cg < 32) {
            const int bb = grow >> 8, kidx = grow & 255, g = (cg - 16) & 7, hh = g >> 1;
            const size_t blk = ((size_t)((bb * 4 + hh) * NTILE + (kidx >> 6))) * 16384; const int key = kidx & 63;
            if (cg < 24) *(u32x2*)(KTp + blk + (g & 1) * 8192 + (c4 >> 3) * 1024 + key * 16 + (c4 & 7) * 2) = w2;
            else { const int dv = (g & 1) * 64 + c4; *(u32x2*)(VTp + blk + (dv >> 5) * 4096 + key * 64 + (dv & 31) * 2) = w2; }
        } else if (cg < 4) {
            unsigned* ap = ATp + AT_CTX + ((size_t)((grow >> 8) * 128 + cg * 32 + (c4 >> 1))) * CL + (grow & 255);
            ap[0] = w2.x; ap[CL] = w2.y;
        } else *(u32x2*)(PBc + (size_t)grow * IN_W + cg * 64 + c4) = w2;
    } else {
        const size_t off = (size_t)grow * D + cg * 64 + c4;
        const f32x4 o4 = *(const f32x4*)(res + off) + mod4(gate + cg * 64 + c4) * v;
        st_wt16(outp + off, __builtin_bit_cast(u32x4, o4));
        asm volatile("s_waitcnt vmcnt(0)" ::: "memory");
    }
    __syncthreads();
}

__global__ void __launch_bounds__(NWAVES * 64, 2) mk_fwd(Args args) {
    extern __shared__ __attribute__((aligned(16))) unsigned char lds[];
    {
        LAS unsigned* z = (LAS unsigned*)((LAS unsigned char*)lds + LDSCTL_OFF);
        for (int u = threadIdx.x; u < (LDS_BYTES - LDSCTL_OFF) / 4; u += NWAVES * 64) z[u] = 0u;
    }
    __syncthreads();
    const int wave_id = __builtin_amdgcn_readfirstlane((int)threadIdx.x >> 6);
    volatile LAS unsigned* MISC = (volatile LAS unsigned*)((LAS unsigned char*)lds + MISC_OFF);
    const int lo = args.ph_lo, hi = args.ph_hi;
    XcdBarrier bar; bar.bar = (unsigned*)(args.ws + WS_CTL) + CW_BAR; bar.x = 0; bar.st = nullptr;
    if (hi - lo > 1) bar = xcd_barrier_post((unsigned*)(args.ws + WS_CTL) + CW_BAR, MISC + 8);

#pragma unroll 1
    for (int ph = lo; ph < hi; ++ph) {
        const int Gd = gridDim.x, vcu = (Gd % 8 == 0) ? ((int)blockIdx.x % 8) * (Gd / 8) + (int)blockIdx.x / 8 : (int)blockIdx.x;
#define MKFRAME(F) Frame F; { int ln_; asm volatile("v_mbcnt_lo_u32_b32 %0, -1, 0\n\tv_mbcnt_hi_u32_b32 %0, -1, %0" : "=v"(ln_)); F.lane = ln_; F.wave = wave_id; F.tid = wave_id * 64 + ln_; F.lds = (LAS unsigned char*)lds; { int g_ = Gd, v_ = vcu; asm volatile("" : "+s"(g_), "+s"(v_)); F.G = g_; F.vcu = v_; } }
        const __attribute__((address_space(4))) Args* ka = (const __attribute__((address_space(4))) Args*)__builtin_amdgcn_kernarg_segment_ptr(); asm volatile("" : "+s"(ka));
        unsigned char* ws = ka->ws; asm volatile("" : "+s"(ws));
        const int l = ph == 0 ? 0 : (ph - 1) / 5, kind = ph == 0 ? 0 : 1 + (ph - 1) % 5;
        const bool upd = l < DEPTH - 1;
        float* out = ka->out;
        const float* xin = l == 0 ? ka->in[0] : out;
        const float* cin = l == 0 ? ka->in[2] : (const float*)(ws + WS_CTX1);
        const float* mod = (const float*)(ws + WS_MOD) + l * 3 * 3072;
        bf16* PB = (bf16*)(ws + WS_PB); bf16* Y = (bf16*)(ws + WS_Y); bf16* U = (bf16*)(ws + WS_U);
        if (kind == 0) {
            MKFRAME(F);
            phase_mod(F, ka, ws);
            __syncthreads();
            phase_prep(F, ka, ws);
            asm volatile("s_waitcnt vmcnt(0)" ::: "memory");
            __syncthreads();
            if (F.tid == 0) (void)__hip_atomic_fetch_add((gu32*)(ws + WS_CTL) + SEAM_PREPCNT, 1u, __ATOMIC_RELAXED, __HIP_MEMORY_SCOPE_AGENT);
        } else if (kind == 1) {
            MKFRAME(F);
            if (l == 0) { if (F.tid == 0) seam_wait_ge((gu32*)(ws + WS_CTL) + SEAM_MODCNT, (unsigned)(DEPTH * 48 * 4)); asm volatile("" ::: "memory"); __syncthreads(); }
            if (l == 0) phase_normmod<true>(F, xin, cin, ka->in[4] + l * D, mod, (bf16*)(ws + WS_H), (gu32*)(ws + WS_CTL) + 16 * 65 * l);
            else phase_normmod_jobs(F, MISC, xin, cin, ka->in[4] + l * D, mod, (bf16*)(ws + WS_H), (gu32*)(ws + WS_CTL) + 16 * 65 * l, (gu32*)(ws + WS_CTL));
        } else if (kind == 2) {
            MKFRAME(F);
            pg8::Gemm g{(const bf16*)(ws + WS_H), (const bf16*)(ws + WS_WIN) + (size_t)l * IN_W * D, M, IN_W, D}; pg8::StaticOrder S; S.init(M, IN_W, F.G, (int)blockIdx.x);
            pg8::EpiIn E{PB, ka->in[11] + l * 128, (const float*)(ws + WS_ROPE), ws + WS_KT, ws + WS_VT, (unsigned*)(ws + WS_AT)};
            {
                if (l == 0 && F.tid == 0) seam_wait_ge((gu32*)(ws + WS_CTL) + SEAM_PREPCNT, (unsigned)F.G);
                if (l > 0 && F.tid == 0) seam_wait_ge((gu32*)(ws + WS_CTL) + SEAM_MIXDONE, (unsigned)F.G);
                { pg8::Unit u_; u_.pm = 0; u_.pn = 0;
#pragma unroll 1
                  for (int i = 0; S.next(i, u_); ++i) { gu32* f_ = (gu32*)(ws + WS_CTL) + 16 * 65 * l + SEAM_HCNT(u_.pm); if (F.tid == 0) seam_wait_ge(f_, 32u); } }
                asm volatile("" ::: "memory");
                __syncthreads();
            }
            pg8::gemm_phase<pg8::EpiIn, pg8::StaticOrder, true, true>(F.lds + RING_OFF, g, S, E, F.tid);
            { if (F.tid == 0) seam_wait_ge((gu32*)(ka->ws + WS_CTL) + 16 * 65 * l + SEAM_CCNT, (unsigned)(MT - M)); asm volatile("" ::: "memory"); __syncthreads(); }
            { const int ncg = upd ? 48 : 16, cg0 = upd ? 0 : 16;
              const bf16* Hc = (const bf16*)(ws + WS_H) + (size_t)M * D; const bf16* Wl = (const bf16*)(ws + WS_WIN) + (size_t)l * IN_W * D;
              if (F.vcu < 16 * ncg) {
                  bf16x8 a[8], b0[8], b1[8];
                  ctx_load(F, Hc, Wl, F.vcu & 15, cg0 + (F.vcu >> 4), a, b0, b1);
#pragma unroll 1
                  for (int id = F.vcu; id < 16 * ncg; id += F.G) {
                      f32x16 c0, c1; ctx_mma(a, b0, b1, c0, c1);
                      const int nid = id + F.G;
                      if (nid < 16 * ncg) ctx_load(F, Hc, Wl, nid & 15, cg0 + (nid >> 4), a, b0, b1);
                      ctx_tail<0>(F, c0, c1, id & 15, cg0 + (id >> 4), PB + (size_t)M * IN_W, ka->in[11] + l * 128, nullptr, nullptr, nullptr, ws + WS_KT, ws + WS_VT, (unsigned*)(ws + WS_AT));
                  }
              } }
        } else if (kind == 3) {
        } else if (kind == 4) {
            {
                MKFRAME(F);
                const float* TW = (const float*)(ws + WS_TW);
                gu32* fcnt = (gu32*)(ws + WS_CTL) + CW_FFT + 64 * l;
                const int nfft = upd ? 512 : 256;
#pragma unroll 1
                for (int it = F.vcu; it < nfft; it += F.G) {
                    const bool cx = it >= 256; const int j = it & 255, b = j >> 7, p = j & 127;
                    const size_t eo = cx ? AT_CTX + (size_t)(b * 128 + p) * CL : (size_t)(b * 128 + p) * L;
                    if (cx) fft_item(F, (const unsigned*)(ws + WS_AT) + eo, 8, (u32x2*)(ws + WS_U) + eo, TW);
                    else fft13_item(F, (const unsigned*)(ws + WS_AT) + eo, (u32x2*)(ws + WS_U) + eo, TW);
                    if (F.tid == 0) __hip_atomic_fetch_add(fcnt, 1u, __ATOMIC_RELAXED, __HIP_MEMORY_SCOPE_AGENT);
                }
            }
            const int skip = ka->skip;
            const int nitem = (skip & 1) ? 0 : (upd ? 528 : 512);
#pragma unroll 1
            for (int it = vcu; it < nitem; it += Gd) {
                const bool cx = it >= 512;
                const int j = cx ? it - 512 : it, bh = cx ? (j >> 1) : (j >> 6), qb = cx ? (j & 1) : (j & 63);
                int t2; asm volatile("v_mbcnt_lo_u32_b32 %0, -1, 0\n\tv_mbcnt_hi_u32_b32 %0, -1, %0" : "=v"(t2)); t2 += wave_id * 64;
                const __attribute__((address_space(4))) Args* ka2 = ka; asm volatile("" : "+s"(ka2));
                unsigned char* ws2 = ka2->ws; asm volatile("" : "+s"(ws2));
                att2::attn_item((const bf16*)(ws2 + WS_PB), ws2 + WS_KT, ws2 + WS_VT, (bf16*)(ws2 + WS_Y), ka2->in[13] + l * 128, (const float*)(ws2 + WS_SC) + l * 4, cx, bh >> 2, bh & 3, qb * 128, (char*)lds + RING_OFF, t2);
            }
            const int ntile = (skip & 2) ? 0 : (upd ? 264 : 256);
            MKFRAME(F2);
            asm volatile("s_waitcnt vmcnt(0)" ::: "memory");
            {
                gu32* fcnt = (gu32*)(ka->ws + WS_CTL) + CW_FFT + 64 * l; const unsigned want = upd ? 512u : 256u;
                if (F2.tid == 0) { unsigned sp = 0; while (__hip_atomic_load(fcnt, __ATOMIC_RELAXED, __HIP_MEMORY_SCOPE_AGENT) < want) { __builtin_amdgcn_s_sleep(8); if (++sp > (1u << 22)) break; }
                    __builtin_amdgcn_fence(__ATOMIC_ACQUIRE, "agent"); asm volatile("s_waitcnt vmcnt(0)" ::: "memory"); }
                __syncthreads();
                if (F2.tid == 0) {
                    for (int it = F2.vcu; it < nitem; it += F2.G) { const int blk = it < 512 ? ((it >> 8) * 32 + ((it & 63) >> 1)) : 64 + ((it - 512) >> 3);
                        (void)__hip_atomic_fetch_add((gu32*)(ka->ws + WS_CTL) + SEAM_YCNT(l, blk), 1u, __ATOMIC_RELAXED, __HIP_MEMORY_SCOPE_AGENT); } }
            }
            gu32* qcnt = (gu32*)(ka->ws + WS_CTL) + CW_Q + 64 * l;
            int prev = -1;
            if (F2.tid == 0) MISC[46] = __hip_atomic_fetch_add(qcnt, 1u, __ATOMIC_RELAXED, __HIP_MEMORY_SCOPE_AGENT);
#pragma unroll 1
            for (;;) {
                __syncthreads();
                const int it = __builtin_amdgcn_readfirstlane((int)MISC[46]);
                unsigned char* ws3 = ka->ws; asm volatile("" : "+s"(ws3));
                gu32* pub = nullptr;
                if (prev >= 0) { const int t_ = prev < ntile ? prev : prev - ntile; const int blk = t_ < 256 ? (t_ >> 2) : 64 + ((t_ - 256) >> 2); pub = (gu32*)(ws3 + WS_CTL) + SEAM_YCNT(l, blk); }
                __syncthreads();
                if (it >= 2 * ntile) {
                    asm volatile("s_waitcnt vmcnt(0)" ::: "memory");
                    __syncthreads();
                    if (pub && F2.tid == 0) (void)__hip_atomic_fetch_add(pub, 1u, __ATOMIC_RELAXED, __HIP_MEMORY_SCOPE_AGENT);
                    break; }
                prev = it;
                if (it < ntile) {
                    const bool cx = it >= 256; const int j = it - 256;
                    const int rb = cx ? M + (j >> 2) * CL : (it >> 7) * L, Lr = cx ? CL : L, t0 = cx ? (j & 3) * 64 : (it & 127) * 64;
                    const unsigned n_ = pool_item(F2, (bf16*)(ws3 + WS_PB), (bf16*)(ws3 + WS_Y), rb, Lr, t0, (const bf16*)(ws3 + WS_WP) + (size_t)l * 4 * 64 * 64, ka->in[10] + l * 256, qcnt, pub);
                    if (F2.tid == 0) MISC[46] = n_;
                } else {
                    const unsigned n_ = flin_item(F2, (const bf16*)(ws3 + WS_PB), (const bf16*)(ws3 + WS_U), (bf16*)(ws3 + WS_Y), (it - ntile) * 64, (const bf16*)(ws3 + WS_WF) + (size_t)l * 4 * 64 * 128, qcnt, pub);
                    if (F2.tid == 0) MISC[46] = n_; }
            }
        } else {
            MKFRAME(F);
            const int Mo = M;
            pg8::Gemm g{Y, (const bf16*)(ws + WS_WOUT) + (size_t)l * D * D, Mo, D, D};
            pg8::EpiResL E{xin, out, mod, L, F.lds + RING_OFF, upd ? 1 : 0};
            gu32* oq = (gu32*)(ws + WS_CTL) + CW_Q + 64 * l + 48;
            if (upd && F.tid == 0) (void)__hip_atomic_fetch_add((gu32*)(ws + WS_CTL) + SEAM_MIXDONE, 1u, __ATOMIC_RELAXED, __HIP_MEMORY_SCOPE_AGENT);
#pragma unroll 1
            for (;;) {
                if (F.tid == 0) MISC[46] = __hip_atomic_fetch_add(oq, 1u, __ATOMIC_RELAXED, __HIP_MEMORY_SCOPE_AGENT);
                __syncthreads();
                const int tk = __builtin_amdgcn_readfirstlane((int)MISC[46]);
                __syncthreads();
                if (tk >= (Mo / 256) * 4) break;
                pg8::OneUnit S; S.pm = tk >> 2; S.pn = tk & 3;
                if (F.tid == 0) seam_wait_ge((gu32*)(ws + WS_CTL) + SEAM_YCNT(l, S.pm), 16u);
                asm volatile("" ::: "memory");
                __syncthreads();
                pg8::gemm_phase<pg8::EpiResL, pg8::OneUnit, true, true>(F.lds + RING_OFF, g, S, E, F.tid);
                if (upd && F.tid == 0) (void)__hip_atomic_fetch_add((gu32*)(ws + WS_CTL) + SEAM_XCNT(S.pm), 1u, __ATOMIC_RELAXED, __HIP_MEMORY_SCOPE_AGENT);
            }
            if (upd) {
#pragma unroll 1
                for (int id = F.vcu; id < 256; id += F.G) { if (F.tid == 0) seam_wait_ge((gu32*)(ka->ws + WS_CTL) + SEAM_YCNT(l, 64 + ((id & 15) >> 3)), 16u); asm volatile("" ::: "memory"); __syncthreads(); ctx_tile<1>(F, Y + (size_t)M * D, (const bf16*)(ws + WS_WOUT) + (size_t)l * D * D, id & 15, id >> 4, nullptr, nullptr, cin, (float*)(ws + WS_CTX1), mod + 2 * 3072 + 2048);
                    if (F.tid == 0) (void)__hip_atomic_fetch_add((gu32*)(ka->ws + WS_CTL) + SEAM_CXCNT, 1u, __ATOMIC_RELAXED, __HIP_MEMORY_SCOPE_AGENT); } }
        }
        if (ph + 1 < hi && kind != 3 && kind != 1 && kind != 0 && kind != 4 && kind != 5) xcd_barrier(bar);
    }
#undef MKFRAME
}


extern "C" void kernel_launch(void* const* d_in, const int* in_sizes, int n_in, void* d_out, int out_size, void* d_ws, size_t ws_size, hipStream_t stream) {
    static int grid = 0;
    if (grid == 0) {
        if (n_in != 15 || out_size != M * D || ws_size < WS_END) { fprintf(stderr, "kernel_launch: unexpected shapes (n_in %d out %d ws %zu)\n", n_in, out_size, ws_size); grid = -1; return; }
        int dev = 0, cus = 0, per_cu = 0;
        if (hipGetDevice(&dev) != hipSuccess || hipDeviceGetAttribute(&cus, hipDeviceAttributeMultiprocessorCount, dev) != hipSuccess) { grid = -1; return; }
        if (hipFuncSetAttribute((const void*)mk_fwd, hipFuncAttributeMaxDynamicSharedMemorySize, LDS_BYTES) != hipSuccess) { fprintf(stderr, "kernel_launch: hipFuncSetAttribute failed\n"); grid = -1; return; }
        if (hipOccupancyMaxActiveBlocksPerMultiprocessor(&per_cu, (const void*)mk_fwd, NWAVES * 64, LDS_BYTES) != hipSuccess || per_cu < 1) { fprintf(stderr, "kernel_launch: occupancy query says %d\n", per_cu); per_cu = 1; }
        (void)hipGetLastError();
        grid = cus;
    }
    if (grid < 0) return;
    (void)hipMemsetAsync((char*)d_ws + WS_CTL, 0, CTL_ZERO_BYTES, stream);
    Args a; memset(&a, 0, sizeof a);
    for (int i = 0; i < 15; ++i) a.in[i] = (const float*)d_in[i];
    a.out = (float*)d_out; a.ws = (unsigned char*)d_ws;
#if MK_PER_PHASE
    for (int ph = 0; ph < NPH; ++ph) { a.ph_lo = ph; a.ph_hi = ph + 1; hipLaunchKernelGGL(mk_fwd, dim3(grid), dim3(NWAVES * 64), LDS_BYTES, stream, a); }
#else
    a.ph_lo = 0; a.ph_hi = NPH; hipLaunchKernelGGL(mk_fwd, dim3(grid), dim3(NWAVES * 64), LDS_BYTES, stream, a);
#endif
    const hipError_t le = hipPeekAtLastError();
    if (le != hipSuccess) fprintf(stderr, "kernel_launch: launch failed: %s\n", hipGetErrorName(le));
}
```

```cpp
#include <hip/hip_runtime.h>
#include <math.h>
#include <string.h>
#include <stdio.h>
#include <stdint.h>

#ifndef MK_PER_PHASE
#define MK_PER_PHASE 0
#endif

constexpr int D = 1024, NB = 2, L = 8192, DEPTH = 2, CL = 256;
constexpr int A_OFF = 0, B_OFF = 256, Q_OFF = 512, K_OFF = 1024, V_OFF = 1536, G_OFF = 2048, IN_W = 3072;
constexpr int M = NB * L, MC = NB * CL, MT = M + MC;
constexpr float EPS = 1e-6f;
constexpr float LOG2E = 1.4426950408889634f;
constexpr int NPH = 1 + 5 * DEPTH;

constexpr size_t MiB = 1u << 20, KiB = 1024;
constexpr size_t WS_CTL = 0, CTL_ZERO_BYTES = 64 * KiB;
constexpr size_t WS_MOD = 18 * MiB;
constexpr int MODQ = DEPTH * 3 * 3072;
constexpr size_t WS_SC = 1 * MiB + 96 * KiB;
constexpr size_t WS_ROPE = 1 * MiB + 128 * KiB;
constexpr size_t WS_TW = 1 * MiB + 256 * KiB;
constexpr size_t WS_WF = 1 * MiB + 512 * KiB;
constexpr size_t WS_WP = 1 * MiB + 768 * KiB;
constexpr size_t WS_WIN = 2 * MiB;
constexpr size_t WS_WOUT = 14 * MiB;
constexpr size_t WS_H = 20 * MiB;
constexpr size_t WS_PB = 54 * MiB;
constexpr size_t WS_U = 154 * MiB;
constexpr size_t WS_Y = 172 * MiB;
constexpr size_t WS_CTX1 = 206 * MiB;
constexpr size_t WS_KT = 208 * MiB;
constexpr size_t WS_VT = 226 * MiB;
constexpr size_t WS_AT = 244 * MiB;
constexpr size_t AT_CTX = (size_t)NB * 128 * L;
constexpr size_t WS_END = 253 * MiB;
constexpr int NTILE = (CL + L) / 64;

typedef unsigned short bf16;
#define LAS __attribute__((address_space(3)))
#define GAS __attribute__((address_space(1)))
typedef float f32x4 __attribute__((ext_vector_type(4)));
typedef float f32x16 __attribute__((ext_vector_type(16)));
typedef unsigned u32x4 __attribute__((ext_vector_type(4)));
typedef unsigned u32x2 __attribute__((ext_vector_type(2)));
typedef short bf16x8 __attribute__((ext_vector_type(8)));
typedef short s16x4 __attribute__((ext_vector_type(4)));

__device__ __forceinline__ float silu_f(float t) { return t * __builtin_amdgcn_rcpf(1.f + __expf(-t)); }
template <int MASK> __device__ __forceinline__ float sxor(float v) {
    return __builtin_bit_cast(float, __builtin_amdgcn_ds_swizzle(__builtin_bit_cast(int, v), (MASK << 10) | 0x1f));
}
__device__ __forceinline__ float half_swap_sum(float v) { unsigned a = __builtin_bit_cast(unsigned, v), b = a; asm volatile("" : "+v"(b)); auto rr = __builtin_amdgcn_permlane32_swap(a, b, false, false); unsigned r0 = rr[0], r1 = rr[1]; asm volatile("" : "+v"(r0), "+v"(r1)); return __builtin_bit_cast(float, r0) + __builtin_bit_cast(float, r1); }
__device__ __forceinline__ float half_swap_max(float v) { unsigned a = __builtin_bit_cast(unsigned, v), b = a; asm volatile("" : "+v"(b)); auto rr = __builtin_amdgcn_permlane32_swap(a, b, false, false); unsigned r0 = rr[0], r1 = rr[1]; asm volatile("" : "+v"(r0), "+v"(r1)); return fmaxf(__builtin_bit_cast(float, r0), __builtin_bit_cast(float, r1)); }
template <int CTRL> __device__ __forceinline__ float dpp_f(float v) { return __builtin_bit_cast(float, __builtin_amdgcn_update_dpp(0, __builtin_bit_cast(int, v), CTRL, 0xf, 0xf, true)); }
__device__ __forceinline__ float row_swap_sum(float v) { unsigned a = __builtin_bit_cast(unsigned, v), b = a; asm volatile("" : "+v"(b)); auto rr = __builtin_amdgcn_permlane16_swap(a, b, false, false); unsigned r0 = rr[0], r1 = rr[1]; asm volatile("" : "+v"(r0), "+v"(r1)); return __builtin_bit_cast(float, r0) + __builtin_bit_cast(float, r1); }
__device__ __forceinline__ float sum32(float v) { v += dpp_f<0xB1>(v); v += dpp_f<0x4E>(v); v += dpp_f<0x141>(v); v += dpp_f<0x140>(v); return row_swap_sum(v); }
__device__ __forceinline__ float wave_sum(float v) { return half_swap_sum(sum32(v)); }
__device__ __forceinline__ float wave_max(float v) {
    v = fmaxf(v, sxor<16>(v)); v = fmaxf(v, sxor<8>(v)); v = fmaxf(v, sxor<4>(v)); v = fmaxf(v, sxor<2>(v)); v = fmaxf(v, sxor<1>(v));
    return half_swap_max(v);
}
__device__ __forceinline__ unsigned f2bf(float f) { unsigned u = __builtin_bit_cast(unsigned, f); return (u + 0x7fffu + ((u >> 16) & 1u)) >> 16; }
__device__ __forceinline__ unsigned pk2(float lo, float hi) { return f2bf(lo) | (f2bf(hi) << 16); }
__device__ __forceinline__ float bflo(unsigned u) { return __builtin_bit_cast(float, u << 16); }
__device__ __forceinline__ float bfhi(unsigned u) { return __builtin_bit_cast(float, u & 0xffff0000u); }
__device__ __forceinline__ float bf2f(bf16 h) { return __builtin_bit_cast(float, (unsigned)h << 16); }

__device__ __forceinline__ f32x4 mod4(const float* p) { return (*(const f32x4*)p + *(const f32x4*)(p + MODQ)) + (*(const f32x4*)(p + 2 * MODQ) + *(const f32x4*)(p + 3 * MODQ)); }

__device__ __forceinline__ void st_wt16(void* p, u32x4 v) { asm volatile("global_store_dwordx4 %0, %1, off sc1\n\ts_nop 1" :: "v"(p), "v"(v) : "memory"); }
namespace pg8 {
#define PG8_LAS __attribute__((address_space(3)))
typedef unsigned short bf16_t;
constexpr int BM = 256, BK = 64, HALF = 128, HTB = HALF * BK * 2, STAGE_BYTES = 8 * HTB, NXCD = 8, WGM = 8;
__host__ __device__ __forceinline__ int lds_byte(int r, int c) { const int st = (r >> 4) * 2 + (c >> 5), rr = r & 15, cc = c & 31, ob = rr * 64 + cc * 2; return st * 1024 + (ob ^ (((ob >> 9) & 1) << 5)); }
__host__ __device__ __forceinline__ void stage_rc(int b, int& R, int& C) { const int st = b / 1024, sb = b % 1024, swz = sb ^ (((sb >> 9) & 1) << 5); R = (st >> 1) * 16 + swz / 64; C = (st & 1) * 32 + (swz % 64) / 2; }
__host__ __device__ __forceinline__ int perm32(int rho) { const int n = rho >> 4, i = rho & 15; return 8 * (i >> 2) + 4 * n + (i & 3); }
struct Unit { int pm, pn; };
struct Gemm { const bf16_t* A; const bf16_t* Bt; int M, N, K; };
struct StaticOrder {
    int nM, nN, nwg, G, c;
    __host__ __device__ void init(int M_, int N_, int G_, int c_) { nM = M_ / BM; nN = N_ / BM; nwg = nM * nN; G = G_; c = c_; }
    __host__ __device__ bool next(int i, Unit& u) const {
        const long Lx = (long)i * G + c; if (Lx >= nwg) return false;
        int wgid = (int)Lx; { const int q = nwg / NXCD, r = nwg % NXCD, xcd = wgid % NXCD, off = wgid / NXCD; wgid = (xcd < r ? xcd * (q + 1) : r * (q + 1) + (xcd - r) * q) + off; }
        const int nig = WGM * nN, gid = wgid / nig, fm = gid * WGM, gsz = (nM - fm) < WGM ? (nM - fm) : WGM;
        u.pm = fm + ((wgid % nig) % gsz); u.pn = (wgid % nig) / gsz; return true;
    }
    __device__ __forceinline__ void a_ready(const Unit&) const {}
    __device__ __forceinline__ void done(const Unit&) const {}
};
__device__ __forceinline__ unsigned cvt_pk_bf16(float lo, float hi) { unsigned r; asm volatile("v_cvt_pk_bf16_f32 %0, %1, %2" : "=v"(r) : "v"(lo), "v"(hi)); return r; }
struct EpiBf16 {
    static constexpr bool PERM = true, AFTER_DRAIN = false, GROUP64 = false;
    bf16_t* O; int ldc;
    __device__ __forceinline__ void operator()(const f32x4 (&acc)[2][2][4][2], const Unit& u, int wr, int wc, int fr, int fq) const {
        const int row0 = u.pm * BM + wr * 64 + fr, col0 = u.pn * BM + wc * 32 + 8 * fq;
#pragma unroll
        for (int ai = 0; ai < 2; ++ai)
#pragma unroll
            for (int m = 0; m < 4; ++m) { bf16_t* rowp = O + (size_t)(row0 + ai * HALF + m * 16) * ldc + col0;
#pragma unroll
                for (int bj = 0; bj < 2; ++bj) { const f32x4 v0 = acc[ai][bj][m][0], v1 = acc[ai][bj][m][1];
                    u32x4 w; w.x = cvt_pk_bf16(v0[0], v0[1]); w.y = cvt_pk_bf16(v0[2], v0[3]); w.z = cvt_pk_bf16(v1[0], v1[1]); w.w = cvt_pk_bf16(v1[2], v1[3]);
                    *(u32x4*)(rowp + bj * HALF) = w; } }
    }
};

struct EpiIn {
    static constexpr bool PERM = true, AFTER_DRAIN = false, GROUP64 = true;
    bf16_t* O; const float* qkg; const float* rope; unsigned char* KT; unsigned char* VT; unsigned* AT;
    static __device__ __forceinline__ size_t kv_block(int row, int h, int& key) { const int b = row >> 13, kidx = CL + (row & (L - 1)); key = kidx & 63; return ((size_t)((b * 4 + h) * NTILE + (kidx >> 6))) * 16384; }
    __device__ __forceinline__ void operator()(const f32x4 (&acc)[2][2][4][2], const Unit& u, int wr, int wc, int fr_, int fq_) const {
        int ln_; asm volatile("v_mbcnt_lo_u32_b32 %0, -1, 0\n\tv_mbcnt_hi_u32_b32 %0, -1, %0" : "=v"(ln_)); const int fr = ln_ & 15, fq = ln_ >> 4; (void)fr_; (void)fq_;
        const int row0 = u.pm * BM + wr * 64 + fr, col0 = u.pn * BM + wc * 64 + 8 * fq;
        if (u.pn == 6 || u.pn == 7) {
            const int g64 = (u.pn - 6) * 4 + wc, h = g64 >> 1;
#pragma unroll
            for (int ai = 0; ai < 2; ++ai)
#pragma unroll
                for (int m = 0; m < 4; ++m) { int key; const size_t blk = kv_block(row0 + ai * HALF + m * 16, h, key);
#pragma unroll
                    for (int bj = 0; bj < 2; ++bj) { const f32x4 v0 = acc[ai][bj][m][0], v1 = acc[ai][bj][m][1];
                        u32x4 w; w.x = cvt_pk_bf16(v0[0], v0[1]); w.y = cvt_pk_bf16(v0[2], v0[3]); w.z = cvt_pk_bf16(v1[0], v1[1]); w.w = cvt_pk_bf16(v1[2], v1[3]);
                        *(u32x4*)(VT + blk + ((g64 & 1) * 2 + bj) * 4096 + key * 64 + fq * 16) = w; } }
            return;
        }
        if (u.pn == 0) {
#pragma unroll
            for (int ai = 0; ai < 2; ++ai)
#pragma unroll
                for (int m = 0; m < 4; ++m) { const int row = row0 + ai * HALF + m * 16; unsigned* ap = AT + ((size_t)((row >> 13) * 128 + 32 * wc + 4 * fq)) * L + (row & (L - 1));
#pragma unroll
                    for (int bj = 0; bj < 2; ++bj) { const f32x4 v0 = acc[ai][bj][m][0], v1 = acc[ai][bj][m][1]; unsigned* a2 = ap + (size_t)(16 * bj) * L;
                        a2[0] = cvt_pk_bf16(v0[0], v0[1]); a2[L] = cvt_pk_bf16(v0[2], v0[3]); a2[2 * L] = cvt_pk_bf16(v1[0], v1[1]); a2[3 * L] = cvt_pk_bf16(v1[2], v1[3]); } }
            return;
        }
        if (u.pn < 2 || u.pn >= 6) {
#pragma unroll
            for (int ai = 0; ai < 2; ++ai)
#pragma unroll
                for (int m = 0; m < 4; ++m) { bf16_t* rowp = O + (size_t)(row0 + ai * HALF + m * 16) * IN_W + col0;
#pragma unroll
                    for (int bj = 0; bj < 2; ++bj) { const f32x4 v0 = acc[ai][bj][m][0], v1 = acc[ai][bj][m][1];
                        u32x4 w; w.x = cvt_pk_bf16(v0[0], v0[1]); w.y = cvt_pk_bf16(v0[2], v0[3]); w.z = cvt_pk_bf16(v1[0], v1[1]); w.w = cvt_pk_bf16(v1[2], v1[3]);
                        *(u32x4*)(rowp + bj * 32) = w; } }
            return;
        }
        const int part = u.pn >= 4 ? 1 : 0;
        const bool isc = u.pm >= 64;
        const float qs = part ? 1.f : 0.125f * LOG2E;
        const int hi = fq >> 1, jb = 8 * (fq & 1);
        f32x4 gv[2][2];
#pragma unroll
        for (int bj = 0; bj < 2; ++bj)
#pragma unroll
            for (int n = 0; n < 2; ++n) gv[bj][n] = *(const f32x4*)(qkg + part * 64 + 32 * bj + 8 * fq + 4 * n);
#pragma unroll
        for (int ai = 0; ai < 2; ++ai)
#pragma unroll
            for (int m = 0; m < 4; ++m) {
                const int row = row0 + ai * HALF + m * 16;
                float ss = 0.f;
#pragma unroll
                for (int bj = 0; bj < 2; ++bj)
#pragma unroll
                    for (int n = 0; n < 2; ++n) { const f32x4 x = acc[ai][bj][m][n]; ss += (x[0] * x[0] + x[1] * x[1]) + (x[2] * x[2] + x[3] * x[3]); }
                ss += sxor<16>(ss); ss = half_swap_sum(ss);
                const float rs = __builtin_amdgcn_rsqf(ss * (1.f / 64.f) + EPS);
                f32x4 y[2][2];
#pragma unroll
                for (int bj = 0; bj < 2; ++bj)
#pragma unroll
                    for (int n = 0; n < 2; ++n) y[bj][n] = acc[ai][bj][m][n] * rs * gv[bj][n];
                if (!isc) {
                    const int t = row & (L - 1);
                    f32x4 tab[2][2][2];
#pragma unroll
                    for (int bj = 0; bj < 2; ++bj) { const float* rp = rope + ((bj ? (t & 63) : (t >> 6)) * 16 + jb) * 2;
#pragma unroll
                        for (int n = 0; n < 2; ++n) { tab[bj][n][0] = *(const f32x4*)(rp + 8 * n); tab[bj][n][1] = *(const f32x4*)(rp + 8 * n + 4); } }
#pragma unroll
                    for (int bj = 0; bj < 2; ++bj) {
#pragma unroll
                        for (int n = 0; n < 2; ++n) {
                            const f32x4 ca = tab[bj][n][0], cb = tab[bj][n][1];
                            const float cs[4] = {ca[0], ca[2], cb[0], cb[2]}, sn[4] = {ca[1], ca[3], cb[1], cb[3]};
#pragma unroll
                            for (int e = 0; e < 4; ++e) {
                                const float yv = y[bj][n][e];
                                unsigned a_ = __builtin_bit_cast(unsigned, yv), b_ = a_; asm volatile("" : "+v"(b_));
                                auto rr = __builtin_amdgcn_permlane32_swap(a_, b_, false, false); unsigned r0 = rr[0], r1 = rr[1]; asm volatile("" : "+v"(r0), "+v"(r1));
                                const float other = __builtin_bit_cast(float, hi ? r0 : r1);
                                y[bj][n][e] = hi ? (yv * cs[e] + other * sn[e]) : (yv * cs[e] - other * sn[e]);
                            }
                        }
                    }
                }
                bf16_t* rowp = O + (size_t)row * IN_W + col0;
                int key = 0; size_t blk = 0; const int g64 = (u.pn & 1) * 4 + wc;
                if (part) blk = kv_block(row, g64 >> 1, key);
#pragma unroll
                for (int bj = 0; bj < 2; ++bj) { const f32x4 v0 = y[bj][0] * qs, v1 = y[bj][1] * qs;
                    u32x4 w; w.x = cvt_pk_bf16(v0[0], v0[1]); w.y = cvt_pk_bf16(v0[2], v0[3]); w.z = cvt_pk_bf16(v1[0], v1[1]); w.w = cvt_pk_bf16(v1[2], v1[3]);
                    if (part) *(u32x4*)(KT + blk + (g64 & 1) * 8192 + (4 * bj + fq) * 1024 + key * 16) = w;
                    else *(u32x4*)(rowp + bj * 32) = w; }
            }
    }
};
struct OneUnit {
    int pm, pn;
    __host__ __device__ bool next(int i, Unit& u) const { if (i != 0) return false; u.pm = pm; u.pn = pn; return true; }
    __device__ __forceinline__ void a_ready(const Unit&) const {}
    __device__ __forceinline__ void done(const Unit&) const {}
};
struct EpiRes {
    static constexpr bool PERM = false, AFTER_DRAIN = false, GROUP64 = false;
    const float* res0; float* out0; const float* res1; float* out1; const float* mod; int mlat, rows_per_vec;
    __device__ __forceinline__ void operator()(const f32x4 (&acc)[2][2][4][2], const Unit& u, int wr, int wc, int fr, int fq) const {
        int row0 = u.pm * BM + wr * 64 + fr; const int col0 = u.pn * BM + wc * 32 + 4 * fq;
        const bool isc = (u.pm * BM) >= mlat;
        const float* res = isc ? res1 : res0; float* out = isc ? out1 : out0;
        const int vec = isc ? 2 : (u.pm * BM) / rows_per_vec;
        if (isc) row0 -= mlat;
        const float* gp = mod + vec * 3072 + 2048 + col0;
        f32x4 gv[2][2];
#pragma unroll
        for (int bj = 0; bj < 2; ++bj)
#pragma unroll
            for (int n = 0; n < 2; ++n) gv[bj][n] = mod4(gp + bj * HALF + n * 16);
#pragma unroll
        for (int ai = 0; ai < 2; ++ai) {
            f32x4 rr[4][2][2];
#pragma unroll
            for (int m = 0; m < 4; ++m) { const size_t off = (size_t)(row0 + ai * HALF + m * 16) * 1024 + col0;
#pragma unroll
                for (int bj = 0; bj < 2; ++bj)
#pragma unroll
                    for (int n = 0; n < 2; ++n) rr[m][bj][n] = *(const f32x4*)(res + off + bj * HALF + n * 16); }
            asm volatile("" ::: "memory");
#pragma unroll
            for (int m = 0; m < 4; ++m) { const size_t off = (size_t)(row0 + ai * HALF + m * 16) * 1024 + col0;
#pragma unroll
                for (int bj = 0; bj < 2; ++bj)
#pragma unroll
                    for (int n = 0; n < 2; ++n) *(f32x4*)(out + off + bj * HALF + n * 16) = rr[m][bj][n] + gv[bj][n] * acc[ai][bj][m][n]; }
            asm volatile("" ::: "memory");
        }
    }
};

struct EpiResL {
    static constexpr bool PERM = false, AFTER_DRAIN = false, GROUP64 = false;
    const float* res; float* out; const float* mod; int rows_per_vec; PG8_LAS unsigned char* lds; int wt;
    __device__ __forceinline__ void operator()(const f32x4 (&acc)[2][2][4][2], const Unit& u, int wr, int wc, int fr_, int fq_) const {
        int ln_; asm volatile("v_mbcnt_lo_u32_b32 %0, -1, 0\n\tv_mbcnt_hi_u32_b32 %0, -1, %0" : "=v"(ln_)); const int fr = ln_ & 15, fq = ln_ >> 4; (void)fr_; (void)fq_;
        const int tid = (wr * 4 + wc) * 64 + ln_;
        asm volatile("s_waitcnt vmcnt(0)" ::: "memory");
        __syncthreads();
        const int vec = (u.pm * BM) / rows_per_vec;
        const float* gp = mod + vec * 3072 + 2048 + u.pn * BM + wc * 32 + 4 * fq;
        f32x4 gv[2][2];
#pragma unroll
        for (int bj = 0; bj < 2; ++bj)
#pragma unroll
            for (int n = 0; n < 2; ++n) gv[bj][n] = mod4(gp + bj * HALF + n * 16);
        PG8_LAS float* X = (PG8_LAS float*)lds;
#pragma unroll
        for (int ai = 0; ai < 2; ++ai)
#pragma unroll
            for (int mh = 0; mh < 2; ++mh) {
#pragma unroll
                for (int j = 0; j < 2; ++j) { PG8_LAS float* xr = X + (wr * 32 + j * 16 + fr) * 260 + wc * 32 + 4 * fq;
#pragma unroll
                    for (int bj = 0; bj < 2; ++bj)
#pragma unroll
                        for (int n = 0; n < 2; ++n) *(PG8_LAS f32x4*)(xr + bj * HALF + n * 16) = gv[bj][n] * acc[ai][bj][2 * mh + j][n]; }
                __syncthreads();
                f32x4 rr[8];
#pragma unroll
                for (int i = 0; i < 8; ++i) { const int id = tid + 512 * i, rl = id >> 6, c4 = id & 63;
                    const size_t off = (size_t)(u.pm * BM + ai * HALF + (rl >> 5) * 64 + (2 * mh + ((rl >> 4) & 1)) * 16 + (rl & 15)) * 1024 + u.pn * BM + 4 * c4;
                    rr[i] = *(const f32x4*)(res + off); }
                asm volatile("" ::: "memory");
#pragma unroll
                for (int i = 0; i < 8; ++i) { const int id = tid + 512 * i, rl = id >> 6, c4 = id & 63;
                    const size_t off = (size_t)(u.pm * BM + ai * HALF + (rl >> 5) * 64 + (2 * mh + ((rl >> 4) & 1)) * 16 + (rl & 15)) * 1024 + u.pn * BM + 4 * c4;
                    const f32x4 o4 = rr[i] + *(const PG8_LAS f32x4*)(X + rl * 260 + 4 * c4);
                    if (wt) st_wt16(out + off, __builtin_bit_cast(u32x4, o4)); else *(f32x4*)(out + off) = o4; }
                asm volatile("" ::: "memory");
                __syncthreads();
            }
    }
};

template <class Epi, class Sched, bool ALIGN_EPI = false, bool SP2 = false>
__device__ __forceinline__ void gemm_phase(PG8_LAS unsigned char* lds, const Gemm g, const Sched& S, const Epi& E, const int tid) {
    const int wid = __builtin_amdgcn_readfirstlane(tid >> 6), lane = tid & 63, wr = wid >> 2, wc = wid & 3, fr = lane & 15, fq = lane >> 4;
    const int K = g.K, nt = K / BK;
    unsigned voffA[2], voffB[2];
#pragma unroll
    for (int i = 0; i < 2; ++i) { int R, C; stage_rc(tid * 16 + i * 8192, R, C);
        const int Rb = Epi::GROUP64 ? ((R >> 5) * 64 + perm32(R & 31)) : (Epi::PERM ? ((R & ~31) + perm32(R & 31)) : R);
        voffA[i] = (unsigned)(R * K + C) * 2u; voffB[i] = (unsigned)(Rb * K + C) * 2u; }
    const size_t kstep = (size_t)(BK * 2);
    const size_t hstep = (size_t)HALF * K * 2;
    const size_t hstepB = Epi::GROUP64 ? (size_t)32 * K * 2 : hstep;
    const size_t tstep = 2 * hstep;
    const unsigned ldsw = (unsigned)wid * 1024u;
    const int aoff = lds_byte(wr * 64 + fr, fq * 8), boff = lds_byte(wc * 32 + fr, fq * 8);
#define PG8_SA(b, h) (((b) * 2 + (h)) * HTB)
#define PG8_SB(b, h) ((4 + (b) * 2 + (h)) * HTB)
#define PG8_STAGE(bufoff, gbase, voff) do { _Pragma("unroll") for (int _i = 0; _i < 2; ++_i) \
        __builtin_amdgcn_global_load_lds((const unsigned*)((const char*)(gbase) + (voff)[_i]), (PG8_LAS unsigned*)(lds + (bufoff) + ldsw + _i * 8192), 16, 0, 0); } while (0)
#define PG8_LDA(dst, b, h) do { _Pragma("unroll") for (int m = 0; m < 4; ++m) _Pragma("unroll") for (int k = 0; k < 2; ++k) dst[m][k] = *(const PG8_LAS bf16x8*)(lds + PG8_SA(b, h) + aoff + m * 2048 + k * 1024); } while (0)
#define PG8_LDB(dst, b, h) do { _Pragma("unroll") for (int n = 0; n < 2; ++n) _Pragma("unroll") for (int k = 0; k < 2; ++k) dst[n][k] = *(const PG8_LAS bf16x8*)(lds + PG8_SB(b, h) + boff + n * 2048 + k * 1024); } while (0)
#define PG8_MMA(ai, bj, At, Bt) do { __builtin_amdgcn_s_setprio(1); _Pragma("unroll") for (int m = 0; m < 4; ++m) _Pragma("unroll") for (int n = 0; n < 2; ++n) _Pragma("unroll") for (int k = 0; k < 2; ++k) \
        acc[ai][bj][m][n] = __builtin_amdgcn_mfma_f32_16x16x32_bf16(Bt[n][k], At[m][k], acc[ai][bj][m][n], 0, 0, 0); __builtin_amdgcn_s_setprio(0); } while (0)
#define PG8_WAIT_V(n) asm volatile("s_waitcnt vmcnt(" #n ")" ::: "memory")
#define PG8_WAIT_L(n) asm volatile("s_waitcnt lgkmcnt(" #n ")" ::: "memory")
#define PG8_BAR __builtin_amdgcn_s_barrier()
#define PG8_SCHED __builtin_amdgcn_sched_barrier(0)
    Unit cur, nxt; int ui = 0;
    if (!S.next(0, cur)) return;
    f32x4 acc[2][2][4][2];
#pragma unroll
    for (int a = 0; a < 2; ++a)
#pragma unroll
        for (int b = 0; b < 2; ++b)
#pragma unroll
            for (int m = 0; m < 4; ++m)
#pragma unroll
                for (int n = 0; n < 2; ++n) acc[a][b][m][n] = (f32x4){0.f, 0.f, 0.f, 0.f};
    bf16x8 At[4][2], B0[2][2], B1[2][2];
    const char* cA = (const char*)g.A + (size_t)cur.pm * tstep; const char* cB = (const char*)g.Bt + (size_t)cur.pn * tstep;
    S.a_ready(cur);
    if constexpr (SP2) {
        PG8_STAGE(PG8_SB(0, 0), cB, voffB); PG8_STAGE(PG8_SB(0, 1), cB + hstepB, voffB); PG8_STAGE(PG8_SA(0, 0), cA, voffA); PG8_STAGE(PG8_SA(0, 1), cA + hstep, voffA);
        if (wr == 1) PG8_BAR;
        PG8_WAIT_V(2); PG8_BAR;
        PG8_STAGE(PG8_SB(1, 0), cB + kstep, voffB); PG8_STAGE(PG8_SA(1, 0), cA + kstep, voffA); PG8_STAGE(PG8_SB(1, 1), cB + hstepB + kstep, voffB);
        PG8_WAIT_V(6); PG8_BAR;
    } else {
        PG8_STAGE(PG8_SB(0, 0), cB, voffB); PG8_STAGE(PG8_SA(0, 0), cA, voffA); PG8_STAGE(PG8_SB(0, 1), cB + hstepB, voffB); PG8_STAGE(PG8_SA(0, 1), cA + hstep, voffA);
        if (wr == 1) PG8_BAR;
        PG8_WAIT_V(4); PG8_BAR;
        PG8_STAGE(PG8_SB(1, 0), cB + kstep, voffB); PG8_STAGE(PG8_SA(1, 0), cA + kstep, voffA); PG8_STAGE(PG8_SB(1, 1), cB + hstepB + kstep, voffB);
        PG8_WAIT_V(6); PG8_BAR;
    }
    for (;;) {
        const bool has_next = S.next(ui + 1, nxt);
        const char* nA = has_next ? (const char*)g.A + (size_t)nxt.pm * tstep : cA; const char* nB = has_next ? (const char*)g.Bt + (size_t)nxt.pn * tstep : cB;
        for (int t = 0; t < nt; t += 2) {
            const bool last = (t == nt - 2);
            const char* a1 = cA + (size_t)(t + 1) * kstep;
            const char* a2 = last ? nA : cA + (size_t)(t + 2) * kstep; const char* b2 = last ? nB : cB + (size_t)(t + 2) * kstep;
            const char* a3 = a2 + kstep; const char* b3 = b2 + kstep;
            if (last && has_next) S.a_ready(nxt);
            if constexpr (SP2) {
            PG8_LDB(B0, 0, 0); PG8_LDB(B1, 0, 1); PG8_SCHED; PG8_LDA(At, 0, 0); PG8_STAGE(PG8_SA(1, 1), a1 + hstep, voffA);
            PG8_WAIT_V(8); PG8_WAIT_L(0); PG8_BAR; PG8_MMA(0, 0, At, B0); PG8_MMA(0, 1, At, B1); PG8_BAR; PG8_SCHED;
            PG8_LDA(At, 0, 1); PG8_STAGE(PG8_SB(0, 0), b2, voffB); PG8_STAGE(PG8_SB(0, 1), b2 + hstepB, voffB); PG8_STAGE(PG8_SA(0, 0), a2, voffA);
            PG8_WAIT_V(8); PG8_WAIT_L(0); PG8_BAR; PG8_MMA(1, 0, At, B0); PG8_MMA(1, 1, At, B1); PG8_BAR; PG8_SCHED;
            PG8_LDB(B0, 1, 0); PG8_LDB(B1, 1, 1); PG8_SCHED; PG8_LDA(At, 1, 0); PG8_STAGE(PG8_SA(0, 1), a2 + hstep, voffA);
            PG8_WAIT_V(8); PG8_WAIT_L(0); PG8_BAR; PG8_MMA(0, 0, At, B0); PG8_MMA(0, 1, At, B1); PG8_BAR; PG8_SCHED;
            PG8_LDA(At, 1, 1); PG8_STAGE(PG8_SB(1, 0), b3, voffB); PG8_STAGE(PG8_SB(1, 1), b3 + hstepB, voffB); PG8_STAGE(PG8_SA(1, 0), a3, voffA);
            PG8_WAIT_V(8); PG8_WAIT_L(0); PG8_BAR; PG8_MMA(1, 0, At, B0); PG8_MMA(1, 1, At, B1); PG8_BAR; PG8_SCHED;
            } else {
            PG8_LDB(B0, 0, 0); PG8_SCHED; PG8_LDA(At, 0, 0); PG8_STAGE(PG8_SA(1, 1), a1 + hstep, voffA);
            PG8_WAIT_L(8); PG8_BAR; PG8_WAIT_L(0); PG8_MMA(0, 0, At, B0); PG8_BAR; PG8_SCHED;
            PG8_LDB(B1, 0, 1); PG8_STAGE(PG8_SB(0, 0), b2, voffB);
            PG8_BAR; PG8_WAIT_L(0); PG8_MMA(0, 1, At, B1); PG8_BAR;
            PG8_LDA(At, 0, 1); PG8_STAGE(PG8_SA(0, 0), a2, voffA);
            PG8_BAR; PG8_WAIT_L(0); PG8_MMA(1, 0, At, B0); PG8_BAR; PG8_SCHED;
            PG8_STAGE(PG8_SB(0, 1), b2 + hstepB, voffB);
            PG8_WAIT_V(6); PG8_BAR; PG8_MMA(1, 1, At, B1); PG8_BAR;
            PG8_LDB(B0, 1, 0); PG8_SCHED; PG8_LDA(At, 1, 0); PG8_STAGE(PG8_SA(0, 1), a2 + hstep, voffA);
            PG8_WAIT_L(8); PG8_BAR; PG8_WAIT_L(0); PG8_MMA(0, 0, At, B0); PG8_BAR; PG8_SCHED;
            PG8_LDB(B1, 1, 1); PG8_STAGE(PG8_SB(1, 0), b3, voffB);
            PG8_BAR; PG8_WAIT_L(0); PG8_MMA(0, 1, At, B1); PG8_BAR;
            PG8_LDA(At, 1, 1); PG8_STAGE(PG8_SA(1, 0), a3, voffA);
            PG8_BAR; PG8_WAIT_L(0); PG8_MMA(1, 0, At, B0); PG8_BAR; PG8_SCHED;
            PG8_STAGE(PG8_SB(1, 1), b3 + hstepB, voffB);
            PG8_WAIT_V(6); PG8_BAR; PG8_MMA(1, 1, At, B1); PG8_BAR;
            }
        }
        if constexpr (ALIGN_EPI) { if (wr == 0) PG8_BAR; }
        if constexpr (!Epi::AFTER_DRAIN) { E(acc, cur, wr, wc, fr, fq); S.done(cur); }
        if (!has_next) break;
#pragma unroll
        for (int a = 0; a < 2; ++a)
#pragma unroll
            for (int b = 0; b < 2; ++b)
#pragma unroll
                for (int m = 0; m < 4; ++m)
#pragma unroll
                    for (int n = 0; n < 2; ++n) acc[a][b][m][n] = (f32x4){0.f, 0.f, 0.f, 0.f};
        cur = nxt; cA = nA; cB = nB; ++ui;
        if constexpr (ALIGN_EPI) { if (wr == 1) PG8_BAR; }
    }
    PG8_WAIT_V(0);
    if constexpr (!ALIGN_EPI) { if (wr == 0) PG8_BAR; }
    PG8_BAR;
#undef PG8_SA
#undef PG8_SB
#undef PG8_STAGE
#undef PG8_LDA
#undef PG8_LDB
#undef PG8_MMA
#undef PG8_WAIT_V
#undef PG8_WAIT_L
#undef PG8_BAR
#undef PG8_SCHED
}
}

namespace att {
constexpr int NW = 8, QBLK = 32, KVBLK = 64;
constexpr size_t SHM_V = KVBLK * 128 * 2, SHM_K = KVBLK * 128 * 2, SHM_ATTN = 2 * SHM_V + 2 * SHM_K + NW * 64 * 4;
#define KSWZ(row, colB) ((row) * 256 + ((colB) ^ (((row) & 7) << 4)))
#define SBAR() __builtin_amdgcn_sched_barrier(0)
__device__ __forceinline__ int crow(int r, int hi) { return (r & 3) + 8 * (r >> 2) + 4 * hi; }
__device__ __forceinline__ unsigned cvtpk(float lo, float hi) { unsigned r; asm volatile("v_cvt_pk_bf16_f32 %0, %1, %2" : "=v"(r) : "v"(lo), "v"(hi)); return r; }
__device__ __forceinline__ void expA(f32x16& p0) {
#pragma unroll
    for (int r = 0; r < 16; ++r) p0[r] = __builtin_amdgcn_exp2f(p0[r]);
}
__device__ __forceinline__ void finishSM(f32x16& p0, f32x16& p1, float& l_reg, bf16x8& pa0, bf16x8& pa1, bf16x8& pa2, bf16x8& pa3) {
#pragma unroll
    for (int r = 0; r < 16; ++r) p1[r] = __builtin_amdgcn_exp2f(p1[r]);
    float ps = 0;
#pragma unroll
    for (int r = 0; r < 16; ++r) ps += p0[r];
#pragma unroll
    for (int r = 0; r < 16; ++r) ps += p1[r];
    l_reg += ps;
#define PK4(P, BASE, OUT) do { unsigned a0 = cvtpk(P[BASE + 0], P[BASE + 1]), a1 = cvtpk(P[BASE + 2], P[BASE + 3]);   \
    unsigned b0 = cvtpk(P[BASE + 4], P[BASE + 5]), b1 = cvtpk(P[BASE + 6], P[BASE + 7]);                              \
    auto r0 = __builtin_amdgcn_permlane32_swap(a0, b0, false, false); auto r1 = __builtin_amdgcn_permlane32_swap(a1, b1, false, false); \
    u32x4 w = {r0[0], r1[0], r0[1], r1[1]}; OUT = *reinterpret_cast<bf16x8*>(&w); } while (0)
    PK4(p0, 0, pa0); PK4(p0, 8, pa1); PK4(p1, 0, pa2); PK4(p1, 8, pa3);
#undef PK4
}
__device__ __forceinline__ void qkt(f32x16& p0, f32x16& p1, const char* Ks, const bf16x8* qr, int kbase, float negM) {
#pragma unroll
    for (int r = 0; r < 16; ++r) { p0[r] = negM; p1[r] = negM; }
#pragma unroll
    for (int d0 = 0; d0 < 4; ++d0) { int kb = kbase; asm volatile("" : "+v"(kb)); const int ad = kb ^ (d0 * 32);
        bf16x8 b0 = *reinterpret_cast<const bf16x8*>(Ks + ad);
        bf16x8 b1 = *reinterpret_cast<const bf16x8*>(Ks + ad + 8192);
        p0 = __builtin_amdgcn_mfma_f32_32x32x16_bf16(b0, qr[d0], p0, 0, 0, 0);
        p1 = __builtin_amdgcn_mfma_f32_32x32x16_bf16(b1, qr[d0], p1, 0, 0, 0); }
}
__device__ __forceinline__ int v_st(int k, int c) { const int kk = (k & ~0xC) | ((k & 4) << 1) | ((k & 8) >> 1); return ((kk >> 3) * 4 + (c >> 5)) * 512 + ((kk & 7) * 32 + (c & 31)) * 2; }
__device__ __forceinline__ int v_rd_base(int lane) { return ((lane & 3) << 3) | (((lane >> 2) & 3) << 6) | (((lane >> 4) & 1) << 5) | (((lane >> 5) & 1) << 8); }
constexpr int v_rd_off(int d0, int ks, int half) { return d0 * 512 + ks * 4096 + half * 2048; }
template <int OFF> __device__ __forceinline__ s16x4 tr_read(int vb) { s16x4 r; asm volatile("ds_read_b64_tr_b16 %0, %1 offset:%2" : "=&v"(r) : "v"(vb), "i"(OFF) : "memory"); return r; }
template <int D0> __device__ __forceinline__ void pv_one(f32x16& od, int vb, bf16x8 pa0, bf16x8 pa1, bf16x8 pa2, bf16x8 pa3) {
    const s16x4 l0 = tr_read<v_rd_off(D0, 0, 0)>(vb), h0 = tr_read<v_rd_off(D0, 0, 1)>(vb), l1 = tr_read<v_rd_off(D0, 1, 0)>(vb), h1 = tr_read<v_rd_off(D0, 1, 1)>(vb);
    const s16x4 l2 = tr_read<v_rd_off(D0, 2, 0)>(vb), h2 = tr_read<v_rd_off(D0, 2, 1)>(vb), l3 = tr_read<v_rd_off(D0, 3, 0)>(vb), h3 = tr_read<v_rd_off(D0, 3, 1)>(vb);
    asm volatile("s_waitcnt lgkmcnt(0)" ::: "memory"); SBAR();
#define PK(Lo, Hi) (bf16x8){Lo[0], Lo[1], Lo[2], Lo[3], Hi[0], Hi[1], Hi[2], Hi[3]}
    od = __builtin_amdgcn_mfma_f32_32x32x16_bf16(pa0, PK(l0, h0), od, 0, 0, 0);
    od = __builtin_amdgcn_mfma_f32_32x32x16_bf16(pa1, PK(l1, h1), od, 0, 0, 0);
    od = __builtin_amdgcn_mfma_f32_32x32x16_bf16(pa2, PK(l2, h2), od, 0, 0, 0);
    od = __builtin_amdgcn_mfma_f32_32x32x16_bf16(pa3, PK(l3, h3), od, 0, 0, 0);
#undef PK
}
__device__ __forceinline__ void pv_d0(f32x16* o, int vb, bf16x8 pa0, bf16x8 pa1, bf16x8 pa2, bf16x8 pa3) {
    pv_one<0>(o[0], vb, pa0, pa1, pa2, pa3); pv_one<1>(o[1], vb, pa0, pa1, pa2, pa3); pv_one<2>(o[2], vb, pa0, pa1, pa2, pa3); pv_one<3>(o[3], vb, pa0, pa1, pa2, pa3);
}
__device__ __forceinline__ void attn_item(const bf16* PB, bf16* Y, const float* subg, const float* SC, const bool cx, int b, int h, int q0, char* lds, const int tid) {
    const int wid = tid >> 6, lane = tid & 63, r32 = lane & 31, hi = lane >> 5, wq = wid & 3, map = wid >> 2;
    char* V_lds = lds; char* K_lds = lds + 2 * SHM_V;
    const float negM = __builtin_bit_cast(float, __builtin_amdgcn_readfirstlane(__builtin_bit_cast(int, -SC[1] * LOG2E)));
    float l_reg = 0; f32x16 o[4] = {}; bf16x8 qr[4];
    const int rowq0 = (cx ? M + b * CL : b * L) + q0;
    const bf16* Qw = PB + (size_t)(rowq0 + wq * QBLK + r32) * IN_W + Q_OFF + h * 128 + map * 64 + hi * 8;
#pragma unroll
    for (int d0 = 0; d0 < 4; ++d0) qr[d0] = *reinterpret_cast<const bf16x8*>(Qw + d0 * 16);
    const int sr = tid >> 4, sc = (tid & 15) * 8, vst0 = v_st(sr, sc), vst1 = v_st(32 + sr, sc);
    const int vb0 = (int)(uintptr_t)V_lds + v_rd_base(lane);
    const int kbase = r32 * 256 + ((map * 128 + hi * 16) ^ ((r32 & 7) << 4));
    const int NT = cx ? CL / KVBLK : (CL + L) / KVBLK;
    struct { bf16x8 vs0, vs1, ks0, ks1; } sr_[2];
    const __amdgpu_buffer_rsrc_t rs = __builtin_amdgcn_make_buffer_rsrc((void*)PB, (short)0, (int)((size_t)MT * IN_W * 2), 0x00020000);
    const unsigned voff = (unsigned)(sr * IN_W + sc) * 2u;
    const unsigned so_ctx = (unsigned)((M + b * CL) * IN_W + h * 128) * 2u, so_lat = (unsigned)((b * L - CL) * IN_W + h * 128) * 2u;
#define LD16(so) __builtin_bit_cast(bf16x8, __builtin_amdgcn_raw_buffer_load_b128(rs, voff, (so), 0))
#define SLOAD(i, t) do { const int t_ = (t); const unsigned so_ = (t_ < CL / KVBLK ? so_ctx : so_lat) + (unsigned)(t_ * KVBLK) * (unsigned)(IN_W * 2); \
        sr_[i].vs0 = LD16(so_ + V_OFF * 2); sr_[i].vs1 = LD16(so_ + V_OFF * 2 + 32 * IN_W * 2); sr_[i].ks0 = LD16(so_ + K_OFF * 2); sr_[i].ks1 = LD16(so_ + K_OFF * 2 + 32 * IN_W * 2); } while (0)
#define SWRITE(bb, i) do { *(bf16x8*)(V_lds + (bb) * SHM_V + vst0) = sr_[i].vs0; *(bf16x8*)(V_lds + (bb) * SHM_V + vst1) = sr_[i].vs1; const int kc = sc * 2; \
    *(bf16x8*)(K_lds + (bb) * SHM_K + KSWZ(sr, kc)) = sr_[i].ks0; *(bf16x8*)(K_lds + (bb) * SHM_K + KSWZ(32 + sr, kc)) = sr_[i].ks1; } while (0)
#define SWAIT() asm volatile("s_waitcnt vmcnt(4)" ::: "memory")
    f32x16 pA0, pA1, pB0, pB1; bf16x8 pa0, pa1, pa2, pa3;
    constexpr int SE = 0, SO = 1;
    SLOAD(SE, 0); asm volatile("s_waitcnt vmcnt(0)" ::: "memory"); SWRITE(0, SE); __syncthreads();
    qkt(pA0, pA1, K_lds, qr, kbase, negM); expA(pA0);
    SLOAD(SO, 1); if (2 < NT) SLOAD(SE, 2);
    SWAIT(); SWRITE(1, SO); __syncthreads();
    for (int j = 1; j + 1 < NT; j += 2) {
        SBAR(); qkt(pB0, pB1, K_lds + SHM_K, qr, kbase, negM);
        finishSM(pA0, pA1, l_reg, pa0, pa1, pa2, pa3); SBAR();
        SLOAD(SO, j + 2); SBAR();
        pv_d0(o, vb0, pa0, pa1, pa2, pa3); expA(pB0);
        __syncthreads(); SWAIT(); SWRITE(0, SE);
        __syncthreads();
        SBAR(); qkt(pA0, pA1, K_lds, qr, kbase, negM);
        finishSM(pB0, pB1, l_reg, pa0, pa1, pa2, pa3); SBAR();
        if (j + 3 < NT) SLOAD(SE, j + 3); SBAR();
        pv_d0(o, vb0 + (int)SHM_V, pa0, pa1, pa2, pa3); expA(pA0);
        __syncthreads(); SWAIT(); SWRITE(1, SO);
        __syncthreads();
    }
    SBAR(); qkt(pB0, pB1, K_lds + SHM_K, qr, kbase, negM);
    finishSM(pA0, pA1, l_reg, pa0, pa1, pa2, pa3); SBAR();
    pv_d0(o, vb0, pa0, pa1, pa2, pa3); expA(pB0);
    finishSM(pB0, pB1, l_reg, pa0, pa1, pa2, pa3); SBAR();
    pv_d0(o, vb0 + (int)SHM_V, pa0, pa1, pa2, pa3);
#undef SLOAD
#undef LD16
#undef SWRITE
#undef SWAIT
    int tid2 = tid; asm volatile("" : "+v"(tid2));
    { const int wid = tid2 >> 6, lane = tid2 & 63, r32 = lane & 31, hi = lane >> 5, wq = wid & 3, map = wid >> 2;
    float* li_l = (float*)(lds + 2 * SHM_V + 2 * SHM_K) + wid * 64;
    const float* SC2 = SC; asm volatile("" : "+s"(SC2));
    const float lam = SC2[0], lam_init = SC2[2];
    l_reg = half_swap_sum(l_reg);
    if (hi == 0) li_l[r32] = l_reg;
    asm volatile("s_waitcnt lgkmcnt(0)" ::: "memory");
    float rli[16];
#pragma unroll
    for (int r = 0; r < 16; ++r) rli[r] = __builtin_amdgcn_rcpf(li_l[crow(r, hi)]);
    __syncthreads();
    float* X = (float*)lds + wq * 4096;
    if (map == 1) {
#pragma unroll
        for (int r = 0; r < 16; ++r)
#pragma unroll
            for (int d0 = 0; d0 < 4; ++d0) X[crow(r, hi) * 128 + d0 * 32 + r32] = o[d0][r] * rli[r];
    }
    __syncthreads();
    if (map == 0) {
        const float oml = 1.f - lam_init;
        float sg[4];
#pragma unroll
        for (int d0 = 0; d0 < 4; ++d0) sg[d0] = subg[d0 * 32 + r32] * oml;
        const size_t rowb = (size_t)((cx ? M + b * CL : b * L) + q0 + wq * QBLK);
#pragma unroll
        for (int r = 0; r < 16; ++r) {
            const int qrow = crow(r, hi);
            float v[4], ss = 0.f;
#pragma unroll
            for (int d0 = 0; d0 < 4; ++d0) { v[d0] = o[d0][r] * rli[r] - lam * X[qrow * 128 + d0 * 32 + r32]; ss += v[d0] * v[d0]; }
            ss += sxor<1>(ss); ss += sxor<2>(ss); ss += sxor<4>(ss); ss += sxor<8>(ss); ss += sxor<16>(ss);
            const float rs = 1.0f / sqrtf(ss * (1.f / 128.f) + EPS);
            const bf16* grow = PB + (rowb + qrow) * IN_W + G_OFF + 512 + h * 128 + r32;
            bf16* yrow = Y + (rowb + qrow) * 1024 + 512 + h * 128 + r32;
#pragma unroll
            for (int d0 = 0; d0 < 4; ++d0) yrow[d0 * 32] = (bf16)f2bf(v[d0] * rs * sg[d0] * silu_f(bf2f(grow[d0 * 32])));
        }
    }
    }
    __syncthreads();
}
#undef KSWZ
#undef SBAR
}


namespace att2 {
constexpr int NW = 8, QBLK = 32, KVBLK = 64, NSLOT = 4, KSLOT = 16384, VSLOT = 16384;
constexpr int LDS_K = 0, LDS_V = NSLOT * KSLOT, LDS_WS = 132096, LDS_END = LDS_WS + NW * 256;
#define SBAR() __builtin_amdgcn_sched_barrier(0)
__device__ __forceinline__ int crow(int r, int hi) { return (r & 3) + 8 * (r >> 2) + 4 * hi; }
typedef __attribute__((address_space(3))) const char* lds_cptr;
typedef short v4i16_t __attribute__((ext_vector_type(4)));
typedef float f32x2_t __attribute__((ext_vector_type(2))); typedef __bf16 bf16x2_t __attribute__((ext_vector_type(2)));
__device__ __forceinline__ unsigned cvtpk_s(float lo, float hi) { f32x2_t v = {lo, hi}; bf16x2_t b = __builtin_convertvector(v, bf16x2_t); return __builtin_bit_cast(unsigned, b); }
__device__ __forceinline__ s16x4 vtr(lds_cptr p) { return __builtin_bit_cast(s16x4, __builtin_amdgcn_ds_read_tr16_b64_v4i16((__attribute__((address_space(3))) v4i16_t*)p)); }
__device__ __forceinline__ void glds16s(const void* sbase, unsigned voff, unsigned lds_dst) { unsigned keep;
    asm volatile("s_mov_b32 %0, m0\n\ts_mov_b32 m0, %3\n\ts_nop 0\n\tglobal_load_lds_dwordx4 %1, %2\n\ts_mov_b32 m0, %0" : "=&s"(keep) : "v"(voff), "s"(sbase), "s"(lds_dst) : "memory"); }
#define WAIT_BAR(N) asm volatile("s_waitcnt vmcnt(" #N ") lgkmcnt(0)\n\ts_barrier" ::: "memory")
__device__ __forceinline__ void kload2(bf16x8* kf, lds_cptr kp, int j) { kf[2 * j] = *(const __attribute__((address_space(3))) bf16x8*)(kp + j * 2048); kf[2 * j + 1] = *(const __attribute__((address_space(3))) bf16x8*)(kp + j * 2048 + 512); }

__device__ __forceinline__ void attn_item(const bf16* PB, const unsigned char* KT, const unsigned char* VT, bf16* Y, const float* subg, const float* SC, const bool cx, int b, int h, int q0, char* shm, const int tid) {
    const int lane = tid & 63, r32 = lane & 31, hi = lane >> 5; const int wid = __builtin_amdgcn_readfirstlane(tid >> 6); const int wq = wid & 3, map = wid >> 2;
    const int rowq0 = (cx ? M + b * CL : b * L) + q0;
    const unsigned lds0 = (unsigned)(uintptr_t)shm;
    const unsigned koff = (unsigned)(wid * 1024 + lane * 16);
    const unsigned voff = (unsigned)(((wid >> 2) * 4 + (wid & 3)) * 1024 + lane * 16);
    const unsigned kdst = lds0 + LDS_K + wid * 1024, vdst = lds0 + LDS_V + ((wid >> 2) * 4 + (wid & 3)) * 1024;
    const char* ktb = (const char*)KT + (size_t)((b * 4 + h) * NTILE) * 16384; const char* vtb = (const char*)VT + (size_t)((b * 4 + h) * NTILE) * 16384;
#define DMA_K(t, slot) do { const char* tb_ = ktb + (size_t)(t) * 16384; const unsigned d_ = (unsigned)__builtin_amdgcn_readfirstlane(kdst + (slot)); glds16s(tb_, koff, d_); glds16s(tb_, koff + 8192u, d_ + 8192u); } while (0)
#define DMA_V(t, slot) do { const char* tb_ = vtb + (size_t)(t) * 16384; const unsigned d_ = (unsigned)__builtin_amdgcn_readfirstlane(vdst + (slot)); glds16s(tb_, voff, d_); glds16s(tb_, voff + 8192u, d_ + 8192u); } while (0)
    const lds_cptr shm3 = (lds_cptr)shm;
    const lds_cptr kp0 = shm3 + LDS_K + map * 8192 + hi * 1024 + r32 * 16;
    const lds_cptr vp0 = shm3 + LDS_V + ((lane >> 4) & 1) * 32 + (lane & 3) * 8 + (4 * hi + ((lane & 15) >> 2)) * 64;
    const int NT = cx ? CL / KVBLK : (CL + L) / KVBLK;
    DMA_K(0, 0); DMA_V(0, 0); DMA_K(1, KSLOT);
    bf16x8 qr[4];
    { const bf16* Qw = PB + (size_t)(rowq0 + wq * QBLK + r32) * IN_W + Q_OFF + h * 128 + map * 64 + hi * 8;
#pragma unroll
      for (int d0 = 0; d0 < 4; ++d0) qr[d0] = *reinterpret_cast<const bf16x8*>(Qw + d0 * 16); }
    float l_reg = 0.f; f32x16 o[4]; o[0] = f32x16{}; o[1] = f32x16{}; o[2] = f32x16{}; o[3] = f32x16{};
    const f32x16 zero = f32x16{};
    f32x16 pA0, pA1, pB0, pB1; bf16x8 kf[8];
    int s_m2 = 3 * KSLOT, s_m1 = 0, s_0 = KSLOT, s_p1 = 2 * KSLOT;
#define ROT4() do { const int x_ = s_m2; s_m2 = s_m1; s_m1 = s_0; s_0 = s_p1; s_p1 = x_; } while (0)
    DMA_K(2, 2 * KSLOT);
    WAIT_BAR(6);
    {
      const lds_cptr kb = kp0;
#pragma unroll
      for (int d0 = 0; d0 < 4; ++d0) { const bf16x8 b0 = *(const __attribute__((address_space(3))) bf16x8*)(kb + d0 * 2048), b1 = *(const __attribute__((address_space(3))) bf16x8*)(kb + d0 * 2048 + 512);
          if (d0 == 0) { pA0 = __builtin_amdgcn_mfma_f32_32x32x16_bf16(b0, qr[0], zero, 0, 0, 0); pA1 = __builtin_amdgcn_mfma_f32_32x32x16_bf16(b1, qr[0], zero, 0, 0, 0); }
          else { pA0 = __builtin_amdgcn_mfma_f32_32x32x16_bf16(b0, qr[d0], pA0, 0, 0, 0); pA1 = __builtin_amdgcn_mfma_f32_32x32x16_bf16(b1, qr[d0], pA1, 0, 0, 0); } }
#pragma unroll
      for (int r = 0; r < 16; ++r) { pA0[r] = __builtin_amdgcn_exp2f(pA0[r]); pA1[r] = __builtin_amdgcn_exp2f(pA1[r]); } }
    WAIT_BAR(0);
    DMA_K(3, 3 * KSLOT); DMA_V(1, VSLOT);
    WAIT_BAR(4);
    s16x4 vlo[8], vhi[8]; u32x4 pw0, pw1, pw2, pw3;
#define PATH_ENTRY() int ln_; asm volatile("v_mbcnt_lo_u32_b32 %0, -1, 0\n\tv_mbcnt_hi_u32_b32 %0, -1, %0" : "=v"(ln_)); \
    const unsigned koff = (unsigned)(wid * 1024 + ln_ * 16); \
    const unsigned voff = (unsigned)(((wid >> 2) * 4 + (wid & 3)) * 1024 + ln_ * 16); \
    kload2(kf, kp0 + s_0, 0); kload2(kf, kp0 + s_0, 1); kload2(kf, kp0 + s_0, 2); kload2(kf, kp0 + s_0, 3);
#define PKW(P, B) cvtpk_s(P[B], P[B + 1])
#define PAF(k) __builtin_bit_cast(bf16x8, pw##k)
#define VFR(i) (bf16x8){vlo[i][0], vlo[i][1], vlo[i][2], vlo[i][3], vhi[i][0], vhi[i][1], vhi[i][2], vhi[i][3]}
#define PIN(x) asm volatile("" : "+v"(x))
#define EX(v) __builtin_amdgcn_exp2f(v)
#define VRD(s, d0, ks) do { vlo[s] = vtr(vp_ + ((d0) * 4096 + (ks) * 1024)); vhi[s] = vtr(vp_ + ((d0) * 4096 + (ks) * 1024 + 512)); } while (0)
#define GAPA(MF, A0, A1, A2, A3, W0, W1, PW) do { MF; W0; W1; PIN(PW); SBAR(); } while (0)
#define GAPB(MF, X, B, S) do { MF; X[B] = EX(X[B]); X[B + 1] = EX(X[B + 1]); PIN(X); sacc += S[B]; sacc += S[B + 1]; PIN(sacc); SBAR(); } while (0)
#define KRD(G, KS, j) do { if (G) { kload2(kf, kp0 + (KS), j); SBAR(); } } while (0)
#define MF32(a, b, c) __builtin_amdgcn_mfma_f32_32x32x16_bf16(a, b, c, 0, 0, 0)
#define PHASE_A(C0, C1, P0, P1, VS) do { SBAR(); \
    const lds_cptr vp_ = vp0 + (VS); \
    VRD(0, 0, 0); SBAR(); \
    GAPA(C0 = MF32(kf[0], qr[0], zero), P0[2], P0[3], P0[4], P0[5],     pw0[0] = PKW(P0, 0),  pw0[1] = PKW(P0, 2),  pw0); \
    VRD(1, 1, 0); SBAR(); GAPA(C1 = MF32(kf[1], qr[0], zero), P0[6], P0[7], P0[8], P0[9],     pw0[2] = PKW(P0, 4),  pw0[3] = PKW(P0, 6),  pw0); \
    VRD(2, 2, 0); SBAR(); GAPA(C0 = MF32(kf[2], qr[1], C0),   P0[10], P0[11], P0[12], P0[13], pw1[0] = PKW(P0, 8),  pw1[1] = PKW(P0, 10), pw1); \
    VRD(3, 3, 0); SBAR(); GAPA(C1 = MF32(kf[3], qr[1], C1),   P0[14], P0[15], P1[0], P1[1],   pw1[2] = PKW(P0, 12), pw1[3] = PKW(P0, 14), pw1); \
    VRD(4, 0, 1); SBAR(); GAPA(C0 = MF32(kf[4], qr[2], C0),   P1[2], P1[3], P1[4], P1[5],     pw2[0] = PKW(P1, 0),  pw2[1] = PKW(P1, 2),  pw2); \
    VRD(5, 1, 1); SBAR(); GAPA(C1 = MF32(kf[5], qr[2], C1),   P1[6], P1[7], P1[8], P1[9],     pw2[2] = PKW(P1, 4),  pw2[3] = PKW(P1, 6),  pw2); \
    VRD(6, 2, 1); SBAR(); GAPA(C0 = MF32(kf[6], qr[3], C0),   P1[10], P1[11], P1[12], P1[13], pw3[0] = PKW(P1, 8),  pw3[1] = PKW(P1, 10), pw3); \
    VRD(7, 3, 1); SBAR(); GAPA(C1 = MF32(kf[7], qr[3], C1),   P1[14], P1[15], 0.f, 0.f,       pw3[2] = PKW(P1, 12), pw3[3] = PKW(P1, 14), pw3); \
    SBAR(); } while (0)
#define PHASE_B(X0, X1, S0, S1, VS, KS, GL) do { SBAR(); \
    const lds_cptr vp_ = vp0 + (VS); float sacc = 0.f; \
    GAPB(o[0] = MF32(PAF(0), VFR(0), o[0]), X0, 0, S0);  VRD(0, 0, 2); SBAR(); \
    GAPB(o[1] = MF32(PAF(0), VFR(1), o[1]), X0, 2, S0);  VRD(1, 1, 2); SBAR(); \
    GAPB(o[2] = MF32(PAF(0), VFR(2), o[2]), X0, 4, S0);  VRD(2, 2, 2); SBAR(); \
    GAPB(o[3] = MF32(PAF(0), VFR(3), o[3]), X0, 6, S0);  VRD(3, 3, 2); SBAR(); KRD(GL, KS, 0); \
    GAPB(o[0] = MF32(PAF(1), VFR(4), o[0]), X0, 8, S0);  VRD(4, 0, 3); SBAR(); KRD(GL, KS, 1); \
    GAPB(o[1] = MF32(PAF(1), VFR(5), o[1]), X0, 10, S0); VRD(5, 1, 3); SBAR(); KRD(GL, KS, 2); \
    GAPB(o[2] = MF32(PAF(1), VFR(6), o[2]), X0, 12, S0); VRD(6, 2, 3); SBAR(); KRD(GL, KS, 3); \
    GAPB(o[3] = MF32(PAF(1), VFR(7), o[3]), X0, 14, S0); VRD(7, 3, 3); SBAR(); \
    GAPB(o[0] = MF32(PAF(2), VFR(0), o[0]), X1, 0, S1); \
    GAPB(o[1] = MF32(PAF(2), VFR(1), o[1]), X1, 2, S1); \
    GAPB(o[2] = MF32(PAF(2), VFR(2), o[2]), X1, 4, S1); \
    GAPB(o[3] = MF32(PAF(2), VFR(3), o[3]), X1, 6, S1); \
    GAPB(o[0] = MF32(PAF(3), VFR(4), o[0]), X1, 8, S1); \
    GAPB(o[1] = MF32(PAF(3), VFR(5), o[1]), X1, 10, S1); \
    GAPB(o[2] = MF32(PAF(3), VFR(6), o[2]), X1, 12, S1); \
    GAPB(o[3] = MF32(PAF(3), VFR(7), o[3]), X1, 14, S1); \
    l_reg += sacc; } while (0)
#define DMA_T(t) do { if ((t) + 3 < NT) { DMA_K((t) + 3, s_m1); } if ((t) + 1 < NT) { DMA_V((t) + 1, s_p1); } } while (0)
#define ENDW(tt) do { if ((tt) + 3 < NT) { WAIT_BAR(4); } else if ((tt) + 1 < NT) { WAIT_BAR(2); } else { WAIT_BAR(0); } } while (0)
#define DMA_F(t) do { DMA_K((t) + 3, s_m1); DMA_V((t) + 1, s_p1); } while (0)
    if (map == 0) {
        __builtin_amdgcn_s_setprio(1);
        PATH_ENTRY();
        int t = 1;
#pragma clang loop unroll(disable)
        for (; t + 5 < NT; t += 2) {
            PHASE_A(pB0, pB1, pA0, pA1, s_m1); DMA_F(t);     PHASE_B(pB0, pB1, pA0, pA1, s_m1, s_p1, true); WAIT_BAR(4); ROT4();
            PHASE_A(pA0, pA1, pB0, pB1, s_m1); DMA_F(t + 1); PHASE_B(pA0, pA1, pB0, pB1, s_m1, s_p1, true); WAIT_BAR(4); ROT4();
        }
#pragma clang loop unroll(disable)
        for (; t + 1 < NT; t += 2) {
            PHASE_A(pB0, pB1, pA0, pA1, s_m1); DMA_T(t);     PHASE_B(pB0, pB1, pA0, pA1, s_m1, s_p1, true); ENDW(t);     ROT4();
            PHASE_A(pA0, pA1, pB0, pB1, s_m1); DMA_T(t + 1); PHASE_B(pA0, pA1, pB0, pB1, s_m1, s_p1, true); ENDW(t + 1); ROT4();
        }
        PHASE_A(pB0, pB1, pA0, pA1, s_m1); PHASE_B(pB0, pB1, pA0, pA1, s_m1, s_p1, false); WAIT_BAR(0);
        __builtin_amdgcn_s_setprio(0);
    } else {
        PATH_ENTRY();
        DMA_T(1); PHASE_A(pB0, pB1, pA0, pA1, s_m1); ENDW(1); ROT4();
        int t = 2;
#pragma clang loop unroll(disable)
        for (; t + 5 < NT; t += 2) {
            PHASE_B(pB0, pB1, pA0, pA1, s_m2, s_0, true); DMA_F(t);     PHASE_A(pA0, pA1, pB0, pB1, s_m1); WAIT_BAR(4); ROT4();
            PHASE_B(pA0, pA1, pB0, pB1, s_m2, s_0, true); DMA_F(t + 1); PHASE_A(pB0, pB1, pA0, pA1, s_m1); WAIT_BAR(4); ROT4();
        }
#pragma clang loop unroll(disable)
        for (; t + 1 < NT; t += 2) {
            PHASE_B(pB0, pB1, pA0, pA1, s_m2, s_0, true); DMA_T(t);     PHASE_A(pA0, pA1, pB0, pB1, s_m1); ENDW(t);     ROT4();
            PHASE_B(pA0, pA1, pB0, pB1, s_m2, s_0, true); DMA_T(t + 1); PHASE_A(pB0, pB1, pA0, pA1, s_m1); ENDW(t + 1); ROT4();
        }
        PHASE_B(pB0, pB1, pA0, pA1, s_m2, s_0, false);
        s_0 = s_m1;
    }
#undef DMA_F
#undef PATH_ENTRY
    WAIT_BAR(0);
    { float sacc = pB0[0] + pB0[1];
#pragma unroll
      for (int r = 2; r < 16; ++r) sacc += pB0[r];
#pragma unroll
      for (int r = 0; r < 16; ++r) sacc += pB1[r];
      l_reg += sacc;
      pw0 = (u32x4){PKW(pB0, 0), PKW(pB0, 2), PKW(pB0, 4), PKW(pB0, 6)}; pw1 = (u32x4){PKW(pB0, 8), PKW(pB0, 10), PKW(pB0, 12), PKW(pB0, 14)};
      pw2 = (u32x4){PKW(pB1, 0), PKW(pB1, 2), PKW(pB1, 4), PKW(pB1, 6)}; pw3 = (u32x4){PKW(pB1, 8), PKW(pB1, 10), PKW(pB1, 12), PKW(pB1, 14)};
      SBAR();
      const lds_cptr vp_ = vp0 + s_0;
#pragma unroll
      for (int d0 = 0; d0 < 4; ++d0) {
          VRD(0, d0, 0); VRD(1, d0, 1); VRD(2, d0, 2); VRD(3, d0, 3);
          o[d0] = MF32(PAF(0), VFR(0), o[d0]); o[d0] = MF32(PAF(1), VFR(1), o[d0]); o[d0] = MF32(PAF(2), VFR(2), o[d0]); o[d0] = MF32(PAF(3), VFR(3), o[d0]); } }
#undef PKW
#undef PAF
#undef VFR
#undef PIN
#undef EX
#undef VRD
#undef GAPA
#undef GAPB
#undef KRD
#undef MF32
#undef PHASE_A
#undef PHASE_B
#undef DMA_T
#undef ENDW
#undef ROT4
#undef DMA_K
#undef DMA_V
    int tid2; asm volatile("v_mbcnt_lo_u32_b32 %0, -1, 0\n\tv_mbcnt_hi_u32_b32 %0, -1, %0" : "=v"(tid2)); tid2 += wid * 64;
    { const int wid = tid2 >> 6, lane = tid2 & 63, r32 = lane & 31, hi = lane >> 5, wq = wid & 3, map = wid >> 2;
    float* li_l = (float*)(shm + LDS_WS) + wid * 64;
    const float* SC2 = SC; asm volatile("" : "+s"(SC2));
    const float lam = SC2[0], lam_init = SC2[2];
    const size_t rowb = (size_t)((cx ? M + b * CL : b * L) + q0 + wq * QBLK);
    u32x4 gt[8];
    if (map == 0) {
        const bf16* gp = PB + (rowb + (lane >> 4)) * IN_W + G_OFF + 512 + h * 128 + (lane & 15) * 8;
#pragma unroll
        for (int i = 0; i < 8; ++i) gt[i] = *(const u32x4*)(gp + (size_t)(4 * i) * IN_W);
    }
    l_reg = half_swap_sum(l_reg);
    if (hi == 0) li_l[r32] = l_reg;
    asm volatile("s_waitcnt lgkmcnt(0)" ::: "memory");
    float rli[16];
#pragma unroll
    for (int r = 0; r < 16; ++r) rli[r] = __builtin_amdgcn_rcpf(li_l[crow(r, hi)]);
    __syncthreads();
    float* X = (float*)shm + wq * 4096;
    bf16* GY = (bf16*)(shm + LDS_V) + wq * 4096;
    if (map == 1) {
#pragma unroll
        for (int r = 0; r < 16; ++r)
#pragma unroll
            for (int d0 = 0; d0 < 4; ++d0) X[crow(r, hi) * 128 + d0 * 32 + r32] = o[d0][r] * rli[r];
    } else {
#pragma unroll
        for (int i = 0; i < 8; ++i) *(u32x4*)(GY + ((lane >> 4) + 4 * i) * 128 + (lane & 15) * 8) = gt[i];
    }
    __syncthreads();
    if (map == 0) {
        const float oml = 1.f - lam_init;
        float sg[4];
#pragma unroll
        for (int d0 = 0; d0 < 4; ++d0) sg[d0] = subg[d0 * 32 + r32] * oml;
#pragma unroll
        for (int r = 0; r < 16; ++r) {
            const int qrow = crow(r, hi);
            float v[4], ss = 0.f;
#pragma unroll
            for (int d0 = 0; d0 < 4; ++d0) { v[d0] = o[d0][r] * rli[r] - lam * X[qrow * 128 + d0 * 32 + r32]; ss += v[d0] * v[d0]; }
            ss = sum32(ss);
            const float rs = __builtin_amdgcn_rsqf(ss * (1.f / 128.f) + EPS);
            bf16* gy = GY + qrow * 128 + r32;
#pragma unroll
            for (int d0 = 0; d0 < 4; ++d0) gy[d0 * 32] = (bf16)f2bf(v[d0] * rs * sg[d0] * silu_f(bf2f(gy[d0 * 32])));
        }
        asm volatile("s_waitcnt lgkmcnt(0)" ::: "memory");
        bf16* yp = Y + (rowb + (lane >> 4)) * 1024 + 512 + h * 128 + (lane & 15) * 8;
#pragma unroll
        for (int i = 0; i < 8; ++i) st_wt16(yp + (size_t)(4 * i) * 1024, *(const u32x4*)(GY + ((lane >> 4) + 4 * i) * 128 + (lane & 15) * 8));
    }
    }
    __syncthreads();
}
#undef SBAR
#undef WAIT_BAR
}

constexpr int NWAVES = 8;
constexpr int RING_OFF = 0, RING_BYTES = 131072;
constexpr int LDSCTL_OFF = RING_BYTES, MISC_OFF = LDSCTL_OFF + 320;
constexpr int LDS_BYTES = 147456;
constexpr int CW_BAR = 1024;
constexpr int CW_FFT = 8192;
constexpr int CW_SEAM = 4608;
#define SEAM_HCNT(i) (CW_SEAM + 16 * (i))
#define SEAM_CCNT    (CW_SEAM + 16 * 64)
#define SEAM_MODCNT  (CW_SEAM + 16 * 130)
#define SEAM_PREPCNT (CW_SEAM + 16 * 131)
constexpr int CW_Q = 8192 + 1024;
constexpr int CW_YCNT = 10240;
#define SEAM_YCNT(l, blk) (CW_YCNT + 16 * (66 * (l) + (blk)))
#define SEAM_XCNT(i) (CW_YCNT + 16 * (132 + (i)))
#define SEAM_CXCNT   (CW_YCNT + 16 * 196)
#define SEAM_MIXDONE (CW_YCNT + 16 * 197)
#define SEAM_NQ      (CW_YCNT + 16 * 198)

typedef GAS unsigned gu32;
#define RLX_AGENT __ATOMIC_RELAXED, __HIP_MEMORY_SCOPE_AGENT
#define LDS_WAIT() asm volatile("s_waitcnt lgkmcnt(0)" ::: "memory")
#define VM_WAIT() asm volatile("s_waitcnt vmcnt(0)" ::: "memory")

#define XB_TMO      128
#define XB_XCNT(j)  (256  + 64 * (j))
#define XB_XSUB(j)  (1280 + 64 * (j))
#define XB_XGEN(j)  (2304 + 64 * (j))
#define XB_TOP      3328
#define XB_TOPGEN   3392
#define XCD_BAR_WORDS 3456
#define XB_SPIN_CAP (1u << 18)
__device__ __forceinline__ unsigned xb_ld(unsigned* p)              { return __hip_atomic_load(p, __ATOMIC_RELAXED, __HIP_MEMORY_SCOPE_AGENT); }
__device__ __forceinline__ unsigned xb_add(unsigned* p, unsigned v) { return __hip_atomic_fetch_add(p, v, __ATOMIC_RELAXED, __HIP_MEMORY_SCOPE_AGENT); }
__device__ __forceinline__ unsigned xb_xcc_id() { return (unsigned)__builtin_amdgcn_s_getreg((3 << 11) | 20) & 0xFu; }
#define XB_SPIN(cond, bar) do { unsigned _sp = 0; while (cond) { __builtin_amdgcn_s_sleep(1); \
    if ((++_sp & 255u) == 0u) { if (xb_ld(&(bar)[XB_TMO])) break; if (_sp > XB_SPIN_CAP) { atomicAdd(&(bar)[XB_TMO], 1u); break; } } } } while (0)
struct XcdBarrier { unsigned* bar; unsigned x; volatile LAS unsigned* st; };
__device__ __forceinline__ XcdBarrier xcd_barrier_post(unsigned* bar, volatile LAS unsigned* st) {
    XcdBarrier b; b.bar = bar; b.x = xb_xcc_id(); b.st = st;
    if (threadIdx.x == 0) (void)xb_add(&bar[XB_XCNT(b.x)], 1u);
    return b;
}
__device__ __forceinline__ void xcd_barrier_complete(unsigned* bar, unsigned x, unsigned& nloc, unsigned& nx) {
    const unsigned G = gridDim.x * gridDim.y * gridDim.z;
    unsigned sum, cnt, mine, sp = 0u;
    for (;;) {
        sum = 0u; cnt = 0u; mine = 0u;
#pragma unroll 1
        for (unsigned j = 0; j < 16; ++j) { const unsigned c = xb_ld(&bar[XB_XCNT(j)]); sum += c; cnt += (c > 0u) ? 1u : 0u; mine = (j == x) ? c : mine; }
        if (sum == G) break;
        __builtin_amdgcn_s_sleep(1);
        if ((++sp & 255u) == 0u) { if (xb_ld(&bar[XB_TMO])) break; if (sp > XB_SPIN_CAP) { atomicAdd(&bar[XB_TMO], 1u); break; } }
    }
    nloc = mine > 0u ? mine : 1u; nx = cnt > 0u ? cnt : 1u;
}
__device__ __forceinline__ void xcd_barrier(const XcdBarrier& b) {
    asm volatile("s_waitcnt vmcnt(0)" ::: "memory");
    __syncthreads();
    if (threadIdx.x == 0) {
        unsigned* bar = b.bar;
        __builtin_amdgcn_s_waitcnt(0);
        unsigned nloc = b.st[0], nx = b.st[1];
        if (nloc == 0u) { xcd_barrier_complete(bar, b.x, nloc, nx); b.st[0] = nloc; b.st[1] = nx; }
        const unsigned old = xb_add(&bar[XB_XSUB(b.x)], 1u);
        const unsigned gen = old / nloc;
        if (old + 1u == (gen + 1u) * nloc) {
            __builtin_amdgcn_fence(__ATOMIC_RELEASE, "agent");
            asm volatile("s_waitcnt vmcnt(0)" ::: "memory");
            const unsigned og = xb_add(&bar[XB_TOP], 1u);
            const unsigned tg = og / nx;
            if (og + 1u == (tg + 1u) * nx) xb_add(&bar[XB_TOPGEN], 1u);
            else XB_SPIN(xb_ld(&bar[XB_TOPGEN]) == tg, bar);
            __builtin_amdgcn_fence(__ATOMIC_ACQUIRE, "agent");
            xb_add(&bar[XB_XGEN(b.x)], 1u);
            asm volatile("s_waitcnt vmcnt(0)" ::: "memory");
        } else {
            XB_SPIN(xb_ld(&bar[XB_XGEN(b.x)]) == gen, bar);
            __builtin_amdgcn_fence(__ATOMIC_ACQUIRE, "agent");
            asm volatile("s_waitcnt vmcnt(0)" ::: "memory");
        }
    }
    __syncthreads();
}

struct Args {
    const float* in[15]; float* out; unsigned char* ws; int ph_lo, ph_hi, skip, pad;
};

struct Frame {
    LAS unsigned char* lds;
    int tid, lane, wave, vcu, G;
};

__device__ __forceinline__ void p0_transpose_item(const float* W, int K, int N, bf16* WT, LAS float* scr, int item, int lane) {
    const int nblk = N / 32, kb = item / nblk, nb = item % nblk, k0 = 64 * kb, n0 = 32 * nb;
    float tv[32];
#pragma unroll
    for (int i = 0; i < 32; ++i) { const int kk = 2 * i + (lane >> 5); tv[i] = W[(size_t)(k0 + kk) * N + n0 + (lane & 31)]; }
#pragma unroll
    for (int i = 0; i < 32; ++i) { const int kk = 2 * i + (lane >> 5); scr[kk * 33 + (lane & 31)] = tv[i]; }
    LDS_WAIT(); asm volatile("" ::: "memory");
    const int c = lane & 7;
#pragma unroll
    for (int j = 0; j < 4; ++j) { const int n = (lane >> 3) + 8 * j; const LAS float* s = scr + (8 * c) * 33 + n;
        u32x4 o; o.x = pk2(s[0 * 33], s[1 * 33]); o.y = pk2(s[2 * 33], s[3 * 33]); o.z = pk2(s[4 * 33], s[5 * 33]); o.w = pk2(s[6 * 33], s[7 * 33]);
        st_wt16(WT + (size_t)(n0 + n) * K + k0 + 8 * c, o); }
    LDS_WAIT(); asm volatile("" ::: "memory");
}

__device__ __forceinline__ void phase_mod(Frame& F, const __attribute__((address_space(4))) Args* ap, unsigned char* ws) {
    const float* c = ap->in[1]; const float* c_ctx = ap->in[3]; const float* w_mod = ap->in[5]; const float* b_mod = ap->in[6]; const float* qk_norm_g = ap->in[11]; const float* lam_vecs = ap->in[12];
    float* MODP = (float*)(ws + WS_MOD); float* SC = (float*)(ws + WS_SC);
    LAS float* red = (LAS float*)F.lds;
    LAS float* scl = (LAS float*)(F.lds + 8192);
    if ((int)blockIdx.x * 2 < DEPTH * 48 * 4) {
#pragma unroll
        for (int i = 0; i < 6; ++i) { const int idx = F.tid + 512 * i, v = idx >> 10, k = idx & 1023; scl[idx] = silu_f(v == 2 ? c_ctx[k] : c[v * 1024 + k]); }
    }
    __syncthreads();
    const int half = F.wave >> 2, w4 = F.wave & 3;
    for (int t0 = blockIdx.x * 2; t0 < DEPTH * 48 * 4; t0 += 2 * F.G) {
        const int task = t0 + half;
        const int kq = task & 3, lc = task >> 2, l = lc / 48, chunk = lc % 48, j = chunk * 64 + F.lane;
        const float* W = w_mod + (size_t)l * 1024 * 3072 + j;
        float a0 = 0.f, a1 = 0.f, a2 = 0.f;
        const int k0 = kq * 256 + w4 * 64;
        float wv[64];
#pragma unroll
        for (int i = 0; i < 64; ++i) wv[i] = W[(size_t)(k0 + i) * 3072];
#pragma unroll
        for (int i = 0; i < 64; i += 4) {
            const f32x4 s0 = *(const LAS f32x4*)(scl + k0 + i), s1 = *(const LAS f32x4*)(scl + 1024 + k0 + i), s2 = *(const LAS f32x4*)(scl + 2048 + k0 + i);
            a0 += s0.x * wv[i] + s0.y * wv[i + 1] + s0.z * wv[i + 2] + s0.w * wv[i + 3];
            a1 += s1.x * wv[i] + s1.y * wv[i + 1] + s1.z * wv[i + 2] + s1.w * wv[i + 3];
            a2 += s2.x * wv[i] + s2.y * wv[i + 1] + s2.z * wv[i + 2] + s2.w * wv[i + 3]; }
        __syncthreads();
        red[(F.wave * 3 + 0) * 64 + F.lane] = a0; red[(F.wave * 3 + 1) * 64 + F.lane] = a1; red[(F.wave * 3 + 2) * 64 + F.lane] = a2;
        __syncthreads();
        { const int t = F.tid & 255;
          if (t < 192) { const int v = t >> 6, ln = t & 63; float s = 0.f;
#pragma unroll
            for (int w = 0; w < 4; ++w) s += red[((half * 4 + w) * 3 + v) * 64 + ln];
            const int jj = chunk * 64 + ln;
            __hip_atomic_store(MODP + kq * MODQ + (l * 3 + v) * 3072 + jj, s + (kq == 0 ? b_mod[l * 3072 + jj] : 0.f), __ATOMIC_RELAXED, __HIP_MEMORY_SCOPE_AGENT); } }
        asm volatile("s_waitcnt vmcnt(0)" ::: "memory");
        __syncthreads();
        if (F.tid == 0) (void)__hip_atomic_fetch_add((gu32*)(ws + WS_CTL) + SEAM_MODCNT, 2u, __ATOMIC_RELAXED, __HIP_MEMORY_SCOPE_AGENT);
    }
    __syncthreads();
    if (blockIdx.x == 0 && F.wave < DEPTH) {
        int l = F.wave; asm volatile("" : "+s"(l)); const int lane = F.lane; const float* lv = lam_vecs + l * 256;
        const float sa = wave_sum(lv[lane] * lv[64 + lane]), sb = wave_sum(lv[128 + lane] * lv[192 + lane]);
        const float lam_init = l == 0 ? 0.2f : 0.8f - 0.6f * 0.7408182206817179f;
        float gq = fabsf(qk_norm_g[l * 128 + lane]), gk = fabsf(qk_norm_g[l * 128 + 64 + lane]);
        gq = wave_max(gq); gk = wave_max(gk);
        if (lane == 0) { SC[l * 4 + 0] = expf(sa) - expf(sb) + lam_init; SC[l * 4 + 1] = 8.f * gq * gk; SC[l * 4 + 2] = lam_init; }
    }
}
__device__ __forceinline__ void phase_prep(Frame& F, const __attribute__((address_space(4))) Args* ap, unsigned char* ws) {
    const float* w_in = ap->in[7]; const float* w_fourier = ap->in[8]; const float* w_pool = ap->in[9]; const float* w_out = ap->in[14];
    float* ROPE = (float*)(ws + WS_ROPE); float* TW = (float*)(ws + WS_TW);
    bf16* WF = (bf16*)(ws + WS_WF); bf16* WP = (bf16*)(ws + WS_WP); bf16* WIN = (bf16*)(ws + WS_WIN); bf16* WOUT = (bf16*)(ws + WS_WOUT);
    {
        LAS float* scr = (LAS float*)(F.lds + F.wave * 12288);
        const int gw = F.vcu * NWAVES + F.wave, NGW = F.G * NWAVES;
        constexpr int I_IN = (D / 64) * (IN_W / 32), I_OUT = (D / 64) * (D / 32);
        constexpr int NITEMS = DEPTH * (I_IN + I_OUT);
        for (int it = gw; it < NITEMS; it += NGW) {
            int r = it;
            if (r < DEPTH * I_IN) { const int l = r / I_IN; p0_transpose_item(w_in + (size_t)l * D * IN_W, D, IN_W, WIN + (size_t)l * IN_W * D, scr, r % I_IN, F.lane); continue; }
            r -= DEPTH * I_IN;
            { const int l = r / I_OUT; p0_transpose_item(w_out + (size_t)l * D * D, D, D, WOUT + (size_t)l * D * D, scr, r % I_OUT, F.lane); }
        }
    }
    {
        const int gt = blockIdx.x * 512 + F.tid, NGT = F.G * 512;
        LAS float* cst = (LAS float*)(F.lds + 98304);
        __syncthreads();
        if (F.tid < 64) { float sv, cv; sincospif((float)F.tid / 32.f, &sv, &cv); cst[2 * F.tid] = cv; cst[2 * F.tid + 1] = sv; }
        __syncthreads();
        for (int i = gt; i < DEPTH * 4 * 64 * 128; i += NGT) {
            const int k = i & 127, n = (i >> 7) & 63, lg = i >> 13; const int cc = k >> 1; const int sn = k & 1;
            const float* wf = w_fourier + (size_t)lg * 64 * 64 + n;
            float s = 0.f;
#pragma unroll 16
            for (int m = 0; m < 64; ++m) s += cst[2 * ((cc * m) & 63) + sn] * wf[m * 64];
            WF[i] = (bf16)f2bf(s);
        }
        for (int i = gt; i < DEPTH * 4 * 64 * 64; i += NGT) { const int k = i & 63, n = (i >> 6) & 63, lg = i >> 12; WP[i] = (bf16)f2bf(w_pool[(size_t)lg * 4096 + k * 64 + n]); }
        for (int i = gt; i < 128 * 16; i += NGT) { const int pos = i >> 4, j = i & 15; const float inv = powf(10000.f, -(float)j / 16.f), ang = (float)pos * inv; __hip_atomic_store((unsigned long long*)(ROPE + 2 * i), (unsigned long long)__builtin_bit_cast(unsigned, cosf(ang)) | ((unsigned long long)__builtin_bit_cast(unsigned, sinf(ang)) << 32), __ATOMIC_RELAXED, __HIP_MEMORY_SCOPE_AGENT); }
        for (int i = gt; i < 8191; i += NGT) { const int half = 1 << (31 - __clz(i + 1)), pos = i + 1 - half; float sv, cv; sincospif(-(float)pos / (float)half, &sv, &cv); TW[2 * i] = cv; TW[2 * i + 1] = sv; }
    }
}

template <int NR, bool WT>
__device__ __forceinline__ void nm_rows(const float* x0, bf16* h0, const float* ng, const float* md, int lane) {
    f32x4 v[NR][4];
#pragma unroll
    for (int q = 0; q < NR; ++q) { const float* xr = x0 + (size_t)q * D + 4 * lane;
#pragma unroll
        for (int j = 0; j < 4; ++j) v[q][j] = *(const f32x4*)(xr + 256 * j); }
    f32x4 a[4], c[4];
#pragma unroll
    for (int j = 0; j < 4; ++j) { const int k = 4 * lane + 256 * j; a[j] = *(const f32x4*)(ng + k) * (mod4(md + 1024 + k) + 1.f); c[j] = mod4(md + k); }
    asm volatile("" ::: "memory");
#pragma unroll
    for (int q = 0; q < NR; ++q) {
        float s = 0.f;
#pragma unroll
        for (int j = 0; j < 4; ++j) s += (v[q][j].x * v[q][j].x + v[q][j].y * v[q][j].y) + (v[q][j].z * v[q][j].z + v[q][j].w * v[q][j].w);
        const float rstd = 1.0f / sqrtf(wave_sum(s) * (1.f / D) + EPS);
        unsigned long long* o8 = (unsigned long long*)(h0 + (size_t)q * D) + lane;
#pragma unroll
        for (int j = 0; j < 4; ++j) { const f32x4 y = v[q][j] * rstd * a[j] + c[j];
            const unsigned long long w = (unsigned long long)pk2(y.x, y.y) | ((unsigned long long)pk2(y.z, y.w) << 32);
            if (WT) __hip_atomic_store(o8 + 64 * j, w, __ATOMIC_RELAXED, __HIP_MEMORY_SCOPE_AGENT); else o8[64 * j] = w; } }
}
template <bool SEAM>
__device__ __forceinline__ void phase_normmod(Frame& F, const float* xin, const float* cin, const float* ng, const float* mod, bf16* H, gu32* ctl) {
    const int gw = F.vcu * NWAVES + F.wave, NGW = F.G * NWAVES;
    for (int blk = gw; blk < M / 8; blk += NGW) {
        const int r0 = blk * 8;
        nm_rows<8, SEAM>(xin + (size_t)r0 * D, H + (size_t)r0 * D, ng, mod + (r0 / L) * 3072, F.lane);
        if (SEAM) { asm volatile("s_waitcnt vmcnt(0)" ::: "memory"); if (F.lane == 0) (void)__hip_atomic_fetch_add(ctl + SEAM_HCNT(r0 >> 8), 1u, __ATOMIC_RELAXED, __HIP_MEMORY_SCOPE_AGENT); }
    }
    for (int r = M + gw; r < MT; r += NGW) {
        nm_rows<1, SEAM>(cin + (size_t)(r - M) * D, H + (size_t)r * D, ng, mod + 2 * 3072, F.lane);
        if (SEAM) { asm volatile("s_waitcnt vmcnt(0)" ::: "memory"); if (F.lane == 0) (void)__hip_atomic_fetch_add(ctl + SEAM_CCNT, 1u, __ATOMIC_RELAXED, __HIP_MEMORY_SCOPE_AGENT); }
    }
}
__device__ __forceinline__ void seam_wait_ge(gu32* cnt, unsigned want);
__device__ __forceinline__ void phase_normmod_jobs(Frame& F, volatile LAS unsigned* MISC, const float* x1, const float* c1, const float* ng, const float* mod, bf16* H, gu32* ctl_seam, gu32* ctlbase) {
#pragma unroll 1
    for (;;) {
        if (F.tid == 0) MISC[46] = __hip_atomic_fetch_add(ctlbase + SEAM_NQ, 1u, __ATOMIC_RELAXED, __HIP_MEMORY_SCOPE_AGENT);
        __syncthreads();
        const int j = __builtin_amdgcn_readfirstlane((int)MISC[46]);
        __syncthreads();
        if (j >= 256 + 8) break;
        if (F.tid == 0) { if (j < 256) seam_wait_ge(ctlbase + SEAM_XCNT(j >> 2), 4u); else seam_wait_ge(ctlbase + SEAM_CXCNT, 256u); }
        asm volatile("" ::: "memory");
        __syncthreads();
        const bool lat = j < 256; const int r0 = 64 * (lat ? j : j - 256) + 8 * F.wave;
        const float* xs = (lat ? x1 : c1) + (size_t)r0 * D; bf16* hs = H + (size_t)(lat ? r0 : M + r0) * D;
        const float* md = mod + (lat ? r0 / L : 2) * 3072; gu32* cnt = ctl_seam + (lat ? SEAM_HCNT(r0 >> 8) : SEAM_CCNT);
        nm_rows<8, true>(xs, hs, ng, md, F.lane);
        asm volatile("s_waitcnt vmcnt(0)" ::: "memory"); if (F.lane == 0) (void)__hip_atomic_fetch_add(cnt, lat ? 1u : 8u, __ATOMIC_RELAXED, __HIP_MEMORY_SCOPE_AGENT);
    }
}
__device__ __forceinline__ void seam_wait_ge(gu32* cnt, unsigned want) { unsigned sp = 0; while (__hip_atomic_load(cnt, __ATOMIC_RELAXED, __HIP_MEMORY_SCOPE_AGENT) < want) { __builtin_amdgcn_s_sleep(8); if (++sp > (1u << 20)) break; } }

__device__ __forceinline__ void phase_qkprep(Frame& F, bf16* PB, const float* qkg, const float* ROPE, int nrows) {
    const int gw = F.vcu * NWAVES + F.wave, NGW = F.G * NWAVES;
    const int g8 = F.lane & 7;
    for (int r = gw; r < nrows; r += NGW) {
        const bool isc = r >= M; const int t = r & (L - 1), pr = t >> 6, pc = t & 63;
#pragma unroll
        for (int part = 0; part < 2; ++part) {
            bf16* p = PB + (size_t)r * IN_W + (part ? K_OFF : Q_OFF) + F.lane * 8;
            const u32x4 w = *(const u32x4*)p;
            float x[8] = {bflo(w.x), bfhi(w.x), bflo(w.y), bfhi(w.y), bflo(w.z), bfhi(w.z), bflo(w.w), bfhi(w.w)};
            float ss = 0.f;
#pragma unroll
            for (int e = 0; e < 8; ++e) ss += x[e] * x[e];
            ss += sxor<1>(ss); ss += sxor<2>(ss); ss += sxor<4>(ss);
            const float rs = 1.0f / sqrtf(ss * (1.f / 64.f) + EPS);
            const f32x4 ga = *(const f32x4*)(qkg + part * 64 + g8 * 8), gb = *(const f32x4*)(qkg + part * 64 + g8 * 8 + 4);
            const float gg[8] = {ga.x, ga.y, ga.z, ga.w, gb.x, gb.y, gb.z, gb.w};
            float y[8];
#pragma unroll
            for (int e = 0; e < 8; ++e) y[e] = x[e] * rs * gg[e];
            if (!isc) {
                const int ax = g8 >> 2, ph = (g8 >> 1) & 1, jb = 8 * (g8 & 1);
                const float* rp = ROPE + ((ax ? pc : pr) * 16 + jb) * 2;
                const f32x4 c0 = *(const f32x4*)(rp), c1 = *(const f32x4*)(rp + 4), c2 = *(const f32x4*)(rp + 8), c3 = *(const f32x4*)(rp + 12);
                const float cs[8] = {c0.x, c0.z, c1.x, c1.z, c2.x, c2.z, c3.x, c3.z}, sn[8] = {c0.y, c0.w, c1.y, c1.w, c2.y, c2.w, c3.y, c3.w};
#pragma unroll
                for (int e = 0; e < 8; ++e) { const float other = sxor<2>(y[e]); y[e] = ph ? (y[e] * cs[e] + other * sn[e]) : (y[e] * cs[e] - other * sn[e]); }
            }
            if (part == 0) {
#pragma unroll
                for (int e = 0; e < 8; ++e) y[e] *= 0.125f * LOG2E;
            }
            u32x4 o; o.x = pk2(y[0], y[1]); o.y = pk2(y[2], y[3]); o.z = pk2(y[4], y[5]); o.w = pk2(y[6], y[7]);
            *(u32x4*)p = o;
        }
    }
}

#define FSW(j) ((j) ^ (((j) >> 7) & 31))
__device__ __forceinline__ void fft13_item(Frame& F, const unsigned* at, u32x2* ut, const float* TW) {
    int tid = F.tid; asm volatile("" : "+v"(tid));
    typedef float f32x2v __attribute__((ext_vector_type(2)));
    LAS f32x2v* z = (LAS f32x2v*)F.lds;
    unsigned v[16]; f32x2v wp[3][2], wf[4];
#pragma unroll
    for (int k = 0; k < 16; ++k) v[k] = at[tid + 512 * k];
#pragma unroll
    for (int pi = 0; pi < 3; ++pi) { const int h = 8 << (3 * pi);
#pragma unroll
        for (int q = 0; q < 2; ++q) wp[pi][q] = *(const f32x2v*)(TW + 2 * (4 * h - 1 + ((tid + 512 * q) & (h - 1)))); }
    asm volatile("" ::: "memory");
#define BF1(p, r)  do { const f32x2v t_ = x[r]; x[r] = x[p] - t_; x[p] = x[p] + t_; } while (0)
#define BFMI(p, r) do { const f32x2v t_ = {x[r].y, -x[r].x}; x[r] = x[p] - t_; x[p] = x[p] + t_; } while (0)
#define BFW1(p, r) do { const f32x2v t_ = {(x[r].x + x[r].y) * 0.70710678118654752f, (x[r].y - x[r].x) * 0.70710678118654752f}; x[r] = x[p] - t_; x[p] = x[p] + t_; } while (0)
#define BFW3(p, r) do { const f32x2v t_ = {(x[r].y - x[r].x) * 0.70710678118654752f, -(x[r].x + x[r].y) * 0.70710678118654752f}; x[r] = x[p] - t_; x[p] = x[p] + t_; } while (0)
#define CMUL(w, b) ((f32x2v){(w).x * (b).x - (w).y * (b).y, (w).x * (b).y + (w).y * (b).x})
#define BFLY(p, r, w) do { const f32x2v t_ = CMUL(w, x[r]); x[r] = x[p] - t_; x[p] = x[p] + t_; } while (0)
#pragma unroll
    for (int g = 0; g < 2; ++g) {
        f32x2v x[8];
#pragma unroll
        for (int j = 0; j < 8; ++j) { const int q = ((j & 1) << 2) | (j & 2) | (j >> 2); x[j] = (f32x2v){bflo(v[2 * q + g]), bfhi(v[2 * q + g])}; }
        BF1(0, 1); BF1(2, 3); BF1(4, 5); BF1(6, 7);
        BF1(0, 2); BF1(4, 6); BFMI(1, 3); BFMI(5, 7);
        BF1(0, 4); BFW1(1, 5); BFMI(2, 6); BFW3(3, 7);
        const int m8 = (int)(__brev((unsigned)(tid + 512 * g)) >> 22) << 3;
#pragma unroll
        for (int j = 0; j < 8; ++j) z[FSW(m8 + j)] = x[j];
    }
    __syncthreads();
#pragma unroll
    for (int pi = 0; pi < 3; ++pi) {
        const int s = 4 + 3 * pi, h = 1 << (s - 1);
        if (pi == 2) {
#pragma unroll
            for (int q = 0; q < 4; ++q) wf[q] = *(const f32x2v*)(TW + 2 * (4095 + tid + 512 * q)); }
#pragma unroll
        for (int q = 0; q < 2; ++q) { const int t = tid + 512 * q;
            const int pos = t & (h - 1), base = ((t >> (s - 1)) << (s + 2)) + pos;
            const f32x2v w3 = wp[pi][q];
            const f32x2v w2 = {w3.x * w3.x - w3.y * w3.y, (w3.x + w3.x) * w3.y};
            const f32x2v w1 = {w2.x * w2.x - w2.y * w2.y, (w2.x + w2.x) * w2.y};
            int e[8]; f32x2v x[8];
#pragma unroll
            for (int j = 0; j < 8; ++j) { e[j] = FSW(base + j * h); x[j] = z[e[j]]; }
            BFLY(0, 1, w1); BFLY(2, 3, w1); BFLY(4, 5, w1); BFLY(6, 7, w1);
            const f32x2v w2b = {w2.y, -w2.x};
            BFLY(0, 2, w2); BFLY(4, 6, w2); BFLY(1, 3, w2b); BFLY(5, 7, w2b);
            const float r2 = 0.70710678118654752f;
            const f32x2v w3a = {(w3.x + w3.y) * r2, (w3.y - w3.x) * r2}, w3b = {w3.y, -w3.x}, w3c = {(w3.y - w3.x) * r2, -(w3.x + w3.y) * r2};
            BFLY(0, 4, w3); BFLY(1, 5, w3a); BFLY(2, 6, w3b); BFLY(3, 7, w3c);
#pragma unroll
            for (int j = 0; j < 8; ++j) z[e[j]] = x[j]; }
        __syncthreads();
    }
#undef BF1
#undef BFMI
#undef BFW1
#undef BFW3
#undef BFLY
    const float sc = 0.5f / sqrtf(8192.f * 64.f);
#define UNPK(kk, za, zb) do { const float ar = ((za).x + (zb).x) * sc, ai = ((za).y - (zb).y) * sc, br = ((za).y + (zb).y) * sc, bi = ((zb).x - (za).x) * sc; \
        __hip_atomic_store((unsigned long long*)(ut + (kk)), (unsigned long long)pk2(ar, ai) | ((unsigned long long)pk2(br, bi) << 32), __ATOMIC_RELAXED, __HIP_MEMORY_SCOPE_AGENT); } while (0)
#pragma unroll
    for (int q = 0; q < 4; ++q) { const int p = tid + 512 * q;
        const int x2 = (4096 - p) & 4095;
        const f32x2v wv = wf[q];
        const f32x2v a1 = z[FSW(p)], b1 = z[FSW(p + 4096)], a2 = z[FSW(x2)], b2 = z[FSW(x2 + 4096)];
        const f32x2v t1 = CMUL(wv, b1);
        const f32x2v w2 = {-wv.x, wv.y};
        const f32x2v t2 = CMUL(w2, b2);
        const f32x2v ZA = a1 + t1, ZB = a1 - t1;
        if (p == 0) { UNPK(0, ZA, ZA); UNPK(4096, ZB, ZB); }
        else {
            const f32x2v ZC = a2 + t2, ZD = a2 - t2;
            UNPK(p, ZA, ZD); UNPK(p + 4096, ZB, ZC); UNPK(x2, ZC, ZB); UNPK(x2 + 4096, ZD, ZA);
        }
    }
    if (tid == 0) {
        const f32x2v a1 = z[FSW(2048)], b1 = z[FSW(6144)];
        const f32x2v t1 = {b1.y, -b1.x};
        const f32x2v ZA = a1 + t1, ZB = a1 - t1;
        UNPK(2048, ZA, ZB); UNPK(6144, ZB, ZA);
    }
#undef UNPK
#undef CMUL
    asm volatile("s_waitcnt vmcnt(0)" ::: "memory");
    __syncthreads();
}

__device__ __forceinline__ void fft_item(Frame& F, const unsigned* at, int logn, u32x2* ut, const float* TW) {
    const int n = 1 << logn, tid = F.tid;
    typedef float f32x2v __attribute__((ext_vector_type(2)));
    LAS f32x2v* z = (LAS f32x2v*)F.lds; LAS float* tw = (LAS float*)(z + 8192);
    for (int i = tid; i < n - 1; i += 512) { const float2 w = *(const float2*)(TW + 2 * i); tw[2 * i] = w.x; tw[2 * i + 1] = w.y; }
    for (int i = tid; i < n; i += 512) { const unsigned v = at[i]; const int j = FSW((int)(__brev((unsigned)i) >> (32 - logn))); z[j] = (f32x2v){bflo(v), bfhi(v)}; }
    __syncthreads();
    int s = 1;
    if (logn & 1) {
        for (int t = tid; t < n / 2; t += 512) { const int i0 = FSW(2 * t), i1 = FSW(2 * t + 1); const f32x2v u_ = z[i0], x_ = z[i1]; z[i0] = u_ + x_; z[i1] = u_ - x_; }
        __syncthreads(); s = 2;
    }
    for (; s <= logn; s += 2) {
        const int h = 1 << (s - 1);
        for (int t = tid; t < n / 4; t += 512) {
            const int pos = t & (h - 1), base = ((t >> (s - 1)) << (s + 1)) + pos;
            const float c1 = tw[2 * (h - 1 + pos)], s1 = tw[2 * (h - 1 + pos) + 1];
            const float c2 = tw[2 * (2 * h - 1 + pos)], s2 = tw[2 * (2 * h - 1 + pos) + 1];
            const int e0 = FSW(base), e1 = FSW(base + h), e2 = FSW(base + 2 * h), e3 = FSW(base + 3 * h);
            const f32x2v z0 = z[e0], z1 = z[e1], z2 = z[e2], z3 = z[e3];
            const float a0r = z0.x, a0i = z0.y, a1r = z1.x, a1i = z1.y, a2r = z2.x, a2i = z2.y, a3r = z3.x, a3i = z3.y;
            const float t1r = a1r * c1 - a1i * s1, t1i = a1r * s1 + a1i * c1, t3r = a3r * c1 - a3i * s1, t3i = a3r * s1 + a3i * c1;
            const float b0r = a0r + t1r, b0i = a0i + t1i, b1r = a0r - t1r, b1i = a0i - t1i, b2r = a2r + t3r, b2i = a2i + t3i, b3r = a2r - t3r, b3i = a2i - t3i;
            const float u2r = b2r * c2 - b2i * s2, u2i = b2r * s2 + b2i * c2;
            const float w3r = b3r * c2 - b3i * s2, w3i = b3r * s2 + b3i * c2;
            z[e0] = (f32x2v){b0r + u2r, b0i + u2i}; z[e2] = (f32x2v){b0r - u2r, b0i - u2i};
            z[e1] = (f32x2v){b1r + w3i, b1i - w3r}; z[e3] = (f32x2v){b1r - w3i, b1i + w3r};
        }
        __syncthreads();
    }
    const float sc = 0.5f / sqrtf((float)n * 64.f);
    for (int k = tid; k < n; k += 512) {
        const int k2 = (n - k) & (n - 1);
        const f32x2v za = z[FSW(k)], zb = z[FSW(k2)]; const float zr = za.x, zi = za.y, wr_ = zb.x, wi_ = zb.y;
        const float ar = (zr + wr_) * sc, ai = (zi - wi_) * sc, br = (zi + wi_) * sc, bi = (wr_ - zr) * sc;
        __hip_atomic_store((unsigned long long*)(ut + k), (unsigned long long)pk2(ar, ai) | ((unsigned long long)pk2(br, bi) << 32), __ATOMIC_RELAXED, __HIP_MEMORY_SCOPE_AGENT);
    }
    asm volatile("s_waitcnt vmcnt(0)" ::: "memory");
    __syncthreads();
}

template <int KG>
__device__ __forceinline__ void group_linear(const LAS bf16* At, int lda, const bf16* W, int g, int rh, int lane, f32x16& acc0, f32x16& acc1) {
    const int r32 = lane & 31, hi = lane >> 5;
    acc0 = f32x16{}; acc1 = f32x16{};
    const LAS bf16* ap = At + (rh * 32 + r32) * lda + g * KG + hi * 8;
    const bf16* wp = W + (size_t)g * 64 * KG + (size_t)r32 * KG + hi * 8;
#pragma unroll
    for (int ks = 0; ks < KG / 16; ++ks) {
        const bf16x8 af = *(const LAS bf16x8*)(ap + ks * 16);
        const bf16x8 b0 = *(const bf16x8*)(wp + ks * 16), b1 = *(const bf16x8*)(wp + 32 * KG + ks * 16);
        acc0 = __builtin_amdgcn_mfma_f32_32x32x16_bf16(af, b0, acc0, 0, 0, 0);
        acc1 = __builtin_amdgcn_mfma_f32_32x32x16_bf16(af, b1, acc1, 0, 0, 0);
    }
}

__device__ __forceinline__ void gated_store_tile(LAS float* X, const f32x16& a0, const f32x16& a1, const bf16* gate, int gstride, bf16* yout, const float* sc, int lane) {
    const int r32 = lane & 31, hi = lane >> 5, ch = lane & 7, rl = lane >> 3;
    u32x4 gt[4];
#pragma unroll
    for (int i = 0; i < 4; ++i) gt[i] = *(const u32x4*)(gate + (size_t)(rl + 8 * i) * gstride + ch * 8);
#pragma unroll
    for (int r = 0; r < 16; ++r) { const int row = att::crow(r, hi); X[row * 64 + r32] = a0[r]; X[row * 64 + 32 + r32] = a1[r]; }
    f32x4 sa = {1.f, 1.f, 1.f, 1.f}, sb = {1.f, 1.f, 1.f, 1.f};
    if (sc) { sa = *(const f32x4*)(sc + ch * 8); sb = *(const f32x4*)(sc + ch * 8 + 4); }
#pragma unroll
    for (int i = 0; i < 4; ++i) {
        const LAS float* xp = X + (rl + 8 * i) * 64 + ch * 8;
        const f32x4 xa = *(const LAS f32x4*)xp * sa, xb = *(const LAS f32x4*)(xp + 4) * sb;
        const u32x4 gq = gt[i];
        u32x4 w;
        w.x = pk2(xa[0] * silu_f(bflo(gq.x)), xa[1] * silu_f(bfhi(gq.x))); w.y = pk2(xa[2] * silu_f(bflo(gq.y)), xa[3] * silu_f(bfhi(gq.y)));
        w.z = pk2(xb[0] * silu_f(bflo(gq.z)), xb[1] * silu_f(bfhi(gq.z))); w.w = pk2(xb[2] * silu_f(bflo(gq.w)), xb[3] * silu_f(bfhi(gq.w)));
        st_wt16(yout + (size_t)(rl + 8 * i) * 1024 + ch * 8, w);
    }
}

template <int W>
__device__ __forceinline__ void pool_strip(const LAS unsigned* B2, LAS bf16* Ao, int tb, int Lr) {
    constexpr int LO = W / 2, HI = W - LO - 1, K0 = 8 - LO, NV = 16 + W - 1;
    unsigned v[NV];
#pragma unroll
    for (int k = 0; k < NV; ++k) v[k] = B2[(K0 + k) * 128];
    float s0 = 0.f, s1 = 0.f;
#pragma unroll
    for (int k = 0; k < W; ++k) { s0 += bflo(v[k]); s1 += bfhi(v[k]); }
#pragma unroll
    for (int i = 0; i < 16; ++i) { const int t = tb + i;
        const int a = max(t - LO, 0), e = min(t + HI, Lr - 1);
        const unsigned c = v[LO + i];
        const float inv = __builtin_amdgcn_rcpf((float)(e - a + 1));
        *(LAS unsigned*)(Ao + i * 264) = pk2(s0 * inv - bflo(c), s1 * inv - bfhi(c));
        if (i < 15) { s0 += bflo(v[i + W]) - bflo(v[i]); s1 += bfhi(v[i + W]) - bfhi(v[i]); } }
}
__device__ __forceinline__ unsigned pool_item(Frame& F, const bf16* PB, bf16* Y, int rb, int Lr, int t0, const bf16* WPl, const float* pscale, gu32* tkq, gu32* pub) {
    LAS bf16* Braw = (LAS bf16*)F.lds;
    LAS bf16* At = (LAS bf16*)(F.lds + 40960);
    const int tid = F.tid;
    for (int i = tid; i < 80 * 32; i += 512) { const int rr = i >> 5, ch = i & 31; const int t = t0 - 8 + rr;
        u32x4 v = {0u, 0u, 0u, 0u}; if (t >= 0 && t < Lr) v = *(const u32x4*)(PB + (size_t)(rb + t) * IN_W + B_OFF + ch * 8);
        *(LAS u32x4*)(Braw + rr * 256 + ch * 8) = v; }
    asm volatile("s_waitcnt vmcnt(0)" ::: "memory");
    __syncthreads();
    if (pub && F.tid == 0) (void)__hip_atomic_fetch_add(pub, 1u, __ATOMIC_RELAXED, __HIP_MEMORY_SCOPE_AGENT);
    {
      const int cp = (F.wave >> 1) * 32 + (F.lane & 31), rq = (F.wave & 1) * 2 + (F.lane >> 5), col = 2 * cp;
      const LAS unsigned* B2 = (const LAS unsigned*)Braw + cp + (rq * 16) * 128;
      LAS bf16* Ao = At + (rq * 16) * 264 + col;
      const int tb = t0 + rq * 16;
      switch (F.wave >> 1) {
        case 0: pool_strip<2>(B2, Ao, tb, Lr); break;
        case 1: pool_strip<4>(B2, Ao, tb, Lr); break;
        case 2: pool_strip<8>(B2, Ao, tb, Lr); break;
        default: pool_strip<16>(B2, Ao, tb, Lr); break;
      } }
    __syncthreads();
    const int g = F.wave >> 1, rh = F.wave & 1, r32 = F.lane & 31, hi = F.lane >> 5;
    f32x16 a0, a1; group_linear<64>(At, 264, WPl, g, rh, F.lane, a0, a1);
    (void)r32; (void)hi;
    __syncthreads();
    unsigned nxt_ = 0u; if (F.tid == 0) nxt_ = __hip_atomic_fetch_add(tkq, 1u, __ATOMIC_RELAXED, __HIP_MEMORY_SCOPE_AGENT);
    { const size_t r0 = (size_t)(rb + t0 + rh * 32);
      gated_store_tile((LAS float*)F.lds + F.wave * 2048, a0, a1, PB + r0 * IN_W + G_OFF + 256 + g * 64, IN_W, Y + r0 * 1024 + 256 + g * 64, pscale + g * 64, F.lane); }
    __syncthreads();
    return nxt_;
}

__device__ __forceinline__ unsigned flin_item(Frame& F, const bf16* PB, const bf16* U, bf16* Y, int row0, const bf16* WFl, gu32* tkq, gu32* pub) {
    LAS bf16* At = (LAS bf16*)F.lds;
    const int tid = F.tid;
    {
      const bool cxs = row0 >= M; const int rr0 = cxs ? row0 - M : row0;
      const int bseg = cxs ? (rr0 >> 8) : (rr0 >> 13), k0 = cxs ? (rr0 & 255) : (rr0 & (L - 1)), nseg = cxs ? CL : L;
      const int p = tid >> 2, q = tid & 3;
      const u32x2* up = (const u32x2*)U + (cxs ? AT_CTX : 0) + ((size_t)(bseg * 128 + p)) * nseg + k0 + q * 16;
      u32x4 v[8];
#pragma unroll
      for (int i = 0; i < 8; ++i) v[i] = *(const u32x4*)(up + 2 * i);
#pragma unroll
      for (int i = 0; i < 8; ++i) { *(LAS u32x2*)(At + (q * 16 + 2 * i) * 520 + p * 4) = (u32x2){v[i].x, v[i].y}; *(LAS u32x2*)(At + (q * 16 + 2 * i + 1) * 520 + p * 4) = (u32x2){v[i].z, v[i].w}; } }
    asm volatile("s_waitcnt vmcnt(0)" ::: "memory");
    __syncthreads();
    if (pub && F.tid == 0) (void)__hip_atomic_fetch_add(pub, 1u, __ATOMIC_RELAXED, __HIP_MEMORY_SCOPE_AGENT);
    const int g = F.wave >> 1, rh = F.wave & 1, r32 = F.lane & 31, hi = F.lane >> 5;
    f32x16 a0, a1; group_linear<128>(At, 520, WFl, g, rh, F.lane, a0, a1);
    (void)r32; (void)hi;
    __syncthreads();
    unsigned nxt_ = 0u; if (F.tid == 0) nxt_ = __hip_atomic_fetch_add(tkq, 1u, __ATOMIC_RELAXED, __HIP_MEMORY_SCOPE_AGENT);
    { const size_t r0 = (size_t)(row0 + rh * 32);
      gated_store_tile((LAS float*)F.lds + F.wave * 2048, a0, a1, PB + r0 * IN_W + G_OFF + g * 64, IN_W, Y + r0 * 1024 + g * 64, nullptr, F.lane); }
    __syncthreads();
    return nxt_;
}


__device__ __forceinline__ void ctx_load(Frame& F, const bf16* A, const bf16* Bt, int rb, int cg, bf16x8 (&a)[8], bf16x8 (&b0)[8], bf16x8 (&b1)[8]) {
    const int lane = F.lane, r32 = lane & 31, hi = lane >> 5, k0 = F.wave * 128;
    const bf16* ap = A + (size_t)(rb * 32 + r32) * D + k0 + hi * 8;
    const bf16* bp = Bt + (size_t)(cg * 64 + r32) * D + k0 + hi * 8;
#pragma unroll
    for (int ks = 0; ks < 8; ++ks) { a[ks] = *(const bf16x8*)(ap + ks * 16); b0[ks] = *(const bf16x8*)(bp + ks * 16); b1[ks] = *(const bf16x8*)(bp + 32 * D + ks * 16); }
}
__device__ __forceinline__ void ctx_mma(const bf16x8 (&a)[8], const bf16x8 (&b0)[8], const bf16x8 (&b1)[8], f32x16& c0, f32x16& c1) {
    c0 = f32x16{}; c1 = f32x16{};
#pragma unroll
    for (int ks = 0; ks < 8; ++ks) { c0 = __builtin_amdgcn_mfma_f32_32x32x16_bf16(a[ks], b0[ks], c0, 0, 0, 0); c1 = __builtin_amdgcn_mfma_f32_32x32x16_bf16(a[ks], b1[ks], c1, 0, 0, 0); }
}
template <int MODE>
__device__ __forceinline__ void ctx_tail(Frame& F, const f32x16& c0, const f32x16& c1, int rb, int cg, bf16* PBc, const float* qkg, const float* res, float* outp, const float* gate, unsigned char* KTp, unsigned char* VTp, unsigned* ATp);
template <int MODE>
__device__ __forceinline__ void ctx_tile(Frame& F, const bf16* A, const bf16* Bt, int rb, int cg, bf16* PBc, const float* qkg, const float* res, float* outp, const float* gate, unsigned char* KTp = nullptr, unsigned char* VTp = nullptr, unsigned* ATp = nullptr) {
    bf16x8 a[8], b0[8], b1[8];
    ctx_load(F, A, Bt, rb, cg, a, b0, b1);
    f32x16 c0, c1; ctx_mma(a, b0, b1, c0, c1);
    ctx_tail<MODE>(F, c0, c1, rb, cg, PBc, qkg, res, outp, gate, KTp, VTp, ATp);
}
template <int MODE>
__device__ __forceinline__ void ctx_tail(Frame& F, const f32x16& c0, const f32x16& c1, int rb, int cg, bf16* PBc, const float* qkg, const float* res, float* outp, const float* gate, unsigned char* KTp, unsigned char* VTp, unsigned* ATp) {
    const int lane = F.lane, r32 = lane & 31, hi = lane >> 5;
    LAS float* red = (LAS float*)F.lds + F.wave * 2048;
#pragma unroll
    for (int r = 0; r < 16; ++r) { const int row = att2::crow(r, hi); red[row * 64 + r32] = c0[r]; red[row * 64 + 32 + r32] = c1[r]; }
    __syncthreads();
    const int row = F.tid >> 4, c4 = (F.tid & 15) * 4;
    f32x4 v = {0.f, 0.f, 0.f, 0.f};
#pragma unroll
    for (int w = 0; w < 8; ++w) v += *(const LAS f32x4*)((LAS float*)F.lds + w * 2048 + row * 64 + c4);
    const int grow = rb * 32 + row;
    if (MODE == 0) {
        if (cg >= 8 && cg < 24) {
            const int part = cg >= 16 ? 1 : 0;
            float ss = (v[0] * v[0] + v[1] * v[1]) + (v[2] * v[2] + v[3] * v[3]);
            ss += sxor<1>(ss); ss += sxor<2>(ss); ss += sxor<4>(ss); ss += sxor<8>(ss);
            const float rs = __builtin_amdgcn_rsqf(ss * (1.f / 64.f) + EPS) * (part ? 1.f : 0.125f * LOG2E);
            const f32x4 g = *(const f32x4*)(qkg + part * 64 + c4);
            v = v * rs * g;
        }
        const u32x2 w2 = (u32x2){pk2(v[0], v[1]), pk2(v[2], v[3])};
        if (cg >= 16 && cg < 32) {
            const int bb = grow >> 8, kidx = grow & 255, g = (cg - 16) & 7, hh = g >> 1;
            const size_t blk = ((size_t)((bb * 4 + hh) * NTILE + (kidx >> 6))) * 16384; const int key = kidx & 63;
            if (cg < 24) *(u32x2*)(KTp + blk + (g & 1) * 8192 + (c4 >> 3) * 1024 + key * 16 + (c4 & 7) * 2) = w2;
            else { const int dv = (g & 1) * 64 + c4; *(u32x2*)(VTp + blk + (dv >> 5) * 4096 + key * 64 + (dv & 31) * 2) = w2; }
        } else if (cg < 4) {
            unsigned* ap = ATp + AT_CTX + ((size_t)((grow >> 8) * 128 + cg * 32 + (c4 >> 1))) * CL + (grow & 255);
            ap[0] = w2.x; ap[CL] = w2.y;
        } else *(u32x2*)(PBc + (size_t)grow * IN_W + cg * 64 + c4) = w2;
    } else {
        const size_t off = (size_t)grow * D + cg * 64 + c4;
        const f32x4 o4 = *(const f32x4*)(res + off) + mod4(gate + cg * 64 + c4) * v;
        st_wt16(outp + off, __builtin_bit_cast(u32x4, o4));
        asm volatile("s_waitcnt vmcnt(0)" ::: "memory");
    }
    __syncthreads();
}

__global__ void __launch_bounds__(NWAVES * 64, 2) mk_fwd(Args args) {
    extern __shared__ __attribute__((aligned(16))) unsigned char lds[];
    {
        LAS unsigned* z = (LAS unsigned*)((LAS unsigned char*)lds + LDSCTL_OFF);
        for (int u = threadIdx.x; u < (LDS_BYTES - LDSCTL_OFF) / 4; u += NWAVES * 64) z[u] = 0u;
    }
    __syncthreads();
    const int wave_id = __builtin_amdgcn_readfirstlane((int)threadIdx.x >> 6);
    volatile LAS unsigned* MISC = (volatile LAS unsigned*)((LAS unsigned char*)lds + MISC_OFF);
    const int lo = args.ph_lo, hi = args.ph_hi;
    XcdBarrier bar; bar.bar = (unsigned*)(args.ws + WS_CTL) + CW_BAR; bar.x = 0; bar.st = nullptr;
    if (hi - lo > 1) bar = xcd_barrier_post((unsigned*)(args.ws + WS_CTL) + CW_BAR, MISC + 8);

#pragma unroll 1
    for (int ph = lo; ph < hi; ++ph) {
        const int Gd = gridDim.x, vcu = (Gd % 8 == 0) ? ((int)blockIdx.x % 8) * (Gd / 8) + (int)blockIdx.x / 8 : (int)blockIdx.x;
#define MKFRAME(F) Frame F; { int ln_; asm volatile("v_mbcnt_lo_u32_b32 %0, -1, 0\n\tv_mbcnt_hi_u32_b32 %0, -1, %0" : "=v"(ln_)); F.lane = ln_; F.wave = wave_id; F.tid = wave_id * 64 + ln_; F.lds = (LAS unsigned char*)lds; { int g_ = Gd, v_ = vcu; asm volatile("" : "+s"(g_), "+s"(v_)); F.G = g_; F.vcu = v_; } }
        const __attribute__((address_space(4))) Args* ka = (const __attribute__((address_space(4))) Args*)__builtin_amdgcn_kernarg_segment_ptr(); asm volatile("" : "+s"(ka));
        unsigned char* ws = ka->ws; asm volatile("" : "+s"(ws));
        const int l = ph == 0 ? 0 : (ph - 1) / 5, kind = ph == 0 ? 0 : 1 + (ph - 1) % 5;
        const bool upd = l < DEPTH - 1;
        float* out = ka->out;
        const float* xin = l == 0 ? ka->in[0] : out;
        const float* cin = l == 0 ? ka->in[2] : (const float*)(ws + WS_CTX1);
        const float* mod = (const float*)(ws + WS_MOD) + l * 3 * 3072;
        bf16* PB = (bf16*)(ws + WS_PB); bf16* Y = (bf16*)(ws + WS_Y); bf16* U = (bf16*)(ws + WS_U);
        if (kind == 0) {
            MKFRAME(F);
            phase_mod(F, ka, ws);
            __syncthreads();
            phase_prep(F, ka, ws);
            asm volatile("s_waitcnt vmcnt(0)" ::: "memory");
            __syncthreads();
            if (F.tid == 0) (void)__hip_atomic_fetch_add((gu32*)(ws + WS_CTL) + SEAM_PREPCNT, 1u, __ATOMIC_RELAXED, __HIP_MEMORY_SCOPE_AGENT);
        } else if (kind == 1) {
            MKFRAME(F);
            if (l == 0) { if (F.tid == 0) seam_wait_ge((gu32*)(ws + WS_CTL) + SEAM_MODCNT, (unsigned)(DEPTH * 48 * 4)); asm volatile("" ::: "memory"); __syncthreads(); }
            if (l == 0) phase_normmod<true>(F, xin, cin, ka->in[4] + l * D, mod, (bf16*)(ws + WS_H), (gu32*)(ws + WS_CTL) + 16 * 65 * l);
            else phase_normmod_jobs(F, MISC, xin, cin, ka->in[4] + l * D, mod, (bf16*)(ws + WS_H), (gu32*)(ws + WS_CTL) + 16 * 65 * l, (gu32*)(ws + WS_CTL));
        } else if (kind == 2) {
            MKFRAME(F);
            pg8::Gemm g{(const bf16*)(ws + WS_H), (const bf16*)(ws + WS_WIN) + (size_t)l * IN_W * D, M, IN_W, D}; pg8::StaticOrder S; S.init(M, IN_W, F.G, (int)blockIdx.x);
            pg8::EpiIn E{PB, ka->in[11] + l * 128, (const float*)(ws + WS_ROPE), ws + WS_KT, ws + WS_VT, (unsigned*)(ws + WS_AT)};
            {
                if (l == 0 && F.tid == 0) seam_wait_ge((gu32*)(ws + WS_CTL) + SEAM_PREPCNT, (unsigned)F.G);
                if (l > 0 && F.tid == 0) seam_wait_ge((gu32*)(ws + WS_CTL) + SEAM_MIXDONE, (unsigned)F.G);
                { pg8::Unit u_; u_.pm = 0; u_.pn = 0;
#pragma unroll 1
                  for (int i = 0; S.next(i, u_); ++i) { gu32* f_ = (gu32*)(ws + WS_CTL) + 16 * 65 * l + SEAM_HCNT(u_.pm); if (F.tid == 0) seam_wait_ge(f_, 32u); } }
                asm volatile("" ::: "memory");
                __syncthreads();
            }
            pg8::gemm_phase<pg8::EpiIn, pg8::StaticOrder, true, true>(F.lds + RING_OFF, g, S, E, F.tid);
            { if (F.tid == 0) seam_wait_ge((gu32*)(ka->ws + WS_CTL) + 16 * 65 * l + SEAM_CCNT, (unsigned)(MT - M)); asm volatile("" ::: "memory"); __syncthreads(); }
            { const int ncg = upd ? 48 : 16, cg0 = upd ? 0 : 16;
              const bf16* Hc = (const bf16*)(ws + WS_H) + (size_t)M * D; const bf16* Wl = (const bf16*)(ws + WS_WIN) + (size_t)l * IN_W * D;
              if (F.vcu < 16 * ncg) {
                  bf16x8 a[8], b0[8], b1[8];
                  ctx_load(F, Hc, Wl, F.vcu & 15, cg0 + (F.vcu >> 4), a, b0, b1);
#pragma unroll 1
                  for (int id = F.vcu; id < 16 * ncg; id += F.G) {
                      f32x16 c0, c1; ctx_mma(a, b0, b1, c0, c1);
                      const int nid = id + F.G;
                      if (nid < 16 * ncg) ctx_load(F, Hc, Wl, nid & 15, cg0 + (nid >> 4), a, b0, b1);
                      ctx_tail<0>(F, c0, c1, id & 15, cg0 + (id >> 4), PB + (size_t)M * IN_W, ka->in[11] + l * 128, nullptr, nullptr, nullptr, ws + WS_KT, ws + WS_VT, (unsigned*)(ws + WS_AT));
                  }
              } }
        } else if (kind == 3) {
        } else if (kind == 4) {
            {
                MKFRAME(F);
                const float* TW = (const float*)(ws + WS_TW);
                gu32* fcnt = (gu32*)(ws + WS_CTL) + CW_FFT + 64 * l;
                const int nfft = upd ? 512 : 256;
#pragma unroll 1
                for (int it = F.vcu; it < nfft; it += F.G) {
                    const bool cx = it >= 256; const int j = it & 255, b = j >> 7, p = j & 127;
                    const size_t eo = cx ? AT_CTX + (size_t)(b * 128 + p) * CL : (size_t)(b * 128 + p) * L;
                    if (cx) fft_item(F, (const unsigned*)(ws + WS_AT) + eo, 8, (u32x2*)(ws + WS_U) + eo, TW);
                    else fft13_item(F, (const unsigned*)(ws + WS_AT) + eo, (u32x2*)(ws + WS_U) + eo, TW);
                    if (F.tid == 0) __hip_atomic_fetch_add(fcnt, 1u, __ATOMIC_RELAXED, __HIP_MEMORY_SCOPE_AGENT);
                }
            }
            const int skip = ka->skip;
            const int nitem = (skip & 1) ? 0 : (upd ? 528 : 512);
#pragma unroll 1
            for (int it = vcu; it < nitem; it += Gd) {
                const bool cx = it >= 512;
                const int j = cx ? it - 512 : it, bh = cx ? (j >> 1) : (j >> 6), qb = cx ? (j & 1) : (j & 63);
                int t2; asm volatile("v_mbcnt_lo_u32_b32 %0, -1, 0\n\tv_mbcnt_hi_u32_b32 %0, -1, %0" : "=v"(t2)); t2 += wave_id * 64;
                const __attribute__((address_space(4))) Args* ka2 = ka; asm volatile("" : "+s"(ka2));
                unsigned char* ws2 = ka2->ws; asm volatile("" : "+s"(ws2));
                att2::attn_item((const bf16*)(ws2 + WS_PB), ws2 + WS_KT, ws2 + WS_VT, (bf16*)(ws2 + WS_Y), ka2->in[13] + l * 128, (const float*)(ws2 + WS_SC) + l * 4, cx, bh >> 2, bh & 3, qb * 128, (char*)lds + RING_OFF, t2);
            }
            const int ntile = (skip & 2) ? 0 : (upd ? 264 : 256);
            MKFRAME(F2);
            asm volatile("s_waitcnt vmcnt(0)" ::: "memory");
            {
                gu32* fcnt = (gu32*)(ka->ws + WS_CTL) + CW_FFT + 64 * l; const unsigned want = upd ? 512u : 256u;
                if (F2.tid == 0) { unsigned sp = 0; while (__hip_atomic_load(fcnt, __ATOMIC_RELAXED, __HIP_MEMORY_SCOPE_AGENT) < want) { __builtin_amdgcn_s_sleep(8); if (++sp > (1u << 22)) break; }
                    __builtin_amdgcn_fence(__ATOMIC_ACQUIRE, "agent"); asm volatile("s_waitcnt vmcnt(0)" ::: "memory"); }
                __syncthreads();
                if (F2.tid == 0) {
                    for (int it = F2.vcu; it < nitem; it += F2.G) { const int blk = it < 512 ? ((it >> 8) * 32 + ((it & 63) >> 1)) : 64 + ((it - 512) >> 3);
                        (void)__hip_atomic_fetch_add((gu32*)(ka->ws + WS_CTL) + SEAM_YCNT(l, blk), 1u, __ATOMIC_RELAXED, __HIP_MEMORY_SCOPE_AGENT); } }
            }
            gu32* qcnt = (gu32*)(ka->ws + WS_CTL) + CW_Q + 64 * l;
            int prev = -1;
            if (F2.tid == 0) MISC[46] = __hip_atomic_fetch_add(qcnt, 1u, __ATOMIC_RELAXED, __HIP_MEMORY_SCOPE_AGENT);
#pragma unroll 1
            for (;;) {
                __syncthreads();
                const int it = __builtin_amdgcn_readfirstlane((int)MISC[46]);
                unsigned char* ws3 = ka->ws; asm volatile("" : "+s"(ws3));
                gu32* pub = nullptr;
                if (prev >= 0) { const int t_ = prev < ntile ? prev : prev - ntile; const int blk = t_ < 256 ? (t_ >> 2) : 64 + ((t_ - 256) >> 2); pub = (gu32*)(ws3 + WS_CTL) + SEAM_YCNT(l, blk); }
                __syncthreads();
                if (it >= 2 * ntile) {
                    asm volatile("s_waitcnt vmcnt(0)" ::: "memory");
                    __syncthreads();
                    if (pub && F2.tid == 0) (void)__hip_atomic_fetch_add(pub, 1u, __ATOMIC_RELAXED, __HIP_MEMORY_SCOPE_AGENT);
                    break; }
                prev = it;
                if (it < ntile) {
                    const bool cx = it >= 256; const int j = it - 256;
                    const int rb = cx ? M + (j >> 2) * CL : (it >> 7) * L, Lr = cx ? CL : L, t0 = cx ? (j & 3) * 64 : (it & 127) * 64;
                    const unsigned n_ = pool_item(F2, (bf16*)(ws3 + WS_PB), (bf16*)(ws3 + WS_Y), rb, Lr, t0, (const bf16*)(ws3 + WS_WP) + (size_t)l * 4 * 64 * 64, ka->in[10] + l * 256, qcnt, pub);
                    if (F2.tid == 0) MISC[46] = n_;
                } else {
                    const unsigned n_ = flin_item(F2, (const bf16*)(ws3 + WS_PB), (const bf16*)(ws3 + WS_U), (bf16*)(ws3 + WS_Y), (it - ntile) * 64, (const bf16*)(ws3 + WS_WF) + (size_t)l * 4 * 64 * 128, qcnt, pub);
                    if (F2.tid == 0) MISC[46] = n_; }
            }
        } else {
            MKFRAME(F);
            const int Mo = M;
            pg8::Gemm g{Y, (const bf16*)(ws + WS_WOUT) + (size_t)l * D * D, Mo, D, D};
            pg8::EpiResL E{xin, out, mod, L, F.lds + RING_OFF, upd ? 1 : 0};
            gu32* oq = (gu32*)(ws + WS_CTL) + CW_Q + 64 * l + 48;
            if (upd && F.tid == 0) (void)__hip_atomic_fetch_add((gu32*)(ws + WS_CTL) + SEAM_MIXDONE, 1u, __ATOMIC_RELAXED, __HIP_MEMORY_SCOPE_AGENT);
#pragma unroll 1
            for (;;) {
                if (F.tid == 0) MISC[46] = __hip_atomic_fetch_add(oq, 1u, __ATOMIC_RELAXED, __HIP_MEMORY_SCOPE_AGENT);
                __syncthreads();
                const int tk = __builtin_amdgcn_readfirstlane((int)MISC[46]);
                __syncthreads();
                if (tk >= (Mo / 256) * 4) break;
                pg8::OneUnit S; S.pm = tk >> 2; S.pn = tk & 3;
                if (F.tid == 0) seam_wait_ge((gu32*)(ws + WS_CTL) + SEAM_YCNT(l, S.pm), 16u);
                asm volatile("" ::: "memory");
                __syncthreads();
                pg8::gemm_phase<pg8::EpiResL, pg8::OneUnit, true, true>(F.lds + RING_OFF, g, S, E, F.tid);
                if (upd && F.tid == 0) (void)__hip_atomic_fetch_add((gu32*)(ws + WS_CTL) + SEAM_XCNT(S.pm), 1u, __ATOMIC_RELAXED, __HIP_MEMORY_SCOPE_AGENT);
            }
            if (upd) {
#pragma unroll 1
                for (int id = F.vcu; id < 256; id += F.G) { if (F.tid == 0) seam_wait_ge((gu32*)(ka->ws + WS_CTL) + SEAM_YCNT(l, 64 + ((id & 15) >> 3)), 16u); asm volatile("" ::: "memory"); __syncthreads(); ctx_tile<1>(F, Y + (size_t)M * D, (const bf16*)(ws + WS_WOUT) + (size_t)l * D * D, id & 15, id >> 4, nullptr, nullptr, cin, (float*)(ws + WS_CTX1), mod + 2 * 3072 + 2048);
                    if (F.tid == 0) (void)__hip_atomic_fetch_add((gu32*)(ka->ws + WS_CTL) + SEAM_CXCNT, 1u, __ATOMIC_RELAXED, __HIP_MEMORY_SCOPE_AGENT); } }
        }
        if (ph + 1 < hi && kind != 3 && kind != 1 && kind != 0 && kind != 4 && kind != 5) xcd_barrier(bar);
    }
#undef MKFRAME
}


extern "C" void kernel_launch(void* const* d_in, const int* in_sizes, int n_in, void* d_out, int out_size, void* d_ws, size_t ws_size, hipStream_t stream) {
    static int grid = 0;
    if (grid == 0) {
        if (n_in != 15 || out_size != M * D || ws_size < WS_END) { fprintf(stderr, "kernel_launch: unexpected shapes (n_in %d out %d ws %zu)\n", n_in, out_size, ws_size); grid = -1; return; }
        int dev = 0, cus = 0, per_cu = 0;
        if (hipGetDevice(&dev) != hipSuccess || hipDeviceGetAttribute(&cus, hipDeviceAttributeMultiprocessorCount, dev) != hipSuccess) { grid = -1; return; }
        if (hipFuncSetAttribute((const void*)mk_fwd, hipFuncAttributeMaxDynamicSharedMemorySize, LDS_BYTES) != hipSuccess) { fprintf(stderr, "kernel_launch: hipFuncSetAttribute failed\n"); grid = -1; return; }
        if (hipOccupancyMaxActiveBlocksPerMultiprocessor(&per_cu, (const void*)mk_fwd, NWAVES * 64, LDS_BYTES) != hipSuccess || per_cu < 1) { fprintf(stderr, "kernel_launch: occupancy query says %d\n", per_cu); per_cu = 1; }
        (void)hipGetLastError();
        grid = cus;
    }
    if (grid < 0) return;
    (void)hipMemsetAsync((char*)d_ws + WS_CTL, 0, CTL_ZERO_BYTES, stream);
    Args a; memset(&a, 0, sizeof a);
    for (int i = 0; i < 15; ++i) a.in[i] = (const float*)d_in[i];
    a.out = (float*)d_out; a.ws = (unsigned char*)d_ws;
#if MK_PER_PHASE
    for (int ph = 0; ph < NPH; ++ph) { a.ph_lo = ph; a.ph_hi = ph + 1; hipLaunchKernelGGL(mk_fwd, dim3(grid), dim3(NWAVES * 64), LDS_BYTES, stream, a); }
#else
    a.ph_lo = 0; a.ph_hi = NPH; hipLaunchKernelGGL(mk_fwd, dim3(grid), dim3(NWAVES * 64), LDS_BYTES, stream, a);
#endif
    const hipError_t le = hipPeekAtLastError();
    if (le != hipSuccess) fprintf(stderr, "kernel_launch: launch failed: %s\n", hipGetErrorName(le));
}
```

```cpp
#include <hip/hip_runtime.h>
#include <math.h>
#include <string.h>
#include <stdio.h>
#include <stdint.h>

#ifndef MK_PER_PHASE
#define MK_PER_PHASE 0
#endif

constexpr int D = 1024, NB = 2, L = 8192, DEPTH = 2, CL = 256;
constexpr int A_OFF = 0, B_OFF = 256, Q_OFF = 512, K_OFF = 1024, V_OFF = 1536, G_OFF = 2048, IN_W = 3072;
constexpr int M = NB * L, MC = NB * CL, MT = M + MC;
constexpr float EPS = 1e-6f;
constexpr float LOG2E = 1.4426950408889634f;
constexpr int NPH = 1 + 5 * DEPTH;

constexpr size_t MiB = 1u << 20, KiB = 1024;
constexpr size_t WS_CTL = 0, CTL_ZERO_BYTES = 64 * KiB;
constexpr size_t WS_MOD = 18 * MiB;
constexpr int MODQ = DEPTH * 3 * 3072;
constexpr size_t WS_SC = 1 * MiB + 96 * KiB;
constexpr size_t WS_ROPE = 1 * MiB + 128 * KiB;
constexpr size_t WS_TW = 1 * MiB + 256 * KiB;
constexpr size_t WS_WF = 1 * MiB + 512 * KiB;
constexpr size_t WS_WP = 1 * MiB + 768 * KiB;
constexpr size_t WS_WIN = 2 * MiB;
constexpr size_t WS_WOUT = 14 * MiB;
constexpr size_t WS_H = 20 * MiB;
constexpr size_t WS_PB = 54 * MiB;
constexpr size_t WS_U = 154 * MiB;
constexpr size_t WS_Y = 172 * MiB;
constexpr size_t WS_CTX1 = 206 * MiB;
constexpr size_t WS_KT = 208 * MiB;
constexpr size_t WS_VT = 226 * MiB;
constexpr size_t WS_AT = 244 * MiB;
constexpr size_t AT_CTX = (size_t)NB * 128 * L;
constexpr size_t WS_END = 253 * MiB;
constexpr int NTILE = (CL + L) / 64;

typedef unsigned short bf16;
#define LAS __attribute__((address_space(3)))
#define GAS __attribute__((address_space(1)))
typedef float f32x4 __attribute__((ext_vector_type(4)));
typedef float f32x16 __attribute__((ext_vector_type(16)));
typedef unsigned u32x4 __attribute__((ext_vector_type(4)));
typedef unsigned u32x2 __attribute__((ext_vector_type(2)));
typedef short bf16x8 __attribute__((ext_vector_type(8)));
typedef short s16x4 __attribute__((ext_vector_type(4)));

__device__ __forceinline__ float silu_f(float t) { return t * __builtin_amdgcn_rcpf(1.f + __expf(-t)); }
template <int MASK> __device__ __forceinline__ float sxor(float v) {
    return __builtin_bit_cast(float, __builtin_amdgcn_ds_swizzle(__builtin_bit_cast(int, v), (MASK << 10) | 0x1f));
}
__device__ __forceinline__ float half_swap_sum(float v) { unsigned a = __builtin_bit_cast(unsigned, v), b = a; asm volatile("" : "+v"(b)); auto rr = __builtin_amdgcn_permlane32_swap(a, b, false, false); unsigned r0 = rr[0], r1 = rr[1]; asm volatile("" : "+v"(r0), "+v"(r1)); return __builtin_bit_cast(float, r0) + __builtin_bit_cast(float, r1); }
__device__ __forceinline__ float half_swap_max(float v) { unsigned a = __builtin_bit_cast(unsigned, v), b = a; asm volatile("" : "+v"(b)); auto rr = __builtin_amdgcn_permlane32_swap(a, b, false, false); unsigned r0 = rr[0], r1 = rr[1]; asm volatile("" : "+v"(r0), "+v"(r1)); return fmaxf(__builtin_bit_cast(float, r0), __builtin_bit_cast(float, r1)); }
template <int CTRL> __device__ __forceinline__ float dpp_f(float v) { return __builtin_bit_cast(float, __builtin_amdgcn_update_dpp(0, __builtin_bit_cast(int, v), CTRL, 0xf, 0xf, true)); }
__device__ __forceinline__ float row_swap_sum(float v) { unsigned a = __builtin_bit_cast(unsigned, v), b = a; asm volatile("" : "+v"(b)); auto rr = __builtin_amdgcn_permlane16_swap(a, b, false, false); unsigned r0 = rr[0], r1 = rr[1]; asm volatile("" : "+v"(r0), "+v"(r1)); return __builtin_bit_cast(float, r0) + __builtin_bit_cast(float, r1); }
__device__ __forceinline__ float sum32(float v) { v += dpp_f<0xB1>(v); v += dpp_f<0x4E>(v); v += dpp_f<0x141>(v); v += dpp_f<0x140>(v); return row_swap_sum(v); }
__device__ __forceinline__ float wave_sum(float v) { return half_swap_sum(sum32(v)); }
__device__ __forceinline__ float wave_max(float v) {
    v = fmaxf(v, sxor<16>(v)); v = fmaxf(v, sxor<8>(v)); v = fmaxf(v, sxor<4>(v)); v = fmaxf(v, sxor<2>(v)); v = fmaxf(v, sxor<1>(v));
    return half_swap_max(v);
}
__device__ __forceinline__ unsigned f2bf(float f) { unsigned u = __builtin_bit_cast(unsigned, f); return (u + 0x7fffu + ((u >> 16) & 1u)) >> 16; }
__device__ __forceinline__ unsigned pk2(float lo, float hi) { return f2bf(lo) | (f2bf(hi) << 16); }
__device__ __forceinline__ float bflo(unsigned u) { return __builtin_bit_cast(float, u << 16); }
__device__ __forceinline__ float bfhi(unsigned u) { return __builtin_bit_cast(float, u & 0xffff0000u); }
__device__ __forceinline__ float bf2f(bf16 h) { return __builtin_bit_cast(float, (unsigned)h << 16); }

__device__ __forceinline__ f32x4 mod4(const float* p) { return (*(const f32x4*)p + *(const f32x4*)(p + MODQ)) + (*(const f32x4*)(p + 2 * MODQ) + *(const f32x4*)(p + 3 * MODQ)); }

__device__ __forceinline__ void st_wt16(void* p, u32x4 v) { asm volatile("global_store_dwordx4 %0, %1, off sc1\n\ts_nop 1" :: "v"(p), "v"(v) : "memory"); }
namespace pg8 {
#define PG8_LAS __attribute__((address_space(3)))
typedef unsigned short bf16_t;
constexpr int BM = 256, BK = 64, HALF = 128, HTB = HALF * BK * 2, STAGE_BYTES = 8 * HTB, NXCD = 8, WGM = 8;
__host__ __device__ __forceinline__ int lds_byte(int r, int c) { const int st = (r >> 4) * 2 + (c >> 5), rr = r & 15, cc = c & 31, ob = rr * 64 + cc * 2; return st * 1024 + (ob ^ (((ob >> 9) & 1) << 5)); }
__host__ __device__ __forceinline__ void stage_rc(int b, int& R, int& C) { const int st = b / 1024, sb = b % 1024, swz = sb ^ (((sb >> 9) & 1) << 5); R = (st >> 1) * 16 + swz / 64; C = (st & 1) * 32 + (swz % 64) / 2; }
__host__ __device__ __forceinline__ int perm32(int rho) { const int n = rho >> 4, i = rho & 15; return 8 * (i >> 2) + 4 * n + (i & 3); }
struct Unit { int pm, pn; };
struct Gemm { const bf16_t* A; const bf16_t* Bt; int M, N, K; };
struct StaticOrder {
    int nM, nN, nwg, G, c;
    __host__ __device__ void init(int M_, int N_, int G_, int c_) { nM = M_ / BM; nN = N_ / BM; nwg = nM * nN; G = G_; c = c_; }
    __host__ __device__ bool next(int i, Unit& u) const {
        const long Lx = (long)i * G + c; if (Lx >= nwg) return false;
        int wgid = (int)Lx; { const int q = nwg / NXCD, r = nwg % NXCD, xcd = wgid % NXCD, off = wgid / NXCD; wgid = (xcd < r ? xcd * (q + 1) : r * (q + 1) + (xcd - r) * q) + off; }
        const int nig = WGM * nN, gid = wgid / nig, fm = gid * WGM, gsz = (nM - fm) < WGM ? (nM - fm) : WGM;
        u.pm = fm + ((wgid % nig) % gsz); u.pn = (wgid % nig) / gsz; return true;
    }
    __device__ __forceinline__ void a_ready(const Unit&) const {}
    __device__ __forceinline__ void done(const Unit&) const {}
};
__device__ __forceinline__ unsigned cvt_pk_bf16(float lo, float hi) { unsigned r; asm volatile("v_cvt_pk_bf16_f32 %0, %1, %2" : "=v"(r) : "v"(lo), "v"(hi)); return r; }
struct EpiBf16 {
    static constexpr bool PERM = true, AFTER_DRAIN = false, GROUP64 = false;
    bf16_t* O; int ldc;
    __device__ __forceinline__ void operator()(const f32x4 (&acc)[2][2][4][2], const Unit& u, int wr, int wc, int fr, int fq) const {
        const int row0 = u.pm * BM + wr * 64 + fr, col0 = u.pn * BM + wc * 32 + 8 * fq;
#pragma unroll
        for (int ai = 0; ai < 2; ++ai)
#pragma unroll
            for (int m = 0; m < 4; ++m) { bf16_t* rowp = O + (size_t)(row0 + ai * HALF + m * 16) * ldc + col0;
#pragma unroll
                for (int bj = 0; bj < 2; ++bj) { const f32x4 v0 = acc[ai][bj][m][0], v1 = acc[ai][bj][m][1];
                    u32x4 w; w.x = cvt_pk_bf16(v0[0], v0[1]); w.y = cvt_pk_bf16(v0[2], v0[3]); w.z = cvt_pk_bf16(v1[0], v1[1]); w.w = cvt_pk_bf16(v1[2], v1[3]);
                    *(u32x4*)(rowp + bj * HALF) = w; } }
    }
};

struct EpiIn {
    static constexpr bool PERM = true, AFTER_DRAIN = false, GROUP64 = true;
    bf16_t* O; const float* qkg; const float* rope; unsigned char* KT; unsigned char* VT; unsigned* AT;
    static __device__ __forceinline__ size_t kv_block(int row, int h, int& key) { const int b = row >> 13, kidx = CL + (row & (L - 1)); key = kidx & 63; return ((size_t)((b * 4 + h) * NTILE + (kidx >> 6))) * 16384; }
    __device__ __forceinline__ void operator()(const f32x4 (&acc)[2][2][4][2], const Unit& u, int wr, int wc, int fr_, int fq_) const {
        int ln_; asm volatile("v_mbcnt_lo_u32_b32 %0, -1, 0\n\tv_mbcnt_hi_u32_b32 %0, -1, %0" : "=v"(ln_)); const int fr = ln_ & 15, fq = ln_ >> 4; (void)fr_; (void)fq_;
        const int row0 = u.pm * BM + wr * 64 + fr, col0 = u.pn * BM + wc * 64 + 8 * fq;
        if (u.pn == 6 || u.pn == 7) {
            const int g64 = (u.pn - 6) * 4 + wc, h = g64 >> 1;
#pragma unroll
            for (int ai = 0; ai < 2; ++ai)
#pragma unroll
                for (int m = 0; m < 4; ++m) { int key; const size_t blk = kv_block(row0 + ai * HALF + m * 16, h, key);
#pragma unroll
                    for (int bj = 0; bj < 2; ++bj) { const f32x4 v0 = acc[ai][bj][m][0], v1 = acc[ai][bj][m][1];
                        u32x4 w; w.x = cvt_pk_bf16(v0[0], v0[1]); w.y = cvt_pk_bf16(v0[2], v0[3]); w.z = cvt_pk_bf16(v1[0], v1[1]); w.w = cvt_pk_bf16(v1[2], v1[3]);
                        *(u32x4*)(VT + blk + ((g64 & 1) * 2 + bj) * 4096 + key * 64 + fq * 16) = w; } }
            return;
        }
        if (u.pn == 0) {
#pragma unroll
            for (int ai = 0; ai < 2; ++ai)
#pragma unroll
                for (int m = 0; m < 4; ++m) { const int row = row0 + ai * HALF + m * 16; unsigned* ap = AT + ((size_t)((row >> 13) * 128 + 32 * wc + 4 * fq)) * L + (row & (L - 1));
#pragma unroll
                    for (int bj = 0; bj < 2; ++bj) { const f32x4 v0 = acc[ai][bj][m][0], v1 = acc[ai][bj][m][1]; unsigned* a2 = ap + (size_t)(16 * bj) * L;
                        a2[0] = cvt_pk_bf16(v0[0], v0[1]); a2[L] = cvt_pk_bf16(v0[2], v0[3]); a2[2 * L] = cvt_pk_bf16(v1[0], v1[1]); a2[3 * L] = cvt_pk_bf16(v1[2], v1[3]); } }
            return;
        }
        if (u.pn < 2 || u.pn >= 6) {
#pragma unroll
            for (int ai = 0; ai < 2; ++ai)
#pragma unroll
                for (int m = 0; m < 4; ++m) { bf16_t* rowp = O + (size_t)(row0 + ai * HALF + m * 16) * IN_W + col0;
#pragma unroll
                    for (int bj = 0; bj < 2; ++bj) { const f32x4 v0 = acc[ai][bj][m][0], v1 = acc[ai][bj][m][1];
                        u32x4 w; w.x = cvt_pk_bf16(v0[0], v0[1]); w.y = cvt_pk_bf16(v0[2], v0[3]); w.z = cvt_pk_bf16(v1[0], v1[1]); w.w = cvt_pk_bf16(v1[2], v1[3]);
                        *(u32x4*)(rowp + bj * 32) = w; } }
            return;
        }
        const int part = u.pn >= 4 ? 1 : 0;
        const bool isc = u.pm >= 64;
        const float qs = part ? 1.f : 0.125f * LOG2E;
        const int hi = fq >> 1, jb = 8 * (fq & 1);
        f32x4 gv[2][2];
#pragma unroll
        for (int bj = 0; bj < 2; ++bj)
#pragma unroll
            for (int n = 0; n < 2; ++n) gv[bj][n] = *(const f32x4*)(qkg + part * 64 + 32 * bj + 8 * fq + 4 * n);
#pragma unroll
        for (int ai = 0; ai < 2; ++ai)
#pragma unroll
            for (int m = 0; m < 4; ++m) {
                const int row = row0 + ai * HALF + m * 16;
                float ss = 0.f;
#pragma unroll
                for (int bj = 0; bj < 2; ++bj)
#pragma unroll
                    for (int n = 0; n < 2; ++n) { const f32x4 x = acc[ai][bj][m][n]; ss += (x[0] * x[0] + x[1] * x[1]) + (x[2] * x[2] + x[3] * x[3]); }
                ss = half_swap_sum(row_swap_sum(ss));
                const float rs = __builtin_amdgcn_rsqf(ss * (1.f / 64.f) + EPS);
                f32x4 y[2][2];
#pragma unroll
                for (int bj = 0; bj < 2; ++bj)
#pragma unroll
                    for (int n = 0; n < 2; ++n) y[bj][n] = acc[ai][bj][m][n] * rs * gv[bj][n];
                if (!isc) {
                    const int t = row & (L - 1);
                    f32x4 tab[2][2][2];
#pragma unroll
                    for (int bj = 0; bj < 2; ++bj) { const float* rp = rope + ((bj ? (t & 63) : (t >> 6)) * 16 + jb) * 2;
#pragma unroll
                        for (int n = 0; n < 2; ++n) { tab[bj][n][0] = *(const f32x4*)(rp + 8 * n); tab[bj][n][1] = *(const f32x4*)(rp + 8 * n + 4); } }
#pragma unroll
                    for (int bj = 0; bj < 2; ++bj) {
#pragma unroll
                        for (int n = 0; n < 2; ++n) {
                            const f32x4 ca = tab[bj][n][0], cb = tab[bj][n][1];
                            const float cs[4] = {ca[0], ca[2], cb[0], cb[2]}, sn[4] = {ca[1], ca[3], cb[1], cb[3]};
#pragma unroll
                            for (int e = 0; e < 4; ++e) {
                                const float yv = y[bj][n][e];
                                unsigned a_ = __builtin_bit_cast(unsigned, yv), b_ = a_; asm volatile("" : "+v"(b_));
                                auto rr = __builtin_amdgcn_permlane32_swap(a_, b_, false, false); unsigned r0 = rr[0], r1 = rr[1]; asm volatile("" : "+v"(r0), "+v"(r1));
                                const float other = __builtin_bit_cast(float, hi ? r0 : r1);
                                y[bj][n][e] = hi ? (yv * cs[e] + other * sn[e]) : (yv * cs[e] - other * sn[e]);
                            }
                        }
                    }
                }
                bf16_t* rowp = O + (size_t)row * IN_W + col0;
                int key = 0; size_t blk = 0; const int g64 = (u.pn & 1) * 4 + wc;
                if (part) blk = kv_block(row, g64 >> 1, key);
#pragma unroll
                for (int bj = 0; bj < 2; ++bj) { const f32x4 v0 = y[bj][0] * qs, v1 = y[bj][1] * qs;
                    u32x4 w; w.x = cvt_pk_bf16(v0[0], v0[1]); w.y = cvt_pk_bf16(v0[2], v0[3]); w.z = cvt_pk_bf16(v1[0], v1[1]); w.w = cvt_pk_bf16(v1[2], v1[3]);
                    if (part) *(u32x4*)(KT + blk + (g64 & 1) * 8192 + (4 * bj + fq) * 1024 + key * 16) = w;
                    else *(u32x4*)(rowp + bj * 32) = w; }
            }
    }
};
struct OneUnit {
    int pm, pn;
    __host__ __device__ bool next(int i, Unit& u) const { if (i != 0) return false; u.pm = pm; u.pn = pn; return true; }
    __device__ __forceinline__ void a_ready(const Unit&) const {}
    __device__ __forceinline__ void done(const Unit&) const {}
};
struct EpiRes {
    static constexpr bool PERM = false, AFTER_DRAIN = false, GROUP64 = false;
    const float* res0; float* out0; const float* res1; float* out1; const float* mod; int mlat, rows_per_vec;
    __device__ __forceinline__ void operator()(const f32x4 (&acc)[2][2][4][2], const Unit& u, int wr, int wc, int fr, int fq) const {
        int row0 = u.pm * BM + wr * 64 + fr; const int col0 = u.pn * BM + wc * 32 + 4 * fq;
        const bool isc = (u.pm * BM) >= mlat;
        const float* res = isc ? res1 : res0; float* out = isc ? out1 : out0;
        const int vec = isc ? 2 : (u.pm * BM) / rows_per_vec;
        if (isc) row0 -= mlat;
        const float* gp = mod + vec * 3072 + 2048 + col0;
        f32x4 gv[2][2];
#pragma unroll
        for (int bj = 0; bj < 2; ++bj)
#pragma unroll
            for (int n = 0; n < 2; ++n) gv[bj][n] = mod4(gp + bj * HALF + n * 16);
#pragma unroll
        for (int ai = 0; ai < 2; ++ai) {
            f32x4 rr[4][2][2];
#pragma unroll
            for (int m = 0; m < 4; ++m) { const size_t off = (size_t)(row0 + ai * HALF + m * 16) * 1024 + col0;
#pragma unroll
                for (int bj = 0; bj < 2; ++bj)
#pragma unroll
                    for (int n = 0; n < 2; ++n) rr[m][bj][n] = *(const f32x4*)(res + off + bj * HALF + n * 16); }
            asm volatile("" ::: "memory");
#pragma unroll
            for (int m = 0; m < 4; ++m) { const size_t off = (size_t)(row0 + ai * HALF + m * 16) * 1024 + col0;
#pragma unroll
                for (int bj = 0; bj < 2; ++bj)
#pragma unroll
                    for (int n = 0; n < 2; ++n) *(f32x4*)(out + off + bj * HALF + n * 16) = rr[m][bj][n] + gv[bj][n] * acc[ai][bj][m][n]; }
            asm volatile("" ::: "memory");
        }
    }
};

struct EpiResL {
    static constexpr bool PERM = false, AFTER_DRAIN = false, GROUP64 = false;
    const float* res; float* out; const float* mod; int rows_per_vec; PG8_LAS unsigned char* lds; int wt;
    __device__ __forceinline__ void operator()(const f32x4 (&acc)[2][2][4][2], const Unit& u, int wr, int wc, int fr_, int fq_) const {
        int ln_; asm volatile("v_mbcnt_lo_u32_b32 %0, -1, 0\n\tv_mbcnt_hi_u32_b32 %0, -1, %0" : "=v"(ln_)); const int fr = ln_ & 15, fq = ln_ >> 4; (void)fr_; (void)fq_;
        const int tid = (wr * 4 + wc) * 64 + ln_;
        asm volatile("s_waitcnt vmcnt(0)" ::: "memory");
        __syncthreads();
        const int vec = (u.pm * BM) / rows_per_vec;
        const float* gp = mod + vec * 3072 + 2048 + u.pn * BM + wc * 32 + 4 * fq;
        f32x4 gv[2][2];
#pragma unroll
        for (int bj = 0; bj < 2; ++bj)
#pragma unroll
            for (int n = 0; n < 2; ++n) gv[bj][n] = mod4(gp + bj * HALF + n * 16);
        PG8_LAS float* X = (PG8_LAS float*)lds;
#pragma unroll
        for (int ai = 0; ai < 2; ++ai)
#pragma unroll
            for (int mh = 0; mh < 2; ++mh) {
#pragma unroll
                for (int j = 0; j < 2; ++j) { PG8_LAS float* xr = X + (wr * 32 + j * 16 + fr) * 260 + wc * 32 + 4 * fq;
#pragma unroll
                    for (int bj = 0; bj < 2; ++bj)
#pragma unroll
                        for (int n = 0; n < 2; ++n) *(PG8_LAS f32x4*)(xr + bj * HALF + n * 16) = gv[bj][n] * acc[ai][bj][2 * mh + j][n]; }
                __syncthreads();
                f32x4 rr[8];
#pragma unroll
                for (int i = 0; i < 8; ++i) { const int id = tid + 512 * i, rl = id >> 6, c4 = id & 63;
                    const size_t off = (size_t)(u.pm * BM + ai * HALF + (rl >> 5) * 64 + (2 * mh + ((rl >> 4) & 1)) * 16 + (rl & 15)) * 1024 + u.pn * BM + 4 * c4;
                    rr[i] = *(const f32x4*)(res + off); }
                asm volatile("" ::: "memory");
#pragma unroll
                for (int i = 0; i < 8; ++i) { const int id = tid + 512 * i, rl = id >> 6, c4 = id & 63;
                    const size_t off = (size_t)(u.pm * BM + ai * HALF + (rl >> 5) * 64 + (2 * mh + ((rl >> 4) & 1)) * 16 + (rl & 15)) * 1024 + u.pn * BM + 4 * c4;
                    const f32x4 o4 = rr[i] + *(const PG8_LAS f32x4*)(X + rl * 260 + 4 * c4);
                    if (wt) st_wt16(out + off, __builtin_bit_cast(u32x4, o4)); else *(f32x4*)(out + off) = o4; }
                asm volatile("" ::: "memory");
                __syncthreads();
            }
    }
};

template <class Epi, class Sched, bool ALIGN_EPI = false, bool SP2 = false>
__device__ __forceinline__ void gemm_phase(PG8_LAS unsigned char* lds, const Gemm g, const Sched& S, const Epi& E, const int tid) {
    const int wid = __builtin_amdgcn_readfirstlane(tid >> 6), lane = tid & 63, wr = wid >> 2, wc = wid & 3, fr = lane & 15, fq = lane >> 4;
    const int K = g.K, nt = K / BK;
    unsigned voffA[2], voffB[2];
#pragma unroll
    for (int i = 0; i < 2; ++i) { int R, C; stage_rc(tid * 16 + i * 8192, R, C);
        const int Rb = Epi::GROUP64 ? ((R >> 5) * 64 + perm32(R & 31)) : (Epi::PERM ? ((R & ~31) + perm32(R & 31)) : R);
        voffA[i] = (unsigned)(R * K + C) * 2u; voffB[i] = (unsigned)(Rb * K + C) * 2u; }
    const size_t kstep = (size_t)(BK * 2);
    const size_t hstep = (size_t)HALF * K * 2;
    const size_t hstepB = Epi::GROUP64 ? (size_t)32 * K * 2 : hstep;
    const size_t tstep = 2 * hstep;
    const unsigned ldsw = (unsigned)wid * 1024u;
    const int aoff = lds_byte(wr * 64 + fr, fq * 8), boff = lds_byte(wc * 32 + fr, fq * 8);
#define PG8_SA(b, h) (((b) * 2 + (h)) * HTB)
#define PG8_SB(b, h) ((4 + (b) * 2 + (h)) * HTB)
#define PG8_STAGE(bufoff, gbase, voff) do { _Pragma("unroll") for (int _i = 0; _i < 2; ++_i) \
        __builtin_amdgcn_global_load_lds((const unsigned*)((const char*)(gbase) + (voff)[_i]), (PG8_LAS unsigned*)(lds + (bufoff) + ldsw + _i * 8192), 16, 0, 0); } while (0)
#define PG8_LDA(dst, b, h) do { _Pragma("unroll") for (int m = 0; m < 4; ++m) _Pragma("unroll") for (int k = 0; k < 2; ++k) dst[m][k] = *(const PG8_LAS bf16x8*)(lds + PG8_SA(b, h) + aoff + m * 2048 + k * 1024); } while (0)
#define PG8_LDB(dst, b, h) do { _Pragma("unroll") for (int n = 0; n < 2; ++n) _Pragma("unroll") for (int k = 0; k < 2; ++k) dst[n][k] = *(const PG8_LAS bf16x8*)(lds + PG8_SB(b, h) + boff + n * 2048 + k * 1024); } while (0)
#define PG8_MMA(ai, bj, At, Bt) do { __builtin_amdgcn_s_setprio(1); _Pragma("unroll") for (int m = 0; m < 4; ++m) _Pragma("unroll") for (int n = 0; n < 2; ++n) _Pragma("unroll") for (int k = 0; k < 2; ++k) \
        acc[ai][bj][m][n] = __builtin_amdgcn_mfma_f32_16x16x32_bf16(Bt[n][k], At[m][k], acc[ai][bj][m][n], 0, 0, 0); __builtin_amdgcn_s_setprio(0); } while (0)
#define PG8_WAIT_V(n) asm volatile("s_waitcnt vmcnt(" #n ")" ::: "memory")
#define PG8_WAIT_L(n) asm volatile("s_waitcnt lgkmcnt(" #n ")" ::: "memory")
#define PG8_BAR __builtin_amdgcn_s_barrier()
#define PG8_SCHED __builtin_amdgcn_sched_barrier(0)
    Unit cur, nxt; int ui = 0;
    if (!S.next(0, cur)) return;
    f32x4 acc[2][2][4][2];
#pragma unroll
    for (int a = 0; a < 2; ++a)
#pragma unroll
        for (int b = 0; b < 2; ++b)
#pragma unroll
            for (int m = 0; m < 4; ++m)
#pragma unroll
                for (int n = 0; n < 2; ++n) acc[a][b][m][n] = (f32x4){0.f, 0.f, 0.f, 0.f};
    bf16x8 At[4][2], B0[2][2], B1[2][2];
    const char* cA = (const char*)g.A + (size_t)cur.pm * tstep; const char* cB = (const char*)g.Bt + (size_t)cur.pn * tstep;
    S.a_ready(cur);
    if constexpr (SP2) {
        PG8_STAGE(PG8_SB(0, 0), cB, voffB); PG8_STAGE(PG8_SB(0, 1), cB + hstepB, voffB); PG8_STAGE(PG8_SA(0, 0), cA, voffA); PG8_STAGE(PG8_SA(0, 1), cA + hstep, voffA);
        if (wr == 1) PG8_BAR;
        PG8_WAIT_V(2); PG8_BAR;
        PG8_STAGE(PG8_SB(1, 0), cB + kstep, voffB); PG8_STAGE(PG8_SA(1, 0), cA + kstep, voffA); PG8_STAGE(PG8_SB(1, 1), cB + hstepB + kstep, voffB);
        PG8_WAIT_V(6); PG8_BAR;
    } else {
        PG8_STAGE(PG8_SB(0, 0), cB, voffB); PG8_STAGE(PG8_SA(0, 0), cA, voffA); PG8_STAGE(PG8_SB(0, 1), cB + hstepB, voffB); PG8_STAGE(PG8_SA(0, 1), cA + hstep, voffA);
        if (wr == 1) PG8_BAR;
        PG8_WAIT_V(4); PG8_BAR;
        PG8_STAGE(PG8_SB(1, 0), cB + kstep, voffB); PG8_STAGE(PG8_SA(1, 0), cA + kstep, voffA); PG8_STAGE(PG8_SB(1, 1), cB + hstepB + kstep, voffB);
        PG8_WAIT_V(6); PG8_BAR;
    }
    for (;;) {
        const bool has_next = S.next(ui + 1, nxt);
        const char* nA = has_next ? (const char*)g.A + (size_t)nxt.pm * tstep : cA; const char* nB = has_next ? (const char*)g.Bt + (size_t)nxt.pn * tstep : cB;
        for (int t = 0; t < nt; t += 2) {
            const bool last = (t == nt - 2);
            const char* a1 = cA + (size_t)(t + 1) * kstep;
            const char* a2 = last ? nA : cA + (size_t)(t + 2) * kstep; const char* b2 = last ? nB : cB + (size_t)(t + 2) * kstep;
            const char* a3 = a2 + kstep; const char* b3 = b2 + kstep;
            if (last && has_next) S.a_ready(nxt);
            if constexpr (SP2) {
            PG8_LDB(B0, 0, 0); PG8_LDB(B1, 0, 1); PG8_SCHED; PG8_LDA(At, 0, 0); PG8_STAGE(PG8_SA(1, 1), a1 + hstep, voffA);
            PG8_WAIT_V(8); PG8_WAIT_L(0); PG8_BAR; PG8_MMA(0, 0, At, B0); PG8_MMA(0, 1, At, B1); PG8_BAR; PG8_SCHED;
            PG8_LDA(At, 0, 1); PG8_STAGE(PG8_SB(0, 0), b2, voffB); PG8_STAGE(PG8_SB(0, 1), b2 + hstepB, voffB); PG8_STAGE(PG8_SA(0, 0), a2, voffA);
            PG8_WAIT_V(8); PG8_WAIT_L(0); PG8_BAR; PG8_MMA(1, 0, At, B0); PG8_MMA(1, 1, At, B1); PG8_BAR; PG8_SCHED;
            PG8_LDB(B0, 1, 0); PG8_LDB(B1, 1, 1); PG8_SCHED; PG8_LDA(At, 1, 0); PG8_STAGE(PG8_SA(0, 1), a2 + hstep, voffA);
            PG8_WAIT_V(8); PG8_WAIT_L(0); PG8_BAR; PG8_MMA(0, 0, At, B0); PG8_MMA(0, 1, At, B1); PG8_BAR; PG8_SCHED;
            PG8_LDA(At, 1, 1); PG8_STAGE(PG8_SB(1, 0), b3, voffB); PG8_STAGE(PG8_SB(1, 1), b3 + hstepB, voffB); PG8_STAGE(PG8_SA(1, 0), a3, voffA);
            PG8_WAIT_V(8); PG8_WAIT_L(0); PG8_BAR; PG8_MMA(1, 0, At, B0); PG8_MMA(1, 1, At, B1); PG8_BAR; PG8_SCHED;
            } else {
            PG8_LDB(B0, 0, 0); PG8_SCHED; PG8_LDA(At, 0, 0); PG8_STAGE(PG8_SA(1, 1), a1 + hstep, voffA);
            PG8_WAIT_L(8); PG8_BAR; PG8_WAIT_L(0); PG8_MMA(0, 0, At, B0); PG8_BAR; PG8_SCHED;
            PG8_LDB(B1, 0, 1); PG8_STAGE(PG8_SB(0, 0), b2, voffB);
            PG8_BAR; PG8_WAIT_L(0); PG8_MMA(0, 1, At, B1); PG8_BAR;
            PG8_LDA(At, 0, 1); PG8_STAGE(PG8_SA(0, 0), a2, voffA);
            PG8_BAR; PG8_WAIT_L(0); PG8_MMA(1, 0, At, B0); PG8_BAR; PG8_SCHED;
            PG8_STAGE(PG8_SB(0, 1), b2 + hstepB, voffB);
            PG8_WAIT_V(6); PG8_BAR; PG8_MMA(1, 1, At, B1); PG8_BAR;
            PG8_LDB(B0, 1, 0); PG8_SCHED; PG8_LDA(At, 1, 0); PG8_STAGE(PG8_SA(0, 1), a2 + hstep, voffA);
            PG8_WAIT_L(8); PG8_BAR; PG8_WAIT_L(0); PG8_MMA(0, 0, At, B0); PG8_BAR; PG8_SCHED;
            PG8_LDB(B1, 1, 1); PG8_STAGE(PG8_SB(1, 0), b3, voffB);
            PG8_BAR; PG8_WAIT_L(0); PG8_MMA(0, 1, At, B1); PG8_BAR;
            PG8_LDA(At, 1, 1); PG8_STAGE(PG8_SA(1, 0), a3, voffA);
            PG8_BAR; PG8_WAIT_L(0); PG8_MMA(1, 0, At, B0); PG8_BAR; PG8_SCHED;
            PG8_STAGE(PG8_SB(1, 1), b3 + hstepB, voffB);
            PG8_WAIT_V(6); PG8_BAR; PG8_MMA(1, 1, At, B1); PG8_BAR;
            }
        }
        if constexpr (ALIGN_EPI) { if (wr == 0) PG8_BAR; }
        if constexpr (!Epi::AFTER_DRAIN) { E(acc, cur, wr, wc, fr, fq); S.done(cur); }
        if (!has_next) break;
#pragma unroll
        for (int a = 0; a < 2; ++a)
#pragma unroll
            for (int b = 0; b < 2; ++b)
#pragma unroll
                for (int m = 0; m < 4; ++m)
#pragma unroll
                    for (int n = 0; n < 2; ++n) acc[a][b][m][n] = (f32x4){0.f, 0.f, 0.f, 0.f};
        cur = nxt; cA = nA; cB = nB; ++ui;
        if constexpr (ALIGN_EPI) { if (wr == 1) PG8_BAR; }
    }
    PG8_WAIT_V(0);
    if constexpr (!ALIGN_EPI) { if (wr == 0) PG8_BAR; }
    PG8_BAR;
#undef PG8_SA
#undef PG8_SB
#undef PG8_STAGE
#undef PG8_LDA
#undef PG8_LDB
#undef PG8_MMA
#undef PG8_WAIT_V
#undef PG8_WAIT_L
#undef PG8_BAR
#undef PG8_SCHED
}
}

namespace att {
constexpr int NW = 8, QBLK = 32, KVBLK = 64;
constexpr size_t SHM_V = KVBLK * 128 * 2, SHM_K = KVBLK * 128 * 2, SHM_ATTN = 2 * SHM_V + 2 * SHM_K + NW * 64 * 4;
#define KSWZ(row, colB) ((row) * 256 + ((colB) ^ (((row) & 7) << 4)))
#define SBAR() __builtin_amdgcn_sched_barrier(0)
__device__ __forceinline__ int crow(int r, int hi) { return (r & 3) + 8 * (r >> 2) + 4 * hi; }
__device__ __forceinline__ unsigned cvtpk(float lo, float hi) { unsigned r; asm volatile("v_cvt_pk_bf16_f32 %0, %1, %2" : "=v"(r) : "v"(lo), "v"(hi)); return r; }
__device__ __forceinline__ void expA(f32x16& p0) {
#pragma unroll
    for (int r = 0; r < 16; ++r) p0[r] = __builtin_amdgcn_exp2f(p0[r]);
}
__device__ __forceinline__ void finishSM(f32x16& p0, f32x16& p1, float& l_reg, bf16x8& pa0, bf16x8& pa1, bf16x8& pa2, bf16x8& pa3) {
#pragma unroll
    for (int r = 0; r < 16; ++r) p1[r] = __builtin_amdgcn_exp2f(p1[r]);
    float ps = 0;
#pragma unroll
    for (int r = 0; r < 16; ++r) ps += p0[r];
#pragma unroll
    for (int r = 0; r < 16; ++r) ps += p1[r];
    l_reg += ps;
#define PK4(P, BASE, OUT) do { unsigned a0 = cvtpk(P[BASE + 0], P[BASE + 1]), a1 = cvtpk(P[BASE + 2], P[BASE + 3]);   \
    unsigned b0 = cvtpk(P[BASE + 4], P[BASE + 5]), b1 = cvtpk(P[BASE + 6], P[BASE + 7]);                              \
    auto r0 = __builtin_amdgcn_permlane32_swap(a0, b0, false, false); auto r1 = __builtin_amdgcn_permlane32_swap(a1, b1, false, false); \
    u32x4 w = {r0[0], r1[0], r0[1], r1[1]}; OUT = *reinterpret_cast<bf16x8*>(&w); } while (0)
    PK4(p0, 0, pa0); PK4(p0, 8, pa1); PK4(p1, 0, pa2); PK4(p1, 8, pa3);
#undef PK4
}
__device__ __forceinline__ void qkt(f32x16& p0, f32x16& p1, const char* Ks, const bf16x8* qr, int kbase, float negM) {
#pragma unroll
    for (int r = 0; r < 16; ++r) { p0[r] = negM; p1[r] = negM; }
#pragma unroll
    for (int d0 = 0; d0 < 4; ++d0) { int kb = kbase; asm volatile("" : "+v"(kb)); const int ad = kb ^ (d0 * 32);
        bf16x8 b0 = *reinterpret_cast<const bf16x8*>(Ks + ad);
        bf16x8 b1 = *reinterpret_cast<const bf16x8*>(Ks + ad + 8192);
        p0 = __builtin_amdgcn_mfma_f32_32x32x16_bf16(b0, qr[d0], p0, 0, 0, 0);
        p1 = __builtin_amdgcn_mfma_f32_32x32x16_bf16(b1, qr[d0], p1, 0, 0, 0); }
}
__device__ __forceinline__ int v_st(int k, int c) { const int kk = (k & ~0xC) | ((k & 4) << 1) | ((k & 8) >> 1); return ((kk >> 3) * 4 + (c >> 5)) * 512 + ((kk & 7) * 32 + (c & 31)) * 2; }
__device__ __forceinline__ int v_rd_base(int lane) { return ((lane & 3) << 3) | (((lane >> 2) & 3) << 6) | (((lane >> 4) & 1) << 5) | (((lane >> 5) & 1) << 8); }
constexpr int v_rd_off(int d0, int ks, int half) { return d0 * 512 + ks * 4096 + half * 2048; }
template <int OFF> __device__ __forceinline__ s16x4 tr_read(int vb) { s16x4 r; asm volatile("ds_read_b64_tr_b16 %0, %1 offset:%2" : "=&v"(r) : "v"(vb), "i"(OFF) : "memory"); return r; }
template <int D0> __device__ __forceinline__ void pv_one(f32x16& od, int vb, bf16x8 pa0, bf16x8 pa1, bf16x8 pa2, bf16x8 pa3) {
    const s16x4 l0 = tr_read<v_rd_off(D0, 0, 0)>(vb), h0 = tr_read<v_rd_off(D0, 0, 1)>(vb), l1 = tr_read<v_rd_off(D0, 1, 0)>(vb), h1 = tr_read<v_rd_off(D0, 1, 1)>(vb);
    const s16x4 l2 = tr_read<v_rd_off(D0, 2, 0)>(vb), h2 = tr_read<v_rd_off(D0, 2, 1)>(vb), l3 = tr_read<v_rd_off(D0, 3, 0)>(vb), h3 = tr_read<v_rd_off(D0, 3, 1)>(vb);
    asm volatile("s_waitcnt lgkmcnt(0)" ::: "memory"); SBAR();
#define PK(Lo, Hi) (bf16x8){Lo[0], Lo[1], Lo[2], Lo[3], Hi[0], Hi[1], Hi[2], Hi[3]}
    od = __builtin_amdgcn_mfma_f32_32x32x16_bf16(pa0, PK(l0, h0), od, 0, 0, 0);
    od = __builtin_amdgcn_mfma_f32_32x32x16_bf16(pa1, PK(l1, h1), od, 0, 0, 0);
    od = __builtin_amdgcn_mfma_f32_32x32x16_bf16(pa2, PK(l2, h2), od, 0, 0, 0);
    od = __builtin_amdgcn_mfma_f32_32x32x16_bf16(pa3, PK(l3, h3), od, 0, 0, 0);
#undef PK
}
__device__ __forceinline__ void pv_d0(f32x16* o, int vb, bf16x8 pa0, bf16x8 pa1, bf16x8 pa2, bf16x8 pa3) {
    pv_one<0>(o[0], vb, pa0, pa1, pa2, pa3); pv_one<1>(o[1], vb, pa0, pa1, pa2, pa3); pv_one<2>(o[2], vb, pa0, pa1, pa2, pa3); pv_one<3>(o[3], vb, pa0, pa1, pa2, pa3);
}
__device__ __forceinline__ void attn_item(const bf16* PB, bf16* Y, const float* subg, const float* SC, const bool cx, int b, int h, int q0, char* lds, const int tid) {
    const int wid = tid >> 6, lane = tid & 63, r32 = lane & 31, hi = lane >> 5, wq = wid & 3, map = wid >> 2;
    char* V_lds = lds; char* K_lds = lds + 2 * SHM_V;
    const float negM = __builtin_bit_cast(float, __builtin_amdgcn_readfirstlane(__builtin_bit_cast(int, -SC[1] * LOG2E)));
    float l_reg = 0; f32x16 o[4] = {}; bf16x8 qr[4];
    const int rowq0 = (cx ? M + b * CL : b * L) + q0;
    const bf16* Qw = PB + (size_t)(rowq0 + wq * QBLK + r32) * IN_W + Q_OFF + h * 128 + map * 64 + hi * 8;
#pragma unroll
    for (int d0 = 0; d0 < 4; ++d0) qr[d0] = *reinterpret_cast<const bf16x8*>(Qw + d0 * 16);
    const int sr = tid >> 4, sc = (tid & 15) * 8, vst0 = v_st(sr, sc), vst1 = v_st(32 + sr, sc);
    const int vb0 = (int)(uintptr_t)V_lds + v_rd_base(lane);
    const int kbase = r32 * 256 + ((map * 128 + hi * 16) ^ ((r32 & 7) << 4));
    const int NT = cx ? CL / KVBLK : (CL + L) / KVBLK;
    struct { bf16x8 vs0, vs1, ks0, ks1; } sr_[2];
    const __amdgpu_buffer_rsrc_t rs = __builtin_amdgcn_make_buffer_rsrc((void*)PB, (short)0, (int)((size_t)MT * IN_W * 2), 0x00020000);
    const unsigned voff = (unsigned)(sr * IN_W + sc) * 2u;
    const unsigned so_ctx = (unsigned)((M + b * CL) * IN_W + h * 128) * 2u, so_lat = (unsigned)((b * L - CL) * IN_W + h * 128) * 2u;
#define LD16(so) __builtin_bit_cast(bf16x8, __builtin_amdgcn_raw_buffer_load_b128(rs, voff, (so), 0))
#define SLOAD(i, t) do { const int t_ = (t); const unsigned so_ = (t_ < CL / KVBLK ? so_ctx : so_lat) + (unsigned)(t_ * KVBLK) * (unsigned)(IN_W * 2); \
        sr_[i].vs0 = LD16(so_ + V_OFF * 2); sr_[i].vs1 = LD16(so_ + V_OFF * 2 + 32 * IN_W * 2); sr_[i].ks0 = LD16(so_ + K_OFF * 2); sr_[i].ks1 = LD16(so_ + K_OFF * 2 + 32 * IN_W * 2); } while (0)
#define SWRITE(bb, i) do { *(bf16x8*)(V_lds + (bb) * SHM_V + vst0) = sr_[i].vs0; *(bf16x8*)(V_lds + (bb) * SHM_V + vst1) = sr_[i].vs1; const int kc = sc * 2; \
    *(bf16x8*)(K_lds + (bb) * SHM_K + KSWZ(sr, kc)) = sr_[i].ks0; *(bf16x8*)(K_lds + (bb) * SHM_K + KSWZ(32 + sr, kc)) = sr_[i].ks1; } while (0)
#define SWAIT() asm volatile("s_waitcnt vmcnt(4)" ::: "memory")
    f32x16 pA0, pA1, pB0, pB1; bf16x8 pa0, pa1, pa2, pa3;
    constexpr int SE = 0, SO = 1;
    SLOAD(SE, 0); asm volatile("s_waitcnt vmcnt(0)" ::: "memory"); SWRITE(0, SE); __syncthreads();
    qkt(pA0, pA1, K_lds, qr, kbase, negM); expA(pA0);
    SLOAD(SO, 1); if (2 < NT) SLOAD(SE, 2);
    SWAIT(); SWRITE(1, SO); __syncthreads();
    for (int j = 1; j + 1 < NT; j += 2) {
        SBAR(); qkt(pB0, pB1, K_lds + SHM_K, qr, kbase, negM);
        finishSM(pA0, pA1, l_reg, pa0, pa1, pa2, pa3); SBAR();
        SLOAD(SO, j + 2); SBAR();
        pv_d0(o, vb0, pa0, pa1, pa2, pa3); expA(pB0);
        __syncthreads(); SWAIT(); SWRITE(0, SE);
        __syncthreads();
        SBAR(); qkt(pA0, pA1, K_lds, qr, kbase, negM);
        finishSM(pB0, pB1, l_reg, pa0, pa1, pa2, pa3); SBAR();
        if (j + 3 < NT) SLOAD(SE, j + 3); SBAR();
        pv_d0(o, vb0 + (int)SHM_V, pa0, pa1, pa2, pa3); expA(pA0);
        __syncthreads(); SWAIT(); SWRITE(1, SO);
        __syncthreads();
    }
    SBAR(); qkt(pB0, pB1, K_lds + SHM_K, qr, kbase, negM);
    finishSM(pA0, pA1, l_reg, pa0, pa1, pa2, pa3); SBAR();
    pv_d0(o, vb0, pa0, pa1, pa2, pa3); expA(pB0);
    finishSM(pB0, pB1, l_reg, pa0, pa1, pa2, pa3); SBAR();
    pv_d0(o, vb0 + (int)SHM_V, pa0, pa1, pa2, pa3);
#undef SLOAD
#undef LD16
#undef SWRITE
#undef SWAIT
    int tid2 = tid; asm volatile("" : "+v"(tid2));
    { const int wid = tid2 >> 6, lane = tid2 & 63, r32 = lane & 31, hi = lane >> 5, wq = wid & 3, map = wid >> 2;
    float* li_l = (float*)(lds + 2 * SHM_V + 2 * SHM_K) + wid * 64;
    const float* SC2 = SC; asm volatile("" : "+s"(SC2));
    const float lam = SC2[0], lam_init = SC2[2];
    l_reg = half_swap_sum(l_reg);
    if (hi == 0) li_l[r32] = l_reg;
    asm volatile("s_waitcnt lgkmcnt(0)" ::: "memory");
    float rli[16];
#pragma unroll
    for (int r = 0; r < 16; ++r) rli[r] = __builtin_amdgcn_rcpf(li_l[crow(r, hi)]);
    __syncthreads();
    float* X = (float*)lds + wq * 4096;
    if (map == 1) {
#pragma unroll
        for (int r = 0; r < 16; ++r)
#pragma unroll
            for (int d0 = 0; d0 < 4; ++d0) X[crow(r, hi) * 128 + d0 * 32 + r32] = o[d0][r] * rli[r];
    }
    __syncthreads();
    if (map == 0) {
        const float oml = 1.f - lam_init;
        float sg[4];
#pragma unroll
        for (int d0 = 0; d0 < 4; ++d0) sg[d0] = subg[d0 * 32 + r32] * oml;
        const size_t rowb = (size_t)((cx ? M + b * CL : b * L) + q0 + wq * QBLK);
#pragma unroll
        for (int r = 0; r < 16; ++r) {
            const int qrow = crow(r, hi);
            float v[4], ss = 0.f;
#pragma unroll
            for (int d0 = 0; d0 < 4; ++d0) { v[d0] = o[d0][r] * rli[r] - lam * X[qrow * 128 + d0 * 32 + r32]; ss += v[d0] * v[d0]; }
            ss += sxor<1>(ss); ss += sxor<2>(ss); ss += sxor<4>(ss); ss += sxor<8>(ss); ss += sxor<16>(ss);
            const float rs = 1.0f / sqrtf(ss * (1.f / 128.f) + EPS);
            const bf16* grow = PB + (rowb + qrow) * IN_W + G_OFF + 512 + h * 128 + r32;
            bf16* yrow = Y + (rowb + qrow) * 1024 + 512 + h * 128 + r32;
#pragma unroll
            for (int d0 = 0; d0 < 4; ++d0) yrow[d0 * 32] = (bf16)f2bf(v[d0] * rs * sg[d0] * silu_f(bf2f(grow[d0 * 32])));
        }
    }
    }
    __syncthreads();
}
#undef KSWZ
#undef SBAR
}


namespace att2 {
constexpr int NW = 8, QBLK = 32, KVBLK = 64, NSLOT = 4, KSLOT = 16384, VSLOT = 16384;
constexpr int LDS_K = 0, LDS_V = NSLOT * KSLOT, LDS_WS = 132096, LDS_END = LDS_WS + NW * 256;
#define SBAR() __builtin_amdgcn_sched_barrier(0)
__device__ __forceinline__ int crow(int r, int hi) { return (r & 3) + 8 * (r >> 2) + 4 * hi; }
typedef __attribute__((address_space(3))) const char* lds_cptr;
typedef short v4i16_t __attribute__((ext_vector_type(4)));
typedef float f32x2_t __attribute__((ext_vector_type(2))); typedef __bf16 bf16x2_t __attribute__((ext_vector_type(2)));
__device__ __forceinline__ unsigned cvtpk_s(float lo, float hi) { f32x2_t v = {lo, hi}; bf16x2_t b = __builtin_convertvector(v, bf16x2_t); return __builtin_bit_cast(unsigned, b); }
__device__ __forceinline__ s16x4 vtr(lds_cptr p) { return __builtin_bit_cast(s16x4, __builtin_amdgcn_ds_read_tr16_b64_v4i16((__attribute__((address_space(3))) v4i16_t*)p)); }
__device__ __forceinline__ void glds16s(const void* sbase, unsigned voff, unsigned lds_dst) { unsigned keep;
    asm volatile("s_mov_b32 %0, m0\n\ts_mov_b32 m0, %3\n\ts_nop 0\n\tglobal_load_lds_dwordx4 %1, %2\n\ts_mov_b32 m0, %0" : "=&s"(keep) : "v"(voff), "s"(sbase), "s"(lds_dst) : "memory"); }
#define WAIT_BAR(N) asm volatile("s_waitcnt vmcnt(" #N ") lgkmcnt(0)\n\ts_barrier" ::: "memory")
__device__ __forceinline__ void kload2(bf16x8* kf, lds_cptr kp, int j) { kf[2 * j] = *(const __attribute__((address_space(3))) bf16x8*)(kp + j * 2048); kf[2 * j + 1] = *(const __attribute__((address_space(3))) bf16x8*)(kp + j * 2048 + 512); }

__device__ __forceinline__ void attn_item(const bf16* PB, const unsigned char* KT, const unsigned char* VT, bf16* Y, const float* subg, const float* SC, const bool cx, int b, int h, int q0, char* shm, const int tid) {
    const int lane = tid & 63, r32 = lane & 31, hi = lane >> 5; const int wid = __builtin_amdgcn_readfirstlane(tid >> 6); const int wq = wid & 3, map = wid >> 2;
    const int rowq0 = (cx ? M + b * CL : b * L) + q0;
    const unsigned lds0 = (unsigned)(uintptr_t)shm;
    const unsigned koff = (unsigned)(wid * 1024 + lane * 16);
    const unsigned voff = (unsigned)(((wid >> 2) * 4 + (wid & 3)) * 1024 + lane * 16);
    const unsigned kdst = lds0 + LDS_K + wid * 1024, vdst = lds0 + LDS_V + ((wid >> 2) * 4 + (wid & 3)) * 1024;
    const char* ktb = (const char*)KT + (size_t)((b * 4 + h) * NTILE) * 16384; const char* vtb = (const char*)VT + (size_t)((b * 4 + h) * NTILE) * 16384;
#define DMA_K(t, slot) do { const char* tb_ = ktb + (size_t)(t) * 16384; const unsigned d_ = (unsigned)__builtin_amdgcn_readfirstlane(kdst + (slot)); glds16s(tb_, koff, d_); glds16s(tb_, koff + 8192u, d_ + 8192u); } while (0)
#define DMA_V(t, slot) do { const char* tb_ = vtb + (size_t)(t) * 16384; const unsigned d_ = (unsigned)__builtin_amdgcn_readfirstlane(vdst + (slot)); glds16s(tb_, voff, d_); glds16s(tb_, voff + 8192u, d_ + 8192u); } while (0)
    const lds_cptr shm3 = (lds_cptr)shm;
    const lds_cptr kp0 = shm3 + LDS_K + map * 8192 + hi * 1024 + r32 * 16;
    const lds_cptr vp0 = shm3 + LDS_V + ((lane >> 4) & 1) * 32 + (lane & 3) * 8 + (4 * hi + ((lane & 15) >> 2)) * 64;
    const int NT = cx ? CL / KVBLK : (CL + L) / KVBLK;
    DMA_K(0, 0); DMA_V(0, 0); DMA_K(1, KSLOT);
    bf16x8 qr[4];
    { const bf16* Qw = PB + (size_t)(rowq0 + wq * QBLK + r32) * IN_W + Q_OFF + h * 128 + map * 64 + hi * 8;
#pragma unroll
      for (int d0 = 0; d0 < 4; ++d0) qr[d0] = *reinterpret_cast<const bf16x8*>(Qw + d0 * 16); }
    float l_reg = 0.f; f32x16 o[4]; o[0] = f32x16{}; o[1] = f32x16{}; o[2] = f32x16{}; o[3] = f32x16{};
    const f32x16 zero = f32x16{};
    f32x16 pA0, pA1, pB0, pB1; bf16x8 kf[8];
    int s_m2 = 3 * KSLOT, s_m1 = 0, s_0 = KSLOT, s_p1 = 2 * KSLOT;
#define ROT4() do { const int x_ = s_m2; s_m2 = s_m1; s_m1 = s_0; s_0 = s_p1; s_p1 = x_; } while (0)
    DMA_K(2, 2 * KSLOT);
    WAIT_BAR(6);
    {
      const lds_cptr kb = kp0;
#pragma unroll
      for (int d0 = 0; d0 < 4; ++d0) { const bf16x8 b0 = *(const __attribute__((address_space(3))) bf16x8*)(kb + d0 * 2048), b1 = *(const __attribute__((address_space(3))) bf16x8*)(kb + d0 * 2048 + 512);
          if (d0 == 0) { pA0 = __builtin_amdgcn_mfma_f32_32x32x16_bf16(b0, qr[0], zero, 0, 0, 0); pA1 = __builtin_amdgcn_mfma_f32_32x32x16_bf16(b1, qr[0], zero, 0, 0, 0); }
          else { pA0 = __builtin_amdgcn_mfma_f32_32x32x16_bf16(b0, qr[d0], pA0, 0, 0, 0); pA1 = __builtin_amdgcn_mfma_f32_32x32x16_bf16(b1, qr[d0], pA1, 0, 0, 0); } }
#pragma unroll
      for (int r = 0; r < 16; ++r) { pA0[r] = __builtin_amdgcn_exp2f(pA0[r]); pA1[r] = __builtin_amdgcn_exp2f(pA1[r]); } }
    WAIT_BAR(0);
    DMA_K(3, 3 * KSLOT); DMA_V(1, VSLOT);
    WAIT_BAR(4);
    s16x4 vlo[8], vhi[8]; u32x4 pw0, pw1, pw2, pw3;
#define PATH_ENTRY() int ln_; asm volatile("v_mbcnt_lo_u32_b32 %0, -1, 0\n\tv_mbcnt_hi_u32_b32 %0, -1, %0" : "=v"(ln_)); \
    const unsigned koff = (unsigned)(wid * 1024 + ln_ * 16); \
    const unsigned voff = (unsigned)(((wid >> 2) * 4 + (wid & 3)) * 1024 + ln_ * 16); \
    kload2(kf, kp0 + s_0, 0); kload2(kf, kp0 + s_0, 1); kload2(kf, kp0 + s_0, 2); kload2(kf, kp0 + s_0, 3);
#define PKW(P, B) cvtpk_s(P[B], P[B + 1])
#define PAF(k) __builtin_bit_cast(bf16x8, pw##k)
#define VFR(i) (bf16x8){vlo[i][0], vlo[i][1], vlo[i][2], vlo[i][3], vhi[i][0], vhi[i][1], vhi[i][2], vhi[i][3]}
#define PIN(x) asm volatile("" : "+v"(x))
#define EX(v) __builtin_amdgcn_exp2f(v)
#define VRD(s, d0, ks) do { vlo[s] = vtr(vp_ + ((d0) * 4096 + (ks) * 1024)); vhi[s] = vtr(vp_ + ((d0) * 4096 + (ks) * 1024 + 512)); } while (0)
#define GAPA(MF, A0, A1, A2, A3, W0, W1, PW) do { MF; W0; W1; PIN(PW); SBAR(); } while (0)
#define GAPB(MF, X, B, S) do { MF; X[B] = EX(X[B]); X[B + 1] = EX(X[B + 1]); PIN(X); sacc += S[B]; sacc += S[B + 1]; PIN(sacc); SBAR(); } while (0)
#define KRD(G, KS, j) do { if (G) { kload2(kf, kp0 + (KS), j); SBAR(); } } while (0)
#define MF32(a, b, c) __builtin_amdgcn_mfma_f32_32x32x16_bf16(a, b, c, 0, 0, 0)
#define PHASE_A(C0, C1, P0, P1, VS) do { SBAR(); \
    const lds_cptr vp_ = vp0 + (VS); \
    VRD(0, 0, 0); SBAR(); \
    GAPA(C0 = MF32(kf[0], qr[0], zero), P0[2], P0[3], P0[4], P0[5],     pw0[0] = PKW(P0, 0),  pw0[1] = PKW(P0, 2),  pw0); \
    VRD(1, 1, 0); SBAR(); GAPA(C1 = MF32(kf[1], qr[0], zero), P0[6], P0[7], P0[8], P0[9],     pw0[2] = PKW(P0, 4),  pw0[3] = PKW(P0, 6),  pw0); \
    VRD(2, 2, 0); SBAR(); GAPA(C0 = MF32(kf[2], qr[1], C0),   P0[10], P0[11], P0[12], P0[13], pw1[0] = PKW(P0, 8),  pw1[1] = PKW(P0, 10), pw1); \
    VRD(3, 3, 0); SBAR(); GAPA(C1 = MF32(kf[3], qr[1], C1),   P0[14], P0[15], P1[0], P1[1],   pw1[2] = PKW(P0, 12), pw1[3] = PKW(P0, 14), pw1); \
    VRD(4, 0, 1); SBAR(); GAPA(C0 = MF32(kf[4], qr[2], C0),   P1[2], P1[3], P1[4], P1[5],     pw2[0] = PKW(P1, 0),  pw2[1] = PKW(P1, 2),  pw2); \
    VRD(5, 1, 1); SBAR(); GAPA(C1 = MF32(kf[5], qr[2], C1),   P1[6], P1[7], P1[8], P1[9],     pw2[2] = PKW(P1, 4),  pw2[3] = PKW(P1, 6),  pw2); \
    VRD(6, 2, 1); SBAR(); GAPA(C0 = MF32(kf[6], qr[3], C0),   P1[10], P1[11], P1[12], P1[13], pw3[0] = PKW(P1, 8),  pw3[1] = PKW(P1, 10), pw3); \
    VRD(7, 3, 1); SBAR(); GAPA(C1 = MF32(kf[7], qr[3], C1),   P1[14], P1[15], 0.f, 0.f,       pw3[2] = PKW(P1, 12), pw3[3] = PKW(P1, 14), pw3); \
    SBAR(); } while (0)
#define PHASE_B(X0, X1, S0, S1, VS, KS, GL) do { SBAR(); \
    const lds_cptr vp_ = vp0 + (VS); float sacc = 0.f; \
    GAPB(o[0] = MF32(PAF(0), VFR(0), o[0]), X0, 0, S0);  VRD(0, 0, 2); SBAR(); \
    GAPB(o[1] = MF32(PAF(0), VFR(1), o[1]), X0, 2, S0);  VRD(1, 1, 2); SBAR(); \
    GAPB(o[2] = MF32(PAF(0), VFR(2), o[2]), X0, 4, S0);  VRD(2, 2, 2); SBAR(); \
    GAPB(o[3] = MF32(PAF(0), VFR(3), o[3]), X0, 6, S0);  VRD(3, 3, 2); SBAR(); KRD(GL, KS, 0); \
    GAPB(o[0] = MF32(PAF(1), VFR(4), o[0]), X0, 8, S0);  VRD(4, 0, 3); SBAR(); KRD(GL, KS, 1); \
    GAPB(o[1] = MF32(PAF(1), VFR(5), o[1]), X0, 10, S0); VRD(5, 1, 3); SBAR(); KRD(GL, KS, 2); \
    GAPB(o[2] = MF32(PAF(1), VFR(6), o[2]), X0, 12, S0); VRD(6, 2, 3); SBAR(); KRD(GL, KS, 3); \
    GAPB(o[3] = MF32(PAF(1), VFR(7), o[3]), X0, 14, S0); VRD(7, 3, 3); SBAR(); \
    GAPB(o[0] = MF32(PAF(2), VFR(0), o[0]), X1, 0, S1); \
    GAPB(o[1] = MF32(PAF(2), VFR(1), o[1]), X1, 2, S1); \
    GAPB(o[2] = MF32(PAF(2), VFR(2), o[2]), X1, 4, S1); \
    GAPB(o[3] = MF32(PAF(2), VFR(3), o[3]), X1, 6, S1); \
    GAPB(o[0] = MF32(PAF(3), VFR(4), o[0]), X1, 8, S1); \
    GAPB(o[1] = MF32(PAF(3), VFR(5), o[1]), X1, 10, S1); \
    GAPB(o[2] = MF32(PAF(3), VFR(6), o[2]), X1, 12, S1); \
    GAPB(o[3] = MF32(PAF(3), VFR(7), o[3]), X1, 14, S1); \
    l_reg += sacc; } while (0)
#define DMA_T(t) do { if ((t) + 3 < NT) { DMA_K((t) + 3, s_m1); } if ((t) + 1 < NT) { DMA_V((t) + 1, s_p1); } } while (0)
#define ENDW(tt) do { if ((tt) + 3 < NT) { WAIT_BAR(4); } else if ((tt) + 1 < NT) { WAIT_BAR(2); } else { WAIT_BAR(0); } } while (0)
#define DMA_F(t) do { DMA_K((t) + 3, s_m1); DMA_V((t) + 1, s_p1); } while (0)
    if (map == 0) {
        __builtin_amdgcn_s_setprio(1);
        PATH_ENTRY();
        int t = 1;
#pragma clang loop unroll(disable)
        for (; t + 5 < NT; t += 2) {
            PHASE_A(pB0, pB1, pA0, pA1, s_m1); DMA_F(t);     PHASE_B(pB0, pB1, pA0, pA1, s_m1, s_p1, true); WAIT_BAR(4); ROT4();
            PHASE_A(pA0, pA1, pB0, pB1, s_m1); DMA_F(t + 1); PHASE_B(pA0, pA1, pB0, pB1, s_m1, s_p1, true); WAIT_BAR(4); ROT4();
        }
#pragma clang loop unroll(disable)
        for (; t + 1 < NT; t += 2) {
            PHASE_A(pB0, pB1, pA0, pA1, s_m1); DMA_T(t);     PHASE_B(pB0, pB1, pA0, pA1, s_m1, s_p1, true); ENDW(t);     ROT4();
            PHASE_A(pA0, pA1, pB0, pB1, s_m1); DMA_T(t + 1); PHASE_B(pA0, pA1, pB0, pB1, s_m1, s_p1, true); ENDW(t + 1); ROT4();
        }
        PHASE_A(pB0, pB1, pA0, pA1, s_m1); PHASE_B(pB0, pB1, pA0, pA1, s_m1, s_p1, false); WAIT_BAR(0);
        __builtin_amdgcn_s_setprio(0);
    } else {
        PATH_ENTRY();
        DMA_T(1); PHASE_A(pB0, pB1, pA0, pA1, s_m1); ENDW(1); ROT4();
        int t = 2;
#pragma clang loop unroll(disable)
        for (; t + 5 < NT; t += 2) {
            PHASE_B(pB0, pB1, pA0, pA1, s_m2, s_0, true); DMA_F(t);     PHASE_A(pA0, pA1, pB0, pB1, s_m1); WAIT_BAR(4); ROT4();
            PHASE_B(pA0, pA1, pB0, pB1, s_m2, s_0, true); DMA_F(t + 1); PHASE_A(pB0, pB1, pA0, pA1, s_m1); WAIT_BAR(4); ROT4();
        }
#pragma clang loop unroll(disable)
        for (; t + 1 < NT; t += 2) {
            PHASE_B(pB0, pB1, pA0, pA1, s_m2, s_0, true); DMA_T(t);     PHASE_A(pA0, pA1, pB0, pB1, s_m1); ENDW(t);     ROT4();
            PHASE_B(pA0, pA1, pB0, pB1, s_m2, s_0, true); DMA_T(t + 1); PHASE_A(pB0, pB1, pA0, pA1, s_m1); ENDW(t + 1); ROT4();
        }
        PHASE_B(pB0, pB1, pA0, pA1, s_m2, s_0, false);
        s_0 = s_m1;
    }
#undef DMA_F
#undef PATH_ENTRY
    WAIT_BAR(0);
    { float sacc = pB0[0] + pB0[1];
#pragma unroll
      for (int r = 2; r < 16; ++r) sacc += pB0[r];
#pragma unroll
      for (int r = 0; r < 16; ++r) sacc += pB1[r];
      l_reg += sacc;
      pw0 = (u32x4){PKW(pB0, 0), PKW(pB0, 2), PKW(pB0, 4), PKW(pB0, 6)}; pw1 = (u32x4){PKW(pB0, 8), PKW(pB0, 10), PKW(pB0, 12), PKW(pB0, 14)};
      pw2 = (u32x4){PKW(pB1, 0), PKW(pB1, 2), PKW(pB1, 4), PKW(pB1, 6)}; pw3 = (u32x4){PKW(pB1, 8), PKW(pB1, 10), PKW(pB1, 12), PKW(pB1, 14)};
      SBAR();
      const lds_cptr vp_ = vp0 + s_0;
#pragma unroll
      for (int d0 = 0; d0 < 4; ++d0) {
          VRD(0, d0, 0); VRD(1, d0, 1); VRD(2, d0, 2); VRD(3, d0, 3);
          o[d0] = MF32(PAF(0), VFR(0), o[d0]); o[d0] = MF32(PAF(1), VFR(1), o[d0]); o[d0] = MF32(PAF(2), VFR(2), o[d0]); o[d0] = MF32(PAF(3), VFR(3), o[d0]); } }
#undef PKW
#undef PAF
#undef VFR
#undef PIN
#undef EX
#undef VRD
#undef GAPA
#undef GAPB
#undef KRD
#undef MF32
#undef PHASE_A
#undef PHASE_B
#undef DMA_T
#undef ENDW
#undef ROT4
#undef DMA_K
#undef DMA_V
    int tid2; asm volatile("v_mbcnt_lo_u32_b32 %0, -1, 0\n\tv_mbcnt_hi_u32_b32 %0, -1, %0" : "=v"(tid2)); tid2 += wid * 64;
    { const int wid = tid2 >> 6, lane = tid2 & 63, r32 = lane & 31, hi = lane >> 5, wq = wid & 3, map = wid >> 2;
    float* li_l = (float*)(shm + LDS_WS) + wid * 64;
    const float* SC2 = SC; asm volatile("" : "+s"(SC2));
    const float lam = SC2[0], lam_init = SC2[2];
    const size_t rowb = (size_t)((cx ? M + b * CL : b * L) + q0 + wq * QBLK);
    u32x4 gt[8];
    if (map == 0) {
        const bf16* gp = PB + (rowb + (lane >> 4)) * IN_W + G_OFF + 512 + h * 128 + (lane & 15) * 8;
#pragma unroll
        for (int i = 0; i < 8; ++i) gt[i] = *(const u32x4*)(gp + (size_t)(4 * i) * IN_W);
    }
    l_reg = half_swap_sum(l_reg);
    if (hi == 0) li_l[r32] = l_reg;
    asm volatile("s_waitcnt lgkmcnt(0)" ::: "memory");
    float rli[16];
#pragma unroll
    for (int r = 0; r < 16; ++r) rli[r] = __builtin_amdgcn_rcpf(li_l[crow(r, hi)]);
    __syncthreads();
    float* X = (float*)shm + wq * 4096;
    bf16* GY = (bf16*)(shm + LDS_V) + wq * 4096;
    if (map == 1) {
#pragma unroll
        for (int r = 0; r < 16; ++r)
#pragma unroll
            for (int d0 = 0; d0 < 4; ++d0) X[crow(r, hi) * 128 + d0 * 32 + r32] = o[d0][r] * rli[r];
    } else {
#pragma unroll
        for (int i = 0; i < 8; ++i) *(u32x4*)(GY + ((lane >> 4) + 4 * i) * 128 + (lane & 15) * 8) = gt[i];
    }
    __syncthreads();
    if (map == 0) {
        const float oml = 1.f - lam_init;
        float sg[4];
#pragma unroll
        for (int d0 = 0; d0 < 4; ++d0) sg[d0] = subg[d0 * 32 + r32] * oml;
#pragma unroll
        for (int r = 0; r < 16; ++r) {
            const int qrow = crow(r, hi);
            float v[4], ss = 0.f;
#pragma unroll
            for (int d0 = 0; d0 < 4; ++d0) { v[d0] = o[d0][r] * rli[r] - lam * X[qrow * 128 + d0 * 32 + r32]; ss += v[d0] * v[d0]; }
            ss = sum32(ss);
            const float rs = __builtin_amdgcn_rsqf(ss * (1.f / 128.f) + EPS);
            bf16* gy = GY + qrow * 128 + r32;
#pragma unroll
            for (int d0 = 0; d0 < 4; ++d0) gy[d0 * 32] = (bf16)f2bf(v[d0] * rs * sg[d0] * silu_f(bf2f(gy[d0 * 32])));
        }
        asm volatile("s_waitcnt lgkmcnt(0)" ::: "memory");
        bf16* yp = Y + (rowb + (lane >> 4)) * 1024 + 512 + h * 128 + (lane & 15) * 8;
#pragma unroll
        for (int i = 0; i < 8; ++i) st_wt16(yp + (size_t)(4 * i) * 1024, *(const u32x4*)(GY + ((lane >> 4) + 4 * i) * 128 + (lane & 15) * 8));
    }
    }
    __syncthreads();
}
#undef SBAR
#undef WAIT_BAR
}

constexpr int NWAVES = 8;
constexpr int RING_OFF = 0, RING_BYTES = 131072;
constexpr int LDSCTL_OFF = RING_BYTES, MISC_OFF = LDSCTL_OFF + 320;
constexpr int LDS_BYTES = 147456;
constexpr int CW_BAR = 1024;
constexpr int CW_FFT = 8192;
constexpr int CW_SEAM = 4608;
#define SEAM_HCNT(i) (CW_SEAM + 16 * (i))
#define SEAM_CCNT    (CW_SEAM + 16 * 64)
#define SEAM_MODCNT  (CW_SEAM + 16 * 130)
#define SEAM_PREPCNT (CW_SEAM + 16 * 131)
constexpr int CW_Q = 8192 + 1024;
constexpr int CW_YCNT = 10240;
#define SEAM_YCNT(l, blk) (CW_YCNT + 16 * (66 * (l) + (blk)))
#define SEAM_XCNT(i) (CW_YCNT + 16 * (132 + (i)))
#define SEAM_CXCNT   (CW_YCNT + 16 * 196)
#define SEAM_MIXDONE (CW_YCNT + 16 * 197)
#define SEAM_NQ      (CW_YCNT + 16 * 198)

typedef GAS unsigned gu32;
#define RLX_AGENT __ATOMIC_RELAXED, __HIP_MEMORY_SCOPE_AGENT
#define LDS_WAIT() asm volatile("s_waitcnt lgkmcnt(0)" ::: "memory")
#define VM_WAIT() asm volatile("s_waitcnt vmcnt(0)" ::: "memory")

#define XB_TMO      128
#define XB_XCNT(j)  (256  + 64 * (j))
#define XB_XSUB(j)  (1280 + 64 * (j))
#define XB_XGEN(j)  (2304 + 64 * (j))
#define XB_TOP      3328
#define XB_TOPGEN   3392
#define XCD_BAR_WORDS 3456
#define XB_SPIN_CAP (1u << 18)
__device__ __forceinline__ unsigned xb_ld(unsigned* p)              { return __hip_atomic_load(p, __ATOMIC_RELAXED, __HIP_MEMORY_SCOPE_AGENT); }
__device__ __forceinline__ unsigned xb_add(unsigned* p, unsigned v) { return __hip_atomic_fetch_add(p, v, __ATOMIC_RELAXED, __HIP_MEMORY_SCOPE_AGENT); }
__device__ __forceinline__ unsigned xb_xcc_id() { return (unsigned)__builtin_amdgcn_s_getreg((3 << 11) | 20) & 0xFu; }
#define XB_SPIN(cond, bar) do { unsigned _sp = 0; while (cond) { __builtin_amdgcn_s_sleep(1); \
    if ((++_sp & 255u) == 0u) { if (xb_ld(&(bar)[XB_TMO])) break; if (_sp > XB_SPIN_CAP) { atomicAdd(&(bar)[XB_TMO], 1u); break; } } } } while (0)
struct XcdBarrier { unsigned* bar; unsigned x; volatile LAS unsigned* st; };
__device__ __forceinline__ XcdBarrier xcd_barrier_post(unsigned* bar, volatile LAS unsigned* st) {
    XcdBarrier b; b.bar = bar; b.x = xb_xcc_id(); b.st = st;
    if (threadIdx.x == 0) (void)xb_add(&bar[XB_XCNT(b.x)], 1u);
    return b;
}
__device__ __forceinline__ void xcd_barrier_complete(unsigned* bar, unsigned x, unsigned& nloc, unsigned& nx) {
    const unsigned G = gridDim.x * gridDim.y * gridDim.z;
    unsigned sum, cnt, mine, sp = 0u;
    for (;;) {
        sum = 0u; cnt = 0u; mine = 0u;
#pragma unroll 1
        for (unsigned j = 0; j < 16; ++j) { const unsigned c = xb_ld(&bar[XB_XCNT(j)]); sum += c; cnt += (c > 0u) ? 1u : 0u; mine = (j == x) ? c : mine; }
        if (sum == G) break;
        __builtin_amdgcn_s_sleep(1);
        if ((++sp & 255u) == 0u) { if (xb_ld(&bar[XB_TMO])) break; if (sp > XB_SPIN_CAP) { atomicAdd(&bar[XB_TMO], 1u); break; } }
    }
    nloc = mine > 0u ? mine : 1u; nx = cnt > 0u ? cnt : 1u;
}
__device__ __forceinline__ void xcd_barrier(const XcdBarrier& b) {
    asm volatile("s_waitcnt vmcnt(0)" ::: "memory");
    __syncthreads();
    if (threadIdx.x == 0) {
        unsigned* bar = b.bar;
        __builtin_amdgcn_s_waitcnt(0);
        unsigned nloc = b.st[0], nx = b.st[1];
        if (nloc == 0u) { xcd_barrier_complete(bar, b.x, nloc, nx); b.st[0] = nloc; b.st[1] = nx; }
        const unsigned old = xb_add(&bar[XB_XSUB(b.x)], 1u);
        const unsigned gen = old / nloc;
        if (old + 1u == (gen + 1u) * nloc) {
            __builtin_amdgcn_fence(__ATOMIC_RELEASE, "agent");
            asm volatile("s_waitcnt vmcnt(0)" ::: "memory");
            const unsigned og = xb_add(&bar[XB_TOP], 1u);
            const unsigned tg = og / nx;
            if (og + 1u == (tg + 1u) * nx) xb_add(&bar[XB_TOPGEN], 1u);
            else XB_SPIN(xb_ld(&bar[XB_TOPGEN]) == tg, bar);
            __builtin_amdgcn_fence(__ATOMIC_ACQUIRE, "agent");
            xb_add(&bar[XB_XGEN(b.x)], 1u);
            asm volatile("s_waitcnt vmcnt(0)" ::: "memory");
        } else {
            XB_SPIN(xb_ld(&bar[XB_XGEN(b.x)]) == gen, bar);
            __builtin_amdgcn_fence(__ATOMIC_ACQUIRE, "agent");
            asm volatile("s_waitcnt vmcnt(0)" ::: "memory");
        }
    }
    __syncthreads();
}

struct Args {
    const float* in[15]; float* out; unsigned char* ws; int ph_lo, ph_hi, skip, pad;
};

struct Frame {
    LAS unsigned char* lds;
    int tid, lane, wave, vcu, G;
};

__device__ __forceinline__ void p0_transpose_item(const float* W, int K, int N, bf16* WT, LAS float* scr, int item, int lane) {
    const int nblk = N / 32, kb = item / nblk, nb = item % nblk, k0 = 64 * kb, n0 = 32 * nb;
    float tv[32];
#pragma unroll
    for (int i = 0; i < 32; ++i) { const int kk = 2 * i + (lane >> 5); tv[i] = W[(size_t)(k0 + kk) * N + n0 + (lane & 31)]; }
#pragma unroll
    for (int i = 0; i < 32; ++i) { const int kk = 2 * i + (lane >> 5); scr[kk * 33 + (lane & 31)] = tv[i]; }
    LDS_WAIT(); asm volatile("" ::: "memory");
    const int c = lane & 7;
#pragma unroll
    for (int j = 0; j < 4; ++j) { const int n = (lane >> 3) + 8 * j; const LAS float* s = scr + (8 * c) * 33 + n;
        u32x4 o; o.x = pk2(s[0 * 33], s[1 * 33]); o.y = pk2(s[2 * 33], s[3 * 33]); o.z = pk2(s[4 * 33], s[5 * 33]); o.w = pk2(s[6 * 33], s[7 * 33]);
        st_wt16(WT + (size_t)(n0 + n) * K + k0 + 8 * c, o); }
    LDS_WAIT(); asm volatile("" ::: "memory");
}

__device__ __forceinline__ void phase_mod(Frame& F, const __attribute__((address_space(4))) Args* ap, unsigned char* ws) {
    const float* c = ap->in[1]; const float* c_ctx = ap->in[3]; const float* w_mod = ap->in[5]; const float* b_mod = ap->in[6]; const float* qk_norm_g = ap->in[11]; const float* lam_vecs = ap->in[12];
    float* MODP = (float*)(ws + WS_MOD); float* SC = (float*)(ws + WS_SC);
    LAS float* red = (LAS float*)F.lds;
    LAS float* scl = (LAS float*)(F.lds + 8192);
    if ((int)blockIdx.x * 2 < DEPTH * 48 * 4) {
#pragma unroll
        for (int i = 0; i < 6; ++i) { const int idx = F.tid + 512 * i, v = idx >> 10, k = idx & 1023; scl[idx] = silu_f(v == 2 ? c_ctx[k] : c[v * 1024 + k]); }
    }
    __syncthreads();
    const int half = F.wave >> 2, w4 = F.wave & 3;
    for (int t0 = blockIdx.x * 2; t0 < DEPTH * 48 * 4; t0 += 2 * F.G) {
        const int task = t0 + half;
        const int kq = task & 3, lc = task >> 2, l = lc / 48, chunk = lc % 48, j = chunk * 64 + F.lane;
        const float* W = w_mod + (size_t)l * 1024 * 3072 + j;
        float a0 = 0.f, a1 = 0.f, a2 = 0.f;
        const int k0 = kq * 256 + w4 * 64;
        float wv[64];
#pragma unroll
        for (int i = 0; i < 64; ++i) wv[i] = W[(size_t)(k0 + i) * 3072];
#pragma unroll
        for (int i = 0; i < 64; i += 4) {
            const f32x4 s0 = *(const LAS f32x4*)(scl + k0 + i), s1 = *(const LAS f32x4*)(scl + 1024 + k0 + i), s2 = *(const LAS f32x4*)(scl + 2048 + k0 + i);
            a0 += s0.x * wv[i] + s0.y * wv[i + 1] + s0.z * wv[i + 2] + s0.w * wv[i + 3];
            a1 += s1.x * wv[i] + s1.y * wv[i + 1] + s1.z * wv[i + 2] + s1.w * wv[i + 3];
            a2 += s2.x * wv[i] + s2.y * wv[i + 1] + s2.z * wv[i + 2] + s2.w * wv[i + 3]; }
        __syncthreads();
        red[(F.wave * 3 + 0) * 64 + F.lane] = a0; red[(F.wave * 3 + 1) * 64 + F.lane] = a1; red[(F.wave * 3 + 2) * 64 + F.lane] = a2;
        __syncthreads();
        { const int t = F.tid & 255;
          if (t < 192) { const int v = t >> 6, ln = t & 63; float s = 0.f;
#pragma unroll
            for (int w = 0; w < 4; ++w) s += red[((half * 4 + w) * 3 + v) * 64 + ln];
            const int jj = chunk * 64 + ln;
            __hip_atomic_store(MODP + kq * MODQ + (l * 3 + v) * 3072 + jj, s + (kq == 0 ? b_mod[l * 3072 + jj] : 0.f), __ATOMIC_RELAXED, __HIP_MEMORY_SCOPE_AGENT); } }
        asm volatile("s_waitcnt vmcnt(0)" ::: "memory");
        __syncthreads();
        if (F.tid == 0) (void)__hip_atomic_fetch_add((gu32*)(ws + WS_CTL) + SEAM_MODCNT, 2u, __ATOMIC_RELAXED, __HIP_MEMORY_SCOPE_AGENT);
    }
    __syncthreads();
    if (blockIdx.x == 0 && F.wave < DEPTH) {
        int l = F.wave; asm volatile("" : "+s"(l)); const int lane = F.lane; const float* lv = lam_vecs + l * 256;
        const float sa = wave_sum(lv[lane] * lv[64 + lane]), sb = wave_sum(lv[128 + lane] * lv[192 + lane]);
        const float lam_init = l == 0 ? 0.2f : 0.8f - 0.6f * 0.7408182206817179f;
        float gq = fabsf(qk_norm_g[l * 128 + lane]), gk = fabsf(qk_norm_g[l * 128 + 64 + lane]);
        gq = wave_max(gq); gk = wave_max(gk);
        if (lane == 0) { SC[l * 4 + 0] = expf(sa) - expf(sb) + lam_init; SC[l * 4 + 1] = 8.f * gq * gk; SC[l * 4 + 2] = lam_init; }
    }
}
__device__ __forceinline__ void phase_prep(Frame& F, const __attribute__((address_space(4))) Args* ap, unsigned char* ws) {
    const float* w_in = ap->in[7]; const float* w_fourier = ap->in[8]; const float* w_pool = ap->in[9]; const float* w_out = ap->in[14];
    float* ROPE = (float*)(ws + WS_ROPE); float* TW = (float*)(ws + WS_TW);
    bf16* WF = (bf16*)(ws + WS_WF); bf16* WP = (bf16*)(ws + WS_WP); bf16* WIN = (bf16*)(ws + WS_WIN); bf16* WOUT = (bf16*)(ws + WS_WOUT);
    {
        LAS float* scr = (LAS float*)(F.lds + F.wave * 12288);
        const int gw = F.vcu * NWAVES + F.wave, NGW = F.G * NWAVES;
        constexpr int I_IN = (D / 64) * (IN_W / 32), I_OUT = (D / 64) * (D / 32);
        constexpr int NITEMS = DEPTH * (I_IN + I_OUT);
        for (int it = gw; it < NITEMS; it += NGW) {
            int r = it;
            if (r < DEPTH * I_IN) { const int l = r / I_IN; p0_transpose_item(w_in + (size_t)l * D * IN_W, D, IN_W, WIN + (size_t)l * IN_W * D, scr, r % I_IN, F.lane); continue; }
            r -= DEPTH * I_IN;
            { const int l = r / I_OUT; p0_transpose_item(w_out + (size_t)l * D * D, D, D, WOUT + (size_t)l * D * D, scr, r % I_OUT, F.lane); }
        }
    }
    {
        const int gt = blockIdx.x * 512 + F.tid, NGT = F.G * 512;
        LAS float* cst = (LAS float*)(F.lds + 98304);
        __syncthreads();
        if (F.tid < 64) { float sv, cv; sincospif((float)F.tid / 32.f, &sv, &cv); cst[2 * F.tid] = cv; cst[2 * F.tid + 1] = sv; }
        __syncthreads();
        for (int i = gt; i < DEPTH * 4 * 64 * 128; i += NGT) {
            const int k = i & 127, n = (i >> 7) & 63, lg = i >> 13; const int cc = k >> 1; const int sn = k & 1;
            const float* wf = w_fourier + (size_t)lg * 64 * 64 + n;
            float s = 0.f;
#pragma unroll 16
            for (int m = 0; m < 64; ++m) s += cst[2 * ((cc * m) & 63) + sn] * wf[m * 64];
            WF[i] = (bf16)f2bf(s);
        }
        for (int i = gt; i < DEPTH * 4 * 64 * 64; i += NGT) { const int k = i & 63, n = (i >> 6) & 63, lg = i >> 12; WP[i] = (bf16)f2bf(w_pool[(size_t)lg * 4096 + k * 64 + n]); }
        for (int i = gt; i < 128 * 16; i += NGT) { const int pos = i >> 4, j = i & 15; const float inv = powf(10000.f, -(float)j / 16.f), ang = (float)pos * inv; __hip_atomic_store((unsigned long long*)(ROPE + 2 * i), (unsigned long long)__builtin_bit_cast(unsigned, cosf(ang)) | ((unsigned long long)__builtin_bit_cast(unsigned, sinf(ang)) << 32), __ATOMIC_RELAXED, __HIP_MEMORY_SCOPE_AGENT); }
        for (int i = gt; i < 8191; i += NGT) { const int half = 1 << (31 - __clz(i + 1)), pos = i + 1 - half; float sv, cv; sincospif(-(float)pos / (float)half, &sv, &cv); TW[2 * i] = cv; TW[2 * i + 1] = sv; }
    }
}

template <int NR, bool WT>
__device__ __forceinline__ void nm_rows(const float* x0, bf16* h0, const float* ng, const float* md, int lane) {
    f32x4 v[NR][4];
#pragma unroll
    for (int q = 0; q < NR; ++q) { const float* xr = x0 + (size_t)q * D + 4 * lane;
#pragma unroll
        for (int j = 0; j < 4; ++j) v[q][j] = *(const f32x4*)(xr + 256 * j); }
    f32x4 a[4], c[4];
#pragma unroll
    for (int j = 0; j < 4; ++j) { const int k = 4 * lane + 256 * j; a[j] = *(const f32x4*)(ng + k) * (mod4(md + 1024 + k) + 1.f); c[j] = mod4(md + k); }
    asm volatile("" ::: "memory");
#pragma unroll
    for (int q = 0; q < NR; ++q) {
        float s = 0.f;
#pragma unroll
        for (int j = 0; j < 4; ++j) s += (v[q][j].x * v[q][j].x + v[q][j].y * v[q][j].y) + (v[q][j].z * v[q][j].z + v[q][j].w * v[q][j].w);
        const float rstd = 1.0f / sqrtf(wave_sum(s) * (1.f / D) + EPS);
        unsigned long long* o8 = (unsigned long long*)(h0 + (size_t)q * D) + lane;
#pragma unroll
        for (int j = 0; j < 4; ++j) { const f32x4 y = v[q][j] * rstd * a[j] + c[j];
            const unsigned long long w = (unsigned long long)pk2(y.x, y.y) | ((unsigned long long)pk2(y.z, y.w) << 32);
            if (WT) __hip_atomic_store(o8 + 64 * j, w, __ATOMIC_RELAXED, __HIP_MEMORY_SCOPE_AGENT); else o8[64 * j] = w; } }
}
template <bool SEAM>
__device__ __forceinline__ void phase_normmod(Frame& F, const float* xin, const float* cin, const float* ng, const float* mod, bf16* H, gu32* ctl) {
    const int gw = F.vcu * NWAVES + F.wave, NGW = F.G * NWAVES;
    for (int blk = gw; blk < M / 8; blk += NGW) {
        const int r0 = blk * 8;
        nm_rows<8, SEAM>(xin + (size_t)r0 * D, H + (size_t)r0 * D, ng, mod + (r0 / L) * 3072, F.lane);
        if (SEAM) { asm volatile("s_waitcnt vmcnt(0)" ::: "memory"); if (F.lane == 0) (void)__hip_atomic_fetch_add(ctl + SEAM_HCNT(r0 >> 8), 1u, __ATOMIC_RELAXED, __HIP_MEMORY_SCOPE_AGENT); }
    }
    for (int r = M + gw; r < MT; r += NGW) {
        nm_rows<1, SEAM>(cin + (size_t)(r - M) * D, H + (size_t)r * D, ng, mod + 2 * 3072, F.lane);
        if (SEAM) { asm volatile("s_waitcnt vmcnt(0)" ::: "memory"); if (F.lane == 0) (void)__hip_atomic_fetch_add(ctl + SEAM_CCNT, 1u, __ATOMIC_RELAXED, __HIP_MEMORY_SCOPE_AGENT); }
    }
}
__device__ __forceinline__ void seam_wait_ge(gu32* cnt, unsigned want);
__device__ __forceinline__ void phase_normmod_jobs(Frame& F, volatile LAS unsigned* MISC, const float* x1, const float* c1, const float* ng, const float* mod, bf16* H, gu32* ctl_seam, gu32* ctlbase) {
#pragma unroll 1
    for (;;) {
        if (F.tid == 0) MISC[46] = __hip_atomic_fetch_add(ctlbase + SEAM_NQ, 1u, __ATOMIC_RELAXED, __HIP_MEMORY_SCOPE_AGENT);
        __syncthreads();
        const int j = __builtin_amdgcn_readfirstlane((int)MISC[46]);
        __syncthreads();
        if (j >= 256 + 8) break;
        if (F.tid == 0) { if (j < 256) seam_wait_ge(ctlbase + SEAM_XCNT(j >> 2), 4u); else seam_wait_ge(ctlbase + SEAM_CXCNT, 256u); }
        asm volatile("" ::: "memory");
        __syncthreads();
        const bool lat = j < 256; const int r0 = 64 * (lat ? j : j - 256) + 8 * F.wave;
        const float* xs = (lat ? x1 : c1) + (size_t)r0 * D; bf16* hs = H + (size_t)(lat ? r0 : M + r0) * D;
        const float* md = mod + (lat ? r0 / L : 2) * 3072; gu32* cnt = ctl_seam + (lat ? SEAM_HCNT(r0 >> 8) : SEAM_CCNT);
        nm_rows<8, true>(xs, hs, ng, md, F.lane);
        asm volatile("s_waitcnt vmcnt(0)" ::: "memory"); if (F.lane == 0) (void)__hip_atomic_fetch_add(cnt, lat ? 1u : 8u, __ATOMIC_RELAXED, __HIP_MEMORY_SCOPE_AGENT);
    }
}
__device__ __forceinline__ void seam_wait_ge(gu32* cnt, unsigned want) { unsigned sp = 0; while (__hip_atomic_load(cnt, __ATOMIC_RELAXED, __HIP_MEMORY_SCOPE_AGENT) < want) { __builtin_amdgcn_s_sleep(8); if (++sp > (1u << 20)) break; } }

__device__ __forceinline__ void phase_qkprep(Frame& F, bf16* PB, const float* qkg, const float* ROPE, int nrows) {
    const int gw = F.vcu * NWAVES + F.wave, NGW = F.G * NWAVES;
    const int g8 = F.lane & 7;
    for (int r = gw; r < nrows; r += NGW) {
        const bool isc = r >= M; const int t = r & (L - 1), pr = t >> 6, pc = t & 63;
#pragma unroll
        for (int part = 0; part < 2; ++part) {
            bf16* p = PB + (size_t)r * IN_W + (part ? K_OFF : Q_OFF) + F.lane * 8;
            const u32x4 w = *(const u32x4*)p;
            float x[8] = {bflo(w.x), bfhi(w.x), bflo(w.y), bfhi(w.y), bflo(w.z), bfhi(w.z), bflo(w.w), bfhi(w.w)};
            float ss = 0.f;
#pragma unroll
            for (int e = 0; e < 8; ++e) ss += x[e] * x[e];
            ss += sxor<1>(ss); ss += sxor<2>(ss); ss += sxor<4>(ss);
            const float rs = 1.0f / sqrtf(ss * (1.f / 64.f) + EPS);
            const f32x4 ga = *(const f32x4*)(qkg + part * 64 + g8 * 8), gb = *(const f32x4*)(qkg + part * 64 + g8 * 8 + 4);
            const float gg[8] = {ga.x, ga.y, ga.z, ga.w, gb.x, gb.y, gb.z, gb.w};
            float y[8];
#pragma unroll
            for (int e = 0; e < 8; ++e) y[e] = x[e] * rs * gg[e];
            if (!isc) {
                const int ax = g8 >> 2, ph = (g8 >> 1) & 1, jb = 8 * (g8 & 1);
                const float* rp = ROPE + ((ax ? pc : pr) * 16 + jb) * 2;
                const f32x4 c0 = *(const f32x4*)(rp), c1 = *(const f32x4*)(rp + 4), c2 = *(const f32x4*)(rp + 8), c3 = *(const f32x4*)(rp + 12);
                const float cs[8] = {c0.x, c0.z, c1.x, c1.z, c2.x, c2.z, c3.x, c3.z}, sn[8] = {c0.y, c0.w, c1.y, c1.w, c2.y, c2.w, c3.y, c3.w};
#pragma unroll
                for (int e = 0; e < 8; ++e) { const float other = sxor<2>(y[e]); y[e] = ph ? (y[e] * cs[e] + other * sn[e]) : (y[e] * cs[e] - other * sn[e]); }
            }
            if (part == 0) {
#pragma unroll
                for (int e = 0; e < 8; ++e) y[e] *= 0.125f * LOG2E;
            }
            u32x4 o; o.x = pk2(y[0], y[1]); o.y = pk2(y[2], y[3]); o.z = pk2(y[4], y[5]); o.w = pk2(y[6], y[7]);
            *(u32x4*)p = o;
        }
    }
}

#define FSW(j) ((j) ^ (((j) >> 7) & 31))
__device__ __forceinline__ void fft13_item(Frame& F, const unsigned* at, u32x2* ut, const float* TW) {
    int tid = F.tid; asm volatile("" : "+v"(tid));
    typedef float f32x2v __attribute__((ext_vector_type(2)));
    LAS f32x2v* z = (LAS f32x2v*)F.lds;
    unsigned v[16]; f32x2v wp[3][2], wf[4];
#pragma unroll
    for (int k = 0; k < 16; ++k) v[k] = at[tid + 512 * k];
#pragma unroll
    for (int pi = 0; pi < 3; ++pi) { const int h = 8 << (3 * pi);
#pragma unroll
        for (int q = 0; q < 2; ++q) wp[pi][q] = *(const f32x2v*)(TW + 2 * (4 * h - 1 + ((tid + 512 * q) & (h - 1)))); }
    asm volatile("" ::: "memory");
#define BF1(p, r)  do { const f32x2v t_ = x[r]; x[r] = x[p] - t_; x[p] = x[p] + t_; } while (0)
#define BFMI(p, r) do { const f32x2v t_ = {x[r].y, -x[r].x}; x[r] = x[p] - t_; x[p] = x[p] + t_; } while (0)
#define BFW1(p, r) do { const f32x2v t_ = {(x[r].x + x[r].y) * 0.70710678118654752f, (x[r].y - x[r].x) * 0.70710678118654752f}; x[r] = x[p] - t_; x[p] = x[p] + t_; } while (0)
#define BFW3(p, r) do { const f32x2v t_ = {(x[r].y - x[r].x) * 0.70710678118654752f, -(x[r].x + x[r].y) * 0.70710678118654752f}; x[r] = x[p] - t_; x[p] = x[p] + t_; } while (0)
#define CMUL(w, b) ((f32x2v){(w).x * (b).x - (w).y * (b).y, (w).x * (b).y + (w).y * (b).x})
#define BFLY(p, r, w) do { const f32x2v t_ = CMUL(w, x[r]); x[r] = x[p] - t_; x[p] = x[p] + t_; } while (0)
#pragma unroll
    for (int g = 0; g < 2; ++g) {
        f32x2v x[8];
#pragma unroll
        for (int j = 0; j < 8; ++j) { const int q = ((j & 1) << 2) | (j & 2) | (j >> 2); x[j] = (f32x2v){bflo(v[2 * q + g]), bfhi(v[2 * q + g])}; }
        BF1(0, 1); BF1(2, 3); BF1(4, 5); BF1(6, 7);
        BF1(0, 2); BF1(4, 6); BFMI(1, 3); BFMI(5, 7);
        BF1(0, 4); BFW1(1, 5); BFMI(2, 6); BFW3(3, 7);
        const int m8 = (int)(__brev((unsigned)(tid + 512 * g)) >> 22) << 3;
#pragma unroll
        for (int j = 0; j < 8; ++j) z[FSW(m8 + j)] = x[j];
    }
    __syncthreads();
#pragma unroll
    for (int pi = 0; pi < 3; ++pi) {
        const int s = 4 + 3 * pi, h = 1 << (s - 1);
        if (pi == 2) {
#pragma unroll
            for (int q = 0; q < 4; ++q) wf[q] = *(const f32x2v*)(TW + 2 * (4095 + tid + 512 * q)); }
#pragma unroll
        for (int q = 0; q < 2; ++q) { const int t = tid + 512 * q;
            const int pos = t & (h - 1), base = ((t >> (s - 1)) << (s + 2)) + pos;
            const f32x2v w3 = wp[pi][q];
            const f32x2v w2 = {w3.x * w3.x - w3.y * w3.y, (w3.x + w3.x) * w3.y};
            const f32x2v w1 = {w2.x * w2.x - w2.y * w2.y, (w2.x + w2.x) * w2.y};
            int e[8]; f32x2v x[8];
#pragma unroll
            for (int j = 0; j < 8; ++j) { e[j] = FSW(base + j * h); x[j] = z[e[j]]; }
            BFLY(0, 1, w1); BFLY(2, 3, w1); BFLY(4, 5, w1); BFLY(6, 7, w1);
            const f32x2v w2b = {w2.y, -w2.x};
            BFLY(0, 2, w2); BFLY(4, 6, w2); BFLY(1, 3, w2b); BFLY(5, 7, w2b);
            const float r2 = 0.70710678118654752f;
            const f32x2v w3a = {(w3.x + w3.y) * r2, (w3.y - w3.x) * r2}, w3b = {w3.y, -w3.x}, w3c = {(w3.y - w3.x) * r2, -(w3.x + w3.y) * r2};
            BFLY(0, 4, w3); BFLY(1, 5, w3a); BFLY(2, 6, w3b); BFLY(3, 7, w3c);
#pragma unroll
            for (int j = 0; j < 8; ++j) z[e[j]] = x[j]; }
        __syncthreads();
    }
#undef BF1
#undef BFMI
#undef BFW1
#undef BFW3
#undef BFLY
    const float sc = 0.5f / sqrtf(8192.f * 64.f);
#define UNPK(kk, za, zb) do { const float ar = ((za).x + (zb).x) * sc, ai = ((za).y - (zb).y) * sc, br = ((za).y + (zb).y) * sc, bi = ((zb).x - (za).x) * sc; \
        __hip_atomic_store((unsigned long long*)(ut + (kk)), (unsigned long long)pk2(ar, ai) | ((unsigned long long)pk2(br, bi) << 32), __ATOMIC_RELAXED, __HIP_MEMORY_SCOPE_AGENT); } while (0)
#pragma unroll
    for (int q = 0; q < 4; ++q) { const int p = tid + 512 * q;
        const int x2 = (4096 - p) & 4095;
        const f32x2v wv = wf[q];
        const f32x2v a1 = z[FSW(p)], b1 = z[FSW(p + 4096)], a2 = z[FSW(x2)], b2 = z[FSW(x2 + 4096)];
        const f32x2v t1 = CMUL(wv, b1);
        const f32x2v w2 = {-wv.x, wv.y};
        const f32x2v t2 = CMUL(w2, b2);
        const f32x2v ZA = a1 + t1, ZB = a1 - t1;
        if (p == 0) { UNPK(0, ZA, ZA); UNPK(4096, ZB, ZB); }
        else {
            const f32x2v ZC = a2 + t2, ZD = a2 - t2;
            UNPK(p, ZA, ZD); UNPK(p + 4096, ZB, ZC); UNPK(x2, ZC, ZB); UNPK(x2 + 4096, ZD, ZA);
        }
    }
    if (tid == 0) {
        const f32x2v a1 = z[FSW(2048)], b1 = z[FSW(6144)];
        const f32x2v t1 = {b1.y, -b1.x};
        const f32x2v ZA = a1 + t1, ZB = a1 - t1;
        UNPK(2048, ZA, ZB); UNPK(6144, ZB, ZA);
    }
#undef UNPK
#undef CMUL
    asm volatile("s_waitcnt vmcnt(0)" ::: "memory");
    __syncthreads();
}

__device__ __forceinline__ void fft_item(Frame& F, const unsigned* at, int logn, u32x2* ut, const float* TW) {
    const int n = 1 << logn, tid = F.tid;
    typedef float f32x2v __attribute__((ext_vector_type(2)));
    LAS f32x2v* z = (LAS f32x2v*)F.lds; LAS float* tw = (LAS float*)(z + 8192);
    for (int i = tid; i < n - 1; i += 512) { const float2 w = *(const float2*)(TW + 2 * i); tw[2 * i] = w.x; tw[2 * i + 1] = w.y; }
    for (int i = tid; i < n; i += 512) { const unsigned v = at[i]; const int j = FSW((int)(__brev((unsigned)i) >> (32 - logn))); z[j] = (f32x2v){bflo(v), bfhi(v)}; }
    __syncthreads();
    int s = 1;
    if (logn & 1) {
        for (int t = tid; t < n / 2; t += 512) { const int i0 = FSW(2 * t), i1 = FSW(2 * t + 1); const f32x2v u_ = z[i0], x_ = z[i1]; z[i0] = u_ + x_; z[i1] = u_ - x_; }
        __syncthreads(); s = 2;
    }
    for (; s <= logn; s += 2) {
        const int h = 1 << (s - 1);
        for (int t = tid; t < n / 4; t += 512) {
            const int pos = t & (h - 1), base = ((t >> (s - 1)) << (s + 1)) + pos;
            const float c1 = tw[2 * (h - 1 + pos)], s1 = tw[2 * (h - 1 + pos) + 1];
            const float c2 = tw[2 * (2 * h - 1 + pos)], s2 = tw[2 * (2 * h - 1 + pos) + 1];
            const int e0 = FSW(base), e1 = FSW(base + h), e2 = FSW(base + 2 * h), e3 = FSW(base + 3 * h);
            const f32x2v z0 = z[e0], z1 = z[e1], z2 = z[e2], z3 = z[e3];
            const float a0r = z0.x, a0i = z0.y, a1r = z1.x, a1i = z1.y, a2r = z2.x, a2i = z2.y, a3r = z3.x, a3i = z3.y;
            const float t1r = a1r * c1 - a1i * s1, t1i = a1r * s1 + a1i * c1, t3r = a3r * c1 - a3i * s1, t3i = a3r * s1 + a3i * c1;
            const float b0r = a0r + t1r, b0i = a0i + t1i, b1r = a0r - t1r, b1i = a0i - t1i, b2r = a2r + t3r, b2i = a2i + t3i, b3r = a2r - t3r, b3i = a2i - t3i;
            const float u2r = b2r * c2 - b2i * s2, u2i = b2r * s2 + b2i * c2;
            const float w3r = b3r * c2 - b3i * s2, w3i = b3r * s2 + b3i * c2;
            z[e0] = (f32x2v){b0r + u2r, b0i + u2i}; z[e2] = (f32x2v){b0r - u2r, b0i - u2i};
            z[e1] = (f32x2v){b1r + w3i, b1i - w3r}; z[e3] = (f32x2v){b1r - w3i, b1i + w3r};
        }
        __syncthreads();
    }
    const float sc = 0.5f / sqrtf((float)n * 64.f);
    for (int k = tid; k < n; k += 512) {
        const int k2 = (n - k) & (n - 1);
        const f32x2v za = z[FSW(k)], zb = z[FSW(k2)]; const float zr = za.x, zi = za.y, wr_ = zb.x, wi_ = zb.y;
        const float ar = (zr + wr_) * sc, ai = (zi - wi_) * sc, br = (zi + wi_) * sc, bi = (wr_ - zr) * sc;
        __hip_atomic_store((unsigned long long*)(ut + k), (unsigned long long)pk2(ar, ai) | ((unsigned long long)pk2(br, bi) << 32), __ATOMIC_RELAXED, __HIP_MEMORY_SCOPE_AGENT);
    }
    asm volatile("s_waitcnt vmcnt(0)" ::: "memory");
    __syncthreads();
}

template <int KG>
__device__ __forceinline__ void group_linear(const LAS bf16* At, int lda, const bf16* W, int g, int rh, int lane, f32x16& acc0, f32x16& acc1) {
    const int r32 = lane & 31, hi = lane >> 5;
    acc0 = f32x16{}; acc1 = f32x16{};
    const LAS bf16* ap = At + (rh * 32 + r32) * lda + g * KG + hi * 8;
    const bf16* wp = W + (size_t)g * 64 * KG + (size_t)r32 * KG + hi * 8;
#pragma unroll
    for (int ks = 0; ks < KG / 16; ++ks) {
        const bf16x8 af = *(const LAS bf16x8*)(ap + ks * 16);
        const bf16x8 b0 = *(const bf16x8*)(wp + ks * 16), b1 = *(const bf16x8*)(wp + 32 * KG + ks * 16);
        acc0 = __builtin_amdgcn_mfma_f32_32x32x16_bf16(af, b0, acc0, 0, 0, 0);
        acc1 = __builtin_amdgcn_mfma_f32_32x32x16_bf16(af, b1, acc1, 0, 0, 0);
    }
}

__device__ __forceinline__ void gated_store_tile(LAS float* X, const f32x16& a0, const f32x16& a1, const bf16* gate, int gstride, bf16* yout, const float* sc, int lane) {
    const int r32 = lane & 31, hi = lane >> 5, ch = lane & 7, rl = lane >> 3;
    u32x4 gt[4];
#pragma unroll
    for (int i = 0; i < 4; ++i) gt[i] = *(const u32x4*)(gate + (size_t)(rl + 8 * i) * gstride + ch * 8);
#pragma unroll
    for (int r = 0; r < 16; ++r) { const int row = att::crow(r, hi); X[row * 64 + r32] = a0[r]; X[row * 64 + 32 + r32] = a1[r]; }
    f32x4 sa = {1.f, 1.f, 1.f, 1.f}, sb = {1.f, 1.f, 1.f, 1.f};
    if (sc) { sa = *(const f32x4*)(sc + ch * 8); sb = *(const f32x4*)(sc + ch * 8 + 4); }
#pragma unroll
    for (int i = 0; i < 4; ++i) {
        const LAS float* xp = X + (rl + 8 * i) * 64 + ch * 8;
        const f32x4 xa = *(const LAS f32x4*)xp * sa, xb = *(const LAS f32x4*)(xp + 4) * sb;
        const u32x4 gq = gt[i];
        u32x4 w;
        w.x = pk2(xa[0] * silu_f(bflo(gq.x)), xa[1] * silu_f(bfhi(gq.x))); w.y = pk2(xa[2] * silu_f(bflo(gq.y)), xa[3] * silu_f(bfhi(gq.y)));
        w.z = pk2(xb[0] * silu_f(bflo(gq.z)), xb[1] * silu_f(bfhi(gq.z))); w.w = pk2(xb[2] * silu_f(bflo(gq.w)), xb[3] * silu_f(bfhi(gq.w)));
        st_wt16(yout + (size_t)(rl + 8 * i) * 1024 + ch * 8, w);
    }
}

template <int W>
__device__ __forceinline__ void pool_strip(const LAS unsigned* B2, LAS bf16* Ao, int tb, int Lr) {
    constexpr int LO = W / 2, HI = W - LO - 1, K0 = 8 - LO, NV = 16 + W - 1;
    unsigned v[NV];
#pragma unroll
    for (int k = 0; k < NV; ++k) v[k] = B2[(K0 + k) * 128];
    float s0 = 0.f, s1 = 0.f;
#pragma unroll
    for (int k = 0; k < W; ++k) { s0 += bflo(v[k]); s1 += bfhi(v[k]); }
#pragma unroll
    for (int i = 0; i < 16; ++i) { const int t = tb + i;
        const int a = max(t - LO, 0), e = min(t + HI, Lr - 1);
        const unsigned c = v[LO + i];
        const float inv = __builtin_amdgcn_rcpf((float)(e - a + 1));
        *(LAS unsigned*)(Ao + i * 264) = pk2(s0 * inv - bflo(c), s1 * inv - bfhi(c));
        if (i < 15) { s0 += bflo(v[i + W]) - bflo(v[i]); s1 += bfhi(v[i + W]) - bfhi(v[i]); } }
}
__device__ __forceinline__ unsigned pool_item(Frame& F, const bf16* PB, bf16* Y, int rb, int Lr, int t0, const bf16* WPl, const float* pscale, gu32* tkq, gu32* pub) {
    LAS bf16* Braw = (LAS bf16*)F.lds;
    LAS bf16* At = (LAS bf16*)(F.lds + 40960);
    const int tid = F.tid;
    for (int i = tid; i < 80 * 32; i += 512) { const int rr = i >> 5, ch = i & 31; const int t = t0 - 8 + rr;
        u32x4 v = {0u, 0u, 0u, 0u}; if (t >= 0 && t < Lr) v = *(const u32x4*)(PB + (size_t)(rb + t) * IN_W + B_OFF + ch * 8);
        *(LAS u32x4*)(Braw + rr * 256 + ch * 8) = v; }
    asm volatile("s_waitcnt vmcnt(0)" ::: "memory");
    __syncthreads();
    if (pub && F.tid == 0) (void)__hip_atomic_fetch_add(pub, 1u, __ATOMIC_RELAXED, __HIP_MEMORY_SCOPE_AGENT);
    {
      const int cp = (F.wave >> 1) * 32 + (F.lane & 31), rq = (F.wave & 1) * 2 + (F.lane >> 5), col = 2 * cp;
      const LAS unsigned* B2 = (const LAS unsigned*)Braw + cp + (rq * 16) * 128;
      LAS bf16* Ao = At + (rq * 16) * 264 + col;
      const int tb = t0 + rq * 16;
      switch (F.wave >> 1) {
        case 0: pool_strip<2>(B2, Ao, tb, Lr); break;
        case 1: pool_strip<4>(B2, Ao, tb, Lr); break;
        case 2: pool_strip<8>(B2, Ao, tb, Lr); break;
        default: pool_strip<16>(B2, Ao, tb, Lr); break;
      } }
    __syncthreads();
    const int g = F.wave >> 1, rh = F.wave & 1, r32 = F.lane & 31, hi = F.lane >> 5;
    f32x16 a0, a1; group_linear<64>(At, 264, WPl, g, rh, F.lane, a0, a1);
    (void)r32; (void)hi;
    __syncthreads();
    unsigned nxt_ = 0u; if (F.tid == 0) nxt_ = __hip_atomic_fetch_add(tkq, 1u, __ATOMIC_RELAXED, __HIP_MEMORY_SCOPE_AGENT);
    { const size_t r0 = (size_t)(rb + t0 + rh * 32);
      gated_store_tile((LAS float*)F.lds + F.wave * 2048, a0, a1, PB + r0 * IN_W + G_OFF + 256 + g * 64, IN_W, Y + r0 * 1024 + 256 + g * 64, pscale + g * 64, F.lane); }
    __syncthreads();
    return nxt_;
}

__device__ __forceinline__ unsigned flin_item(Frame& F, const bf16* PB, const bf16* U, bf16* Y, int row0, const bf16* WFl, gu32* tkq, gu32* pub) {
    LAS bf16* At = (LAS bf16*)F.lds;
    const int tid = F.tid;
    {
      const bool cxs = row0 >= M; const int rr0 = cxs ? row0 - M : row0;
      const int bseg = cxs ? (rr0 >> 8) : (rr0 >> 13), k0 = cxs ? (rr0 & 255) : (rr0 & (L - 1)), nseg = cxs ? CL : L;
      const int p = tid >> 2, q = tid & 3;
      const u32x2* up = (const u32x2*)U + (cxs ? AT_CTX : 0) + ((size_t)(bseg * 128 + p)) * nseg + k0 + q * 16;
      u32x4 v[8];
#pragma unroll
      for (int i = 0; i < 8; ++i) v[i] = *(const u32x4*)(up + 2 * i);
#pragma unroll
      for (int i = 0; i < 8; ++i) { *(LAS u32x2*)(At + (q * 16 + 2 * i) * 520 + p * 4) = (u32x2){v[i].x, v[i].y}; *(LAS u32x2*)(At + (q * 16 + 2 * i + 1) * 520 + p * 4) = (u32x2){v[i].z, v[i].w}; } }
    asm volatile("s_waitcnt vmcnt(0)" ::: "memory");
    __syncthreads();
    if (pub && F.tid == 0) (void)__hip_atomic_fetch_add(pub, 1u, __ATOMIC_RELAXED, __HIP_MEMORY_SCOPE_AGENT);
    const int g = F.wave >> 1, rh = F.wave & 1, r32 = F.lane & 31, hi = F.lane >> 5;
    f32x16 a0, a1; group_linear<128>(At, 520, WFl, g, rh, F.lane, a0, a1);
    (void)r32; (void)hi;
    __syncthreads();
    unsigned nxt_ = 0u; if (F.tid == 0) nxt_ = __hip_atomic_fetch_add(tkq, 1u, __ATOMIC_RELAXED, __HIP_MEMORY_SCOPE_AGENT);
    { const size_t r0 = (size_t)(row0 + rh * 32);
      gated_store_tile((LAS float*)F.lds + F.wave * 2048, a0, a1, PB + r0 * IN_W + G_OFF + g * 64, IN_W, Y + r0 * 1024 + g * 64, nullptr, F.lane); }
    __syncthreads();
    return nxt_;
}


__device__ __forceinline__ void ctx_load(Frame& F, const bf16* A, const bf16* Bt, int rb, int cg, bf16x8 (&a)[8], bf16x8 (&b0)[8], bf16x8 (&b1)[8]) {
    const int lane = F.lane, r32 = lane & 31, hi = lane >> 5, k0 = F.wave * 128;
    const bf16* ap = A + (size_t)(rb * 32 + r32) * D + k0 + hi * 8;
    const bf16* bp = Bt + (size_t)(cg * 64 + r32) * D + k0 + hi * 8;
#pragma unroll
    for (int ks = 0; ks < 8; ++ks) { a[ks] = *(const bf16x8*)(ap + ks * 16); b0[ks] = *(const bf16x8*)(bp + ks * 16); b1[ks] = *(const bf16x8*)(bp + 32 * D + ks * 16); }
}
__device__ __forceinline__ void ctx_mma(const bf16x8 (&a)[8], const bf16x8 (&b0)[8], const bf16x8 (&b1)[8], f32x16& c0, f32x16& c1) {
    c0 = f32x16{}; c1 = f32x16{};
#pragma unroll
    for (int ks = 0; ks < 8; ++ks) { c0 = __builtin_amdgcn_mfma_f32_32x32x16_bf16(a[ks], b0[ks], c0, 0, 0, 0); c1 = __builtin_amdgcn_mfma_f32_32x32x16_bf16(a[ks], b1[ks], c1, 0, 0, 0); }
}
template <int MODE>
__device__ __forceinline__ void ctx_tail(Frame& F, const f32x16& c0, const f32x16& c1, int rb, int cg, bf16* PBc, const float* qkg, const float* res, float* outp, const float* gate, unsigned char* KTp, unsigned char* VTp, unsigned* ATp);
template <int MODE>
__device__ __forceinline__ void ctx_tile(Frame& F, const bf16* A, const bf16* Bt, int rb, int cg, bf16* PBc, const float* qkg, const float* res, float* outp, const float* gate, unsigned char* KTp = nullptr, unsigned char* VTp = nullptr, unsigned* ATp = nullptr) {
    bf16x8 a[8], b0[8], b1[8];
    ctx_load(F, A, Bt, rb, cg, a, b0, b1);
    f32x16 c0, c1; ctx_mma(a, b0, b1, c0, c1);
    ctx_tail<MODE>(F, c0, c1, rb, cg, PBc, qkg, res, outp, gate, KTp, VTp, ATp);
}
template <int MODE>
__device__ __forceinline__ void ctx_tail(Frame& F, const f32x16& c0, const f32x16& c1, int rb, int cg, bf16* PBc, const float* qkg, const float* res, float* outp, const float* gate, unsigned char* KTp, unsigned char* VTp, unsigned* ATp) {
    const int lane = F.lane, r32 = lane & 31, hi = lane >> 5;
    LAS float* red = (LAS float*)F.lds + F.wave * 2048;
#pragma unroll
    for (int r = 0; r < 16; ++r) { const int row = att2::crow(r, hi); red[row * 64 + r32] = c0[r]; red[row * 64 + 32 + r32] = c1[r]; }
    __syncthreads();
    const int row = F.tid >> 4, c4 = (F.tid & 15) * 4;
    f32x4 v = {0.f, 0.f, 0.f, 0.f};
#pragma unroll
    for (int w = 0; w < 8; ++w) v += *(const LAS f32x4*)((LAS float*)F.lds + w * 2048 + row * 64 + c4);
    const int grow = rb * 32 + row;
    if (MODE == 0) {
        if (cg >= 8 && cg < 24) {
            const int part = cg >= 16 ? 1 : 0;
            float ss = (v[0] * v[0] + v[1] * v[1]) + (v[2] * v[2] + v[3] * v[3]);
            ss += dpp_f<0xB1>(ss); ss += dpp_f<0x4E>(ss); ss += dpp_f<0x141>(ss); ss += dpp_f<0x140>(ss);
            const float rs = __builtin_amdgcn_rsqf(ss * (1.f / 64.f) + EPS) * (part ? 1.f : 0.125f * LOG2E);
            const f32x4 g = *(const f32x4*)(qkg + part * 64 + c4);
            v = v * rs * g;
        }
        const u32x2 w2 = (u32x2){pk2(v[0], v[1]), pk2(v[2], v[3])};
        if (cg >= 16 && cg < 32) {
            const int bb = grow >> 8, kidx = grow & 255, g = (cg - 16) & 7, hh = g >> 1;
            const size_t blk = ((size_t)((bb * 4 + hh) * NTILE + (kidx >> 6))) * 16384; const int key = kidx & 63;
            if (cg < 24) *(u32x2*)(KTp + blk + (g & 1) * 8192 + (c4 >> 3) * 1024 + key * 16 + (c4 & 7) * 2) = w2;
            else { const int dv = (g & 1) * 64 + c4; *(u32x2*)(VTp + blk + (dv >> 5) * 4096 + key * 64 + (dv & 31) * 2) = w2; }
        } else if (cg < 4) {
            unsigned* ap = ATp + AT_CTX + ((size_t)((grow >> 8) * 128 + cg * 32 + (c4 >> 1))) * CL + (grow & 255);
            ap[0] = w2.x; ap[CL] = w2.y;
        } else *(u32x2*)(PBc + (size_t)grow * IN_W + cg * 64 + c4) = w2;
    } else {
        const size_t off = (size_t)grow * D + cg * 64 + c4;
        const f32x4 o4 = *(const f32x4*)(res + off) + mod4(gate + cg * 64 + c4) * v;
        st_wt16(outp + off, __builtin_bit_cast(u32x4, o4));
        asm volatile("s_waitcnt vmcnt(0)" ::: "memory");
    }
    __syncthreads();
}

__global__ void __launch_bounds__(NWAVES * 64, 2) mk_fwd(Args args) {
    extern __shared__ __attribute__((aligned(16))) unsigned char lds[];
    {
        LAS unsigned* z = (LAS unsigned*)((LAS unsigned char*)lds + LDSCTL_OFF);
        for (int u = threadIdx.x; u < (LDS_BYTES - LDSCTL_OFF) / 4; u += NWAVES * 64) z[u] = 0u;
    }
    __syncthreads();
    const int wave_id = __builtin_amdgcn_readfirstlane((int)threadIdx.x >> 6);
    volatile LAS unsigned* MISC = (volatile LAS unsigned*)((LAS unsigned char*)lds + MISC_OFF);
    const int lo = args.ph_lo, hi = args.ph_hi;
    XcdBarrier bar; bar.bar = (unsigned*)(args.ws + WS_CTL) + CW_BAR; bar.x = 0; bar.st = nullptr;
    if (hi - lo > 1) bar = xcd_barrier_post((unsigned*)(args.ws + WS_CTL) + CW_BAR, MISC + 8);

#pragma unroll 1
    for (int ph = lo; ph < hi; ++ph) {
        const int Gd = gridDim.x, vcu = (Gd % 8 == 0) ? ((int)blockIdx.x % 8) * (Gd / 8) + (int)blockIdx.x / 8 : (int)blockIdx.x;
#define MKFRAME(F) Frame F; { int ln_; asm volatile("v_mbcnt_lo_u32_b32 %0, -1, 0\n\tv_mbcnt_hi_u32_b32 %0, -1, %0" : "=v"(ln_)); F.lane = ln_; F.wave = wave_id; F.tid = wave_id * 64 + ln_; F.lds = (LAS unsigned char*)lds; { int g_ = Gd, v_ = vcu; asm volatile("" : "+s"(g_), "+s"(v_)); F.G = g_; F.vcu = v_; } }
        const __attribute__((address_space(4))) Args* ka = (const __attribute__((address_space(4))) Args*)__builtin_amdgcn_kernarg_segment_ptr(); asm volatile("" : "+s"(ka));
        unsigned char* ws = ka->ws; asm volatile("" : "+s"(ws));
        const int l = ph == 0 ? 0 : (ph - 1) / 5, kind = ph == 0 ? 0 : 1 + (ph - 1) % 5;
        const bool upd = l < DEPTH - 1;
        float* out = ka->out;
        const float* xin = l == 0 ? ka->in[0] : out;
        const float* cin = l == 0 ? ka->in[2] : (const float*)(ws + WS_CTX1);
        const float* mod = (const float*)(ws + WS_MOD) + l * 3 * 3072;
        bf16* PB = (bf16*)(ws + WS_PB); bf16* Y = (bf16*)(ws + WS_Y); bf16* U = (bf16*)(ws + WS_U);
        if (kind == 0) {
            MKFRAME(F);
            phase_mod(F, ka, ws);
            __syncthreads();
            phase_prep(F, ka, ws);
            asm volatile("s_waitcnt vmcnt(0)" ::: "memory");
            __syncthreads();
            if (F.tid == 0) (void)__hip_atomic_fetch_add((gu32*)(ws + WS_CTL) + SEAM_PREPCNT, 1u, __ATOMIC_RELAXED, __HIP_MEMORY_SCOPE_AGENT);
        } else if (kind == 1) {
            MKFRAME(F);
            if (l == 0) { if (F.tid == 0) seam_wait_ge((gu32*)(ws + WS_CTL) + SEAM_MODCNT, (unsigned)(DEPTH * 48 * 4)); asm volatile("" ::: "memory"); __syncthreads(); }
            if (l == 0) phase_normmod<true>(F, xin, cin, ka->in[4] + l * D, mod, (bf16*)(ws + WS_H), (gu32*)(ws + WS_CTL) + 16 * 65 * l);
            else phase_normmod_jobs(F, MISC, xin, cin, ka->in[4] + l * D, mod, (bf16*)(ws + WS_H), (gu32*)(ws + WS_CTL) + 16 * 65 * l, (gu32*)(ws + WS_CTL));
        } else if (kind == 2) {
            MKFRAME(F);
            pg8::Gemm g{(const bf16*)(ws + WS_H), (const bf16*)(ws + WS_WIN) + (size_t)l * IN_W * D, M, IN_W, D}; pg8::StaticOrder S; S.init(M, IN_W, F.G, (int)blockIdx.x);
            pg8::EpiIn E{PB, ka->in[11] + l * 128, (const float*)(ws + WS_ROPE), ws + WS_KT, ws + WS_VT, (unsigned*)(ws + WS_AT)};
            {
                if (l == 0 && F.tid == 0) seam_wait_ge((gu32*)(ws + WS_CTL) + SEAM_PREPCNT, (unsigned)F.G);
                if (l > 0 && F.tid == 0) seam_wait_ge((gu32*)(ws + WS_CTL) + SEAM_MIXDONE, (unsigned)F.G);
                { pg8::Unit u_; u_.pm = 0; u_.pn = 0;
#pragma unroll 1
                  for (int i = 0; S.next(i, u_); ++i) { gu32* f_ = (gu32*)(ws + WS_CTL) + 16 * 65 * l + SEAM_HCNT(u_.pm); if (F.tid == 0) seam_wait_ge(f_, 32u); } }
                asm volatile("" ::: "memory");
                __syncthreads();
            }
            pg8::gemm_phase<pg8::EpiIn, pg8::StaticOrder, true, true>(F.lds + RING_OFF, g, S, E, F.tid);
            { if (F.tid == 0) seam_wait_ge((gu32*)(ka->ws + WS_CTL) + 16 * 65 * l + SEAM_CCNT, (unsigned)(MT - M)); asm volatile("" ::: "memory"); __syncthreads(); }
            { const int ncg = upd ? 48 : 16, cg0 = upd ? 0 : 16;
              const bf16* Hc = (const bf16*)(ws + WS_H) + (size_t)M * D; const bf16* Wl = (const bf16*)(ws + WS_WIN) + (size_t)l * IN_W * D;
              if (F.vcu < 16 * ncg) {
                  bf16x8 a[8], b0[8], b1[8];
                  ctx_load(F, Hc, Wl, F.vcu & 15, cg0 + (F.vcu >> 4), a, b0, b1);
#pragma unroll 1
                  for (int id = F.vcu; id < 16 * ncg; id += F.G) {
                      f32x16 c0, c1; ctx_mma(a, b0, b1, c0, c1);
                      const int nid = id + F.G;
                      if (nid < 16 * ncg) ctx_load(F, Hc, Wl, nid & 15, cg0 + (nid >> 4), a, b0, b1);
                      ctx_tail<0>(F, c0, c1, id & 15, cg0 + (id >> 4), PB + (size_t)M * IN_W, ka->in[11] + l * 128, nullptr, nullptr, nullptr, ws + WS_KT, ws + WS_VT, (unsigned*)(ws + WS_AT));
                  }
              } }
        } else if (kind == 3) {
        } else if (kind == 4) {
            {
                MKFRAME(F);
                const float* TW = (const float*)(ws + WS_TW);
                gu32* fcnt = (gu32*)(ws + WS_CTL) + CW_FFT + 64 * l;
                const int nfft = upd ? 512 : 256;
#pragma unroll 1
                for (int it = F.vcu; it < nfft; it += F.G) {
                    const bool cx = it >= 256; const int j = it & 255, b = j >> 7, p = j & 127;
                    const size_t eo = cx ? AT_CTX + (size_t)(b * 128 + p) * CL : (size_t)(b * 128 + p) * L;
                    if (cx) fft_item(F, (const unsigned*)(ws + WS_AT) + eo, 8, (u32x2*)(ws + WS_U) + eo, TW);
                    else fft13_item(F, (const unsigned*)(ws + WS_AT) + eo, (u32x2*)(ws + WS_U) + eo, TW);
                    if (F.tid == 0) __hip_atomic_fetch_add(fcnt, 1u, __ATOMIC_RELAXED, __HIP_MEMORY_SCOPE_AGENT);
                }
            }
            const int skip = ka->skip;
            const int nitem = (skip & 1) ? 0 : (upd ? 528 : 512);
#pragma unroll 1
            for (int it = vcu; it < nitem; it += Gd) {
                const bool cx = it >= 512;
                const int j = cx ? it - 512 : it, bh = cx ? (j >> 1) : (j >> 6), qb = cx ? (j & 1) : (j & 63);
                int t2; asm volatile("v_mbcnt_lo_u32_b32 %0, -1, 0\n\tv_mbcnt_hi_u32_b32 %0, -1, %0" : "=v"(t2)); t2 += wave_id * 64;
                const __attribute__((address_space(4))) Args* ka2 = ka; asm volatile("" : "+s"(ka2));
                unsigned char* ws2 = ka2->ws; asm volatile("" : "+s"(ws2));
                att2::attn_item((const bf16*)(ws2 + WS_PB), ws2 + WS_KT, ws2 + WS_VT, (bf16*)(ws2 + WS_Y), ka2->in[13] + l * 128, (const float*)(ws2 + WS_SC) + l * 4, cx, bh >> 2, bh & 3, qb * 128, (char*)lds + RING_OFF, t2);
            }
            const int ntile = (skip & 2) ? 0 : (upd ? 264 : 256);
            MKFRAME(F2);
            asm volatile("s_waitcnt vmcnt(0)" ::: "memory");
            {
                gu32* fcnt = (gu32*)(ka->ws + WS_CTL) + CW_FFT + 64 * l; const unsigned want = upd ? 512u : 256u;
                if (F2.tid == 0) { unsigned sp = 0; while (__hip_atomic_load(fcnt, __ATOMIC_RELAXED, __HIP_MEMORY_SCOPE_AGENT) < want) { __builtin_amdgcn_s_sleep(8); if (++sp > (1u << 22)) break; }
                    __builtin_amdgcn_fence(__ATOMIC_ACQUIRE, "agent"); asm volatile("s_waitcnt vmcnt(0)" ::: "memory"); }
                __syncthreads();
                if (F2.tid == 0) {
                    for (int it = F2.vcu; it < nitem; it += F2.G) { const int blk = it < 512 ? ((it >> 8) * 32 + ((it & 63) >> 1)) : 64 + ((it - 512) >> 3);
                        (void)__hip_atomic_fetch_add((gu32*)(ka->ws + WS_CTL) + SEAM_YCNT(l, blk), 1u, __ATOMIC_RELAXED, __HIP_MEMORY_SCOPE_AGENT); } }
            }
            gu32* qcnt = (gu32*)(ka->ws + WS_CTL) + CW_Q + 64 * l;
            int prev = -1;
            if (F2.tid == 0) MISC[46] = __hip_atomic_fetch_add(qcnt, 1u, __ATOMIC_RELAXED, __HIP_MEMORY_SCOPE_AGENT);
#pragma unroll 1
            for (;;) {
                __syncthreads();
                const int it = __builtin_amdgcn_readfirstlane((int)MISC[46]);
                unsigned char* ws3 = ka->ws; asm volatile("" : "+s"(ws3));
                gu32* pub = nullptr;
                if (prev >= 0) { const int t_ = prev < ntile ? prev : prev - ntile; const int blk = t_ < 256 ? (t_ >> 2) : 64 + ((t_ - 256) >> 2); pub = (gu32*)(ws3 + WS_CTL) + SEAM_YCNT(l, blk); }
                __syncthreads();
                if (it >= 2 * ntile) {
                    asm volatile("s_waitcnt vmcnt(0)" ::: "memory");
                    __syncthreads();
                    if (pub && F2.tid == 0) (void)__hip_atomic_fetch_add(pub, 1u, __ATOMIC_RELAXED, __HIP_MEMORY_SCOPE_AGENT);
                    break; }
                prev = it;
                if (it < ntile) {
                    const bool cx = it >= 256; const int j = it - 256;
                    const int rb = cx ? M + (j >> 2) * CL : (it >> 7) * L, Lr = cx ? CL : L, t0 = cx ? (j & 3) * 64 : (it & 127) * 64;
                    const unsigned n_ = pool_item(F2, (bf16*)(ws3 + WS_PB), (bf16*)(ws3 + WS_Y), rb, Lr, t0, (const bf16*)(ws3 + WS_WP) + (size_t)l * 4 * 64 * 64, ka->in[10] + l * 256, qcnt, pub);
                    if (F2.tid == 0) MISC[46] = n_;
                } else {
                    const unsigned n_ = flin_item(F2, (const bf16*)(ws3 + WS_PB), (const bf16*)(ws3 + WS_U), (bf16*)(ws3 + WS_Y), (it - ntile) * 64, (const bf16*)(ws3 + WS_WF) + (size_t)l * 4 * 64 * 128, qcnt, pub);
                    if (F2.tid == 0) MISC[46] = n_; }
            }
        } else {
            MKFRAME(F);
            const int Mo = M;
            pg8::Gemm g{Y, (const bf16*)(ws + WS_WOUT) + (size_t)l * D * D, Mo, D, D};
            pg8::EpiResL E{xin, out, mod, L, F.lds + RING_OFF, upd ? 1 : 0};
            gu32* oq = (gu32*)(ws + WS_CTL) + CW_Q + 64 * l + 48;
            if (upd && F.tid == 0) (void)__hip_atomic_fetch_add((gu32*)(ws + WS_CTL) + SEAM_MIXDONE, 1u, __ATOMIC_RELAXED, __HIP_MEMORY_SCOPE_AGENT);
#pragma unroll 1
            for (;;) {
                if (F.tid == 0) MISC[46] = __hip_atomic_fetch_add(oq, 1u, __ATOMIC_RELAXED, __HIP_MEMORY_SCOPE_AGENT);
                __syncthreads();
                const int tk = __builtin_amdgcn_readfirstlane((int)MISC[46]);
                __syncthreads();
                if (tk >= (Mo / 256) * 4) break;
                pg8::OneUnit S; S.pm = tk >> 2; S.pn = tk & 3;
                if (F.tid == 0) seam_wait_ge((gu32*)(ws + WS_CTL) + SEAM_YCNT(l, S.pm), 16u);
                asm volatile("" ::: "memory");
                __syncthreads();
                pg8::gemm_phase<pg8::EpiResL, pg8::OneUnit, true, true>(F.lds + RING_OFF, g, S, E, F.tid);
                if (upd && F.tid == 0) (void)__hip_atomic_fetch_add((gu32*)(ws + WS_CTL) + SEAM_XCNT(S.pm), 1u, __ATOMIC_RELAXED, __HIP_MEMORY_SCOPE_AGENT);
            }
            if (upd) {
#pragma unroll 1
                for (int id = F.vcu; id < 256; id += F.G) { if (F.tid == 0) seam_wait_ge((gu32*)(ka->ws + WS_CTL) + SEAM_YCNT(l, 64 + ((id & 15) >> 3)), 16u); asm volatile("" ::: "memory"); __syncthreads(); ctx_tile<1>(F, Y + (size_t)M * D, (const bf16*)(ws + WS_WOUT) + (size_t)l * D * D, id & 15, id >> 4, nullptr, nullptr, cin, (float*)(ws + WS_CTX1), mod + 2 * 3072 + 2048);
                    if (F.tid == 0) (void)__hip_atomic_fetch_add((gu32*)(ka->ws + WS_CTL) + SEAM_CXCNT, 1u, __ATOMIC_RELAXED, __HIP_MEMORY_SCOPE_AGENT); } }
        }
        if (ph + 1 < hi && kind != 3 && kind != 1 && kind != 0 && kind != 4 && kind != 5) xcd_barrier(bar);
    }
#undef MKFRAME
}


extern "C" void kernel_launch(void* const* d_in, const int* in_sizes, int n_in, void* d_out, int out_size, void* d_ws, size_t ws_size, hipStream_t stream) {
    static int grid = 0;
    if (grid == 0) {
        if (n_in != 15 || out_size != M * D || ws_size < WS_END) { fprintf(stderr, "kernel_launch: unexpected shapes (n_in %d out %d ws %zu)\n", n_in, out_size, ws_size); grid = -1; return; }
        int dev = 0, cus = 0, per_cu = 0;
        if (hipGetDevice(&dev) != hipSuccess || hipDeviceGetAttribute(&cus, hipDeviceAttributeMultiprocessorCount, dev) != hipSuccess) { grid = -1; return; }
        if (hipFuncSetAttribute((const void*)mk_fwd, hipFuncAttributeMaxDynamicSharedMemorySize, LDS_BYTES) != hipSuccess) { fprintf(stderr, "kernel_launch: hipFuncSetAttribute failed\n"); grid = -1; return; }
        if (hipOccupancyMaxActiveBlocksPerMultiprocessor(&per_cu, (const void*)mk_fwd, NWAVES * 64, LDS_BYTES) != hipSuccess || per_cu < 1) { fprintf(stderr, "kernel_launch: occupancy query says %d\n", per_cu); per_cu = 1; }
        (void)hipGetLastError();
        grid = cus;
    }
    if (grid < 0) return;
    (void)hipMemsetAsync((char*)d_ws + WS_CTL, 0, CTL_ZERO_BYTES, stream);
    Args a; memset(&a, 0, sizeof a);
    for (int i = 0; i < 15; ++i) a.in[i] = (const float*)d_in[i];
    a.out = (float*)d_out; a.ws = (unsigned char*)d_ws;
#if MK_PER_PHASE
    for (int ph = 0; ph < NPH; ++ph) { a.ph_lo = ph; a.ph_hi = ph + 1; hipLaunchKernelGGL(mk_fwd, dim3(grid), dim3(NWAVES * 64), LDS_BYTES, stream, a); }
#else
    a.ph_lo = 0; a.ph_hi = NPH; hipLaunchKernelGGL(mk_fwd, dim3(grid), dim3(NWAVES * 64), LDS_BYTES, stream, a);
#endif
    const hipError_t le = hipPeekAtLastError();
    if (le != hipSuccess) fprintf(stderr, "kernel_launch: launch failed: %s\n", hipGetErrorName(le));
}
```

```cpp
#include <hip/hip_runtime.h>
#include <math.h>
#include <string.h>
#include <stdio.h>
#include <stdint.h>

#ifndef MK_PER_PHASE
#define MK_PER_PHASE 0
#endif

constexpr int D = 1024, NB = 2, L = 8192, DEPTH = 2, CL = 256;
constexpr int A_OFF = 0, B_OFF = 256, Q_OFF = 512, K_OFF = 1024, V_OFF = 1536, G_OFF = 2048, IN_W = 3072;
constexpr int M = NB * L, MC = NB * CL, MT = M + MC;
constexpr float EPS = 1e-6f;
constexpr float LOG2E = 1.4426950408889634f;
constexpr int NPH = 1 + 5 * DEPTH;

constexpr size_t MiB = 1u << 20, KiB = 1024;
constexpr size_t WS_CTL = 0, CTL_ZERO_BYTES = 64 * KiB;
constexpr size_t WS_MOD = 18 * MiB;
constexpr int MODQ = DEPTH * 3 * 3072;
constexpr size_t WS_SC = 1 * MiB + 96 * KiB;
constexpr size_t WS_ROPE = 1 * MiB + 128 * KiB;
constexpr size_t WS_TW = 1 * MiB + 256 * KiB;
constexpr size_t WS_WF = 1 * MiB + 512 * KiB;
constexpr size_t WS_WP = 1 * MiB + 768 * KiB;
constexpr size_t WS_WIN = 2 * MiB;
constexpr size_t WS_WOUT = 14 * MiB;
constexpr size_t WS_H = 20 * MiB;
constexpr size_t WS_PB = 54 * MiB;
constexpr size_t WS_U = 154 * MiB;
constexpr size_t WS_Y = 172 * MiB;
constexpr size_t WS_CTX1 = 206 * MiB;
constexpr size_t WS_KT = 208 * MiB;
constexpr size_t WS_VT = 226 * MiB;
constexpr size_t WS_AT = 244 * MiB;
constexpr size_t AT_CTX = (size_t)NB * 128 * L;
constexpr size_t WS_END = 253 * MiB;
constexpr int NTILE = (CL + L) / 64;

typedef unsigned short bf16;
#define LAS __attribute__((address_space(3)))
#define GAS __attribute__((address_space(1)))
typedef float f32x4 __attribute__((ext_vector_type(4)));
typedef float f32x16 __attribute__((ext_vector_type(16)));
typedef unsigned u32x4 __attribute__((ext_vector_type(4)));
typedef unsigned u32x2 __attribute__((ext_vector_type(2)));
typedef short bf16x8 __attribute__((ext_vector_type(8)));
typedef short s16x4 __attribute__((ext_vector_type(4)));

__device__ __forceinline__ float silu_f(float t) { return t * __builtin_amdgcn_rcpf(1.f + __expf(-t)); }
template <int MASK> __device__ __forceinline__ float sxor(float v) {
    return __builtin_bit_cast(float, __builtin_amdgcn_ds_swizzle(__builtin_bit_cast(int, v), (MASK << 10) | 0x1f));
}
__device__ __forceinline__ float half_swap_sum(float v) { unsigned a = __builtin_bit_cast(unsigned, v), b = a; asm volatile("" : "+v"(b)); auto rr = __builtin_amdgcn_permlane32_swap(a, b, false, false); unsigned r0 = rr[0], r1 = rr[1]; asm volatile("" : "+v"(r0), "+v"(r1)); return __builtin_bit_cast(float, r0) + __builtin_bit_cast(float, r1); }
__device__ __forceinline__ float half_swap_max(float v) { unsigned a = __builtin_bit_cast(unsigned, v), b = a; asm volatile("" : "+v"(b)); auto rr = __builtin_amdgcn_permlane32_swap(a, b, false, false); unsigned r0 = rr[0], r1 = rr[1]; asm volatile("" : "+v"(r0), "+v"(r1)); return fmaxf(__builtin_bit_cast(float, r0), __builtin_bit_cast(float, r1)); }
template <int CTRL> __device__ __forceinline__ float dpp_f(float v) { return __builtin_bit_cast(float, __builtin_amdgcn_update_dpp(0, __builtin_bit_cast(int, v), CTRL, 0xf, 0xf, true)); }
__device__ __forceinline__ float row_swap_sum(float v) { unsigned a = __builtin_bit_cast(unsigned, v), b = a; asm volatile("" : "+v"(b)); auto rr = __builtin_amdgcn_permlane16_swap(a, b, false, false); unsigned r0 = rr[0], r1 = rr[1]; asm volatile("" : "+v"(r0), "+v"(r1)); return __builtin_bit_cast(float, r0) + __builtin_bit_cast(float, r1); }
__device__ __forceinline__ float sum32(float v) { v += dpp_f<0xB1>(v); v += dpp_f<0x4E>(v); v += dpp_f<0x141>(v); v += dpp_f<0x140>(v); return row_swap_sum(v); }
__device__ __forceinline__ float wave_sum(float v) { return half_swap_sum(sum32(v)); }
__device__ __forceinline__ float wave_max(float v) {
    v = fmaxf(v, sxor<16>(v)); v = fmaxf(v, sxor<8>(v)); v = fmaxf(v, sxor<4>(v)); v = fmaxf(v, sxor<2>(v)); v = fmaxf(v, sxor<1>(v));
    return half_swap_max(v);
}
__device__ __forceinline__ unsigned f2bf(float f) { unsigned u = __builtin_bit_cast(unsigned, f); return (u + 0x7fffu + ((u >> 16) & 1u)) >> 16; }
__device__ __forceinline__ unsigned pk2(float lo, float hi) { return f2bf(lo) | (f2bf(hi) << 16); }
__device__ __forceinline__ float bflo(unsigned u) { return __builtin_bit_cast(float, u << 16); }
__device__ __forceinline__ float bfhi(unsigned u) { return __builtin_bit_cast(float, u & 0xffff0000u); }
__device__ __forceinline__ float bf2f(bf16 h) { return __builtin_bit_cast(float, (unsigned)h << 16); }

__device__ __forceinline__ f32x4 mod4(const float* p) { return (*(const f32x4*)p + *(const f32x4*)(p + MODQ)) + (*(const f32x4*)(p + 2 * MODQ) + *(const f32x4*)(p + 3 * MODQ)); }

__device__ __forceinline__ void st_wt16(void* p, u32x4 v) { asm volatile("global_store_dwordx4 %0, %1, off sc1\n\ts_nop 1" :: "v"(p), "v"(v) : "memory"); }
namespace pg8 {
#define PG8_LAS __attribute__((address_space(3)))
typedef unsigned short bf16_t;
constexpr int BM = 256, BK = 64, HALF = 128, HTB = HALF * BK * 2, STAGE_BYTES = 8 * HTB, NXCD = 8, WGM = 8;
__host__ __device__ __forceinline__ int lds_byte(int r, int c) { const int st = (r >> 4) * 2 + (c >> 5), rr = r & 15, cc = c & 31, ob = rr * 64 + cc * 2; return st * 1024 + (ob ^ (((ob >> 9) & 1) << 5)); }
__host__ __device__ __forceinline__ void stage_rc(int b, int& R, int& C) { const int st = b / 1024, sb = b % 1024, swz = sb ^ (((sb >> 9) & 1) << 5); R = (st >> 1) * 16 + swz / 64; C = (st & 1) * 32 + (swz % 64) / 2; }
__host__ __device__ __forceinline__ int perm32(int rho) { const int n = rho >> 4, i = rho & 15; return 8 * (i >> 2) + 4 * n + (i & 3); }
struct Unit { int pm, pn; };
struct Gemm { const bf16_t* A; const bf16_t* Bt; int M, N, K; };
struct StaticOrder {
    int nM, nN, nwg, G, c;
    __host__ __device__ void init(int M_, int N_, int G_, int c_) { nM = M_ / BM; nN = N_ / BM; nwg = nM * nN; G = G_; c = c_; }
    __host__ __device__ bool next(int i, Unit& u) const {
        const long Lx = (long)i * G + c; if (Lx >= nwg) return false;
        int wgid = (int)Lx; { const int q = nwg / NXCD, r = nwg % NXCD, xcd = wgid % NXCD, off = wgid / NXCD; wgid = (xcd < r ? xcd * (q + 1) : r * (q + 1) + (xcd - r) * q) + off; }
        const int nig = WGM * nN, gid = wgid / nig, fm = gid * WGM, gsz = (nM - fm) < WGM ? (nM - fm) : WGM;
        u.pm = fm + ((wgid % nig) % gsz); u.pn = (wgid % nig) / gsz; return true;
    }
    __device__ __forceinline__ void a_ready(const Unit&) const {}
    __device__ __forceinline__ void done(const Unit&) const {}
};
__device__ __forceinline__ unsigned cvt_pk_bf16(float lo, float hi) { unsigned r; asm volatile("v_cvt_pk_bf16_f32 %0, %1, %2" : "=v"(r) : "v"(lo), "v"(hi)); return r; }
struct EpiBf16 {
    static constexpr bool PERM = true, AFTER_DRAIN = false, GROUP64 = false;
    bf16_t* O; int ldc;
    __device__ __forceinline__ void operator()(const f32x4 (&acc)[2][2][4][2], const Unit& u, int wr, int wc, int fr, int fq) const {
        const int row0 = u.pm * BM + wr * 64 + fr, col0 = u.pn * BM + wc * 32 + 8 * fq;
#pragma unroll
        for (int ai = 0; ai < 2; ++ai)
#pragma unroll
            for (int m = 0; m < 4; ++m) { bf16_t* rowp = O + (size_t)(row0 + ai * HALF + m * 16) * ldc + col0;
#pragma unroll
                for (int bj = 0; bj < 2; ++bj) { const f32x4 v0 = acc[ai][bj][m][0], v1 = acc[ai][bj][m][1];
                    u32x4 w; w.x = cvt_pk_bf16(v0[0], v0[1]); w.y = cvt_pk_bf16(v0[2], v0[3]); w.z = cvt_pk_bf16(v1[0], v1[1]); w.w = cvt_pk_bf16(v1[2], v1[3]);
                    *(u32x4*)(rowp + bj * HALF) = w; } }
    }
};

struct EpiIn {
    static constexpr bool PERM = true, AFTER_DRAIN = false, GROUP64 = true;
    bf16_t* O; const float* qkg; const float* rope; unsigned char* KT; unsigned char* VT; unsigned* AT;
    static __device__ __forceinline__ size_t kv_block(int row, int h, int& key) { const int b = row >> 13, kidx = CL + (row & (L - 1)); key = kidx & 63; return ((size_t)((b * 4 + h) * NTILE + (kidx >> 6))) * 16384; }
    __device__ __forceinline__ void operator()(const f32x4 (&acc)[2][2][4][2], const Unit& u, int wr, int wc, int fr_, int fq_) const {
        int ln_; asm volatile("v_mbcnt_lo_u32_b32 %0, -1, 0\n\tv_mbcnt_hi_u32_b32 %0, -1, %0" : "=v"(ln_)); const int fr = ln_ & 15, fq = ln_ >> 4; (void)fr_; (void)fq_;
        const int row0 = u.pm * BM + wr * 64 + fr, col0 = u.pn * BM + wc * 64 + 8 * fq;
        if (u.pn == 6 || u.pn == 7) {
            const int g64 = (u.pn - 6) * 4 + wc, h = g64 >> 1;
#pragma unroll
            for (int ai = 0; ai < 2; ++ai)
#pragma unroll
                for (int m = 0; m < 4; ++m) { int key; const size_t blk = kv_block(row0 + ai * HALF + m * 16, h, key);
#pragma unroll
                    for (int bj = 0; bj < 2; ++bj) { const f32x4 v0 = acc[ai][bj][m][0], v1 = acc[ai][bj][m][1];
                        u32x4 w; w.x = cvt_pk_bf16(v0[0], v0[1]); w.y = cvt_pk_bf16(v0[2], v0[3]); w.z = cvt_pk_bf16(v1[0], v1[1]); w.w = cvt_pk_bf16(v1[2], v1[3]);
                        *(u32x4*)(VT + blk + ((g64 & 1) * 2 + bj) * 4096 + key * 64 + fq * 16) = w; } }
            return;
        }
        if (u.pn == 0) {
#pragma unroll
            for (int ai = 0; ai < 2; ++ai)
#pragma unroll
                for (int m = 0; m < 4; ++m) { const int row = row0 + ai * HALF + m * 16; unsigned* ap = AT + ((size_t)((row >> 13) * 128 + 32 * wc + 4 * fq)) * L + (row & (L - 1));
#pragma unroll
                    for (int bj = 0; bj < 2; ++bj) { const f32x4 v0 = acc[ai][bj][m][0], v1 = acc[ai][bj][m][1]; unsigned* a2 = ap + (size_t)(16 * bj) * L;
                        a2[0] = cvt_pk_bf16(v0[0], v0[1]); a2[L] = cvt_pk_bf16(v0[2], v0[3]); a2[2 * L] = cvt_pk_bf16(v1[0], v1[1]); a2[3 * L] = cvt_pk_bf16(v1[2], v1[3]); } }
            return;
        }
        if (u.pn < 2 || u.pn >= 6) {
#pragma unroll
            for (int ai = 0; ai < 2; ++ai)
#pragma unroll
                for (int m = 0; m < 4; ++m) { bf16_t* rowp = O + (size_t)(row0 + ai * HALF + m * 16) * IN_W + col0;
#pragma unroll
                    for (int bj = 0; bj < 2; ++bj) { const f32x4 v0 = acc[ai][bj][m][0], v1 = acc[ai][bj][m][1];
                        u32x4 w; w.x = cvt_pk_bf16(v0[0], v0[1]); w.y = cvt_pk_bf16(v0[2], v0[3]); w.z = cvt_pk_bf16(v1[0], v1[1]); w.w = cvt_pk_bf16(v1[2], v1[3]);
                        *(u32x4*)(rowp + bj * 32) = w; } }
            return;
        }
        const int part = u.pn >= 4 ? 1 : 0;
        const bool isc = u.pm >= 64;
        const float qs = part ? 1.f : 0.125f * LOG2E;
        const int hi = fq >> 1, jb = 8 * (fq & 1);
        f32x4 gv[2][2];
#pragma unroll
        for (int bj = 0; bj < 2; ++bj)
#pragma unroll
            for (int n = 0; n < 2; ++n) gv[bj][n] = *(const f32x4*)(qkg + part * 64 + 32 * bj + 8 * fq + 4 * n);
#pragma unroll
        for (int ai = 0; ai < 2; ++ai)
#pragma unroll
            for (int m = 0; m < 4; ++m) {
                const int row = row0 + ai * HALF + m * 16;
                float ss = 0.f;
#pragma unroll
                for (int bj = 0; bj < 2; ++bj)
#pragma unroll
                    for (int n = 0; n < 2; ++n) { const f32x4 x = acc[ai][bj][m][n]; ss += (x[0] * x[0] + x[1] * x[1]) + (x[2] * x[2] + x[3] * x[3]); }
                ss = half_swap_sum(row_swap_sum(ss));
                const float rs = __builtin_amdgcn_rsqf(ss * (1.f / 64.f) + EPS);
                f32x4 y[2][2];
#pragma unroll
                for (int bj = 0; bj < 2; ++bj)
#pragma unroll
                    for (int n = 0; n < 2; ++n) y[bj][n] = acc[ai][bj][m][n] * rs * gv[bj][n];
                if (!isc) {
                    const int t = row & (L - 1);
                    f32x4 tab[2][2][2];
#pragma unroll
                    for (int bj = 0; bj < 2; ++bj) { const float* rp = rope + ((bj ? (t & 63) : (t >> 6)) * 16 + jb) * 2;
#pragma unroll
                        for (int n = 0; n < 2; ++n) { tab[bj][n][0] = *(const f32x4*)(rp + 8 * n); tab[bj][n][1] = *(const f32x4*)(rp + 8 * n + 4); } }
#pragma unroll
                    for (int bj = 0; bj < 2; ++bj) {
#pragma unroll
                        for (int n = 0; n < 2; ++n) {
                            const f32x4 ca = tab[bj][n][0], cb = tab[bj][n][1];
                            const float cs[4] = {ca[0], ca[2], cb[0], cb[2]}, sn[4] = {ca[1], ca[3], cb[1], cb[3]};
#pragma unroll
                            for (int e = 0; e < 4; ++e) {
                                const float yv = y[bj][n][e];
                                unsigned a_ = __builtin_bit_cast(unsigned, yv), b_ = a_; asm volatile("" : "+v"(b_));
                                auto rr = __builtin_amdgcn_permlane32_swap(a_, b_, false, false); unsigned r0 = rr[0], r1 = rr[1]; asm volatile("" : "+v"(r0), "+v"(r1));
                                const float other = __builtin_bit_cast(float, hi ? r0 : r1);
                                y[bj][n][e] = hi ? (yv * cs[e] + other * sn[e]) : (yv * cs[e] - other * sn[e]);
                            }
                        }
                    }
                }
                bf16_t* rowp = O + (size_t)row * IN_W + col0;
                int key = 0; size_t blk = 0; const int g64 = (u.pn & 1) * 4 + wc;
                if (part) blk = kv_block(row, g64 >> 1, key);
#pragma unroll
                for (int bj = 0; bj < 2; ++bj) { const f32x4 v0 = y[bj][0] * qs, v1 = y[bj][1] * qs;
                    u32x4 w; w.x = cvt_pk_bf16(v0[0], v0[1]); w.y = cvt_pk_bf16(v0[2], v0[3]); w.z = cvt_pk_bf16(v1[0], v1[1]); w.w = cvt_pk_bf16(v1[2], v1[3]);
                    if (part) *(u32x4*)(KT + blk + (g64 & 1) * 8192 + (4 * bj + fq) * 1024 + key * 16) = w;
                    else *(u32x4*)(rowp + bj * 32) = w; }
            }
    }
};
struct OneUnit {
    int pm, pn;
    __host__ __device__ bool next(int i, Unit& u) const { if (i != 0) return false; u.pm = pm; u.pn = pn; return true; }
    __device__ __forceinline__ void a_ready(const Unit&) const {}
    __device__ __forceinline__ void done(const Unit&) const {}
};
struct EpiRes {
    static constexpr bool PERM = false, AFTER_DRAIN = false, GROUP64 = false;
    const float* res0; float* out0; const float* res1; float* out1; const float* mod; int mlat, rows_per_vec;
    __device__ __forceinline__ void operator()(const f32x4 (&acc)[2][2][4][2], const Unit& u, int wr, int wc, int fr, int fq) const {
        int row0 = u.pm * BM + wr * 64 + fr; const int col0 = u.pn * BM + wc * 32 + 4 * fq;
        const bool isc = (u.pm * BM) >= mlat;
        const float* res = isc ? res1 : res0; float* out = isc ? out1 : out0;
        const int vec = isc ? 2 : (u.pm * BM) / rows_per_vec;
        if (isc) row0 -= mlat;
        const float* gp = mod + vec * 3072 + 2048 + col0;
        f32x4 gv[2][2];
#pragma unroll
        for (int bj = 0; bj < 2; ++bj)
#pragma unroll
            for (int n = 0; n < 2; ++n) gv[bj][n] = mod4(gp + bj * HALF + n * 16);
#pragma unroll
        for (int ai = 0; ai < 2; ++ai) {
            f32x4 rr[4][2][2];
#pragma unroll
            for (int m = 0; m < 4; ++m) { const size_t off = (size_t)(row0 + ai * HALF + m * 16) * 1024 + col0;
#pragma unroll
                for (int bj = 0; bj < 2; ++bj)
#pragma unroll
                    for (int n = 0; n < 2; ++n) rr[m][bj][n] = *(const f32x4*)(res + off + bj * HALF + n * 16); }
            asm volatile("" ::: "memory");
#pragma unroll
            for (int m = 0; m < 4; ++m) { const size_t off = (size_t)(row0 + ai * HALF + m * 16) * 1024 + col0;
#pragma unroll
                for (int bj = 0; bj < 2; ++bj)
#pragma unroll
                    for (int n = 0; n < 2; ++n) *(f32x4*)(out + off + bj * HALF + n * 16) = rr[m][bj][n] + gv[bj][n] * acc[ai][bj][m][n]; }
            asm volatile("" ::: "memory");
        }
    }
};

struct EpiResL {
    static constexpr bool PERM = false, AFTER_DRAIN = false, GROUP64 = false;
    const float* res; float* out; const float* mod; int rows_per_vec; PG8_LAS unsigned char* lds; int wt;
    __device__ __forceinline__ void operator()(const f32x4 (&acc)[2][2][4][2], const Unit& u, int wr, int wc, int fr_, int fq_) const {
        int ln_; asm volatile("v_mbcnt_lo_u32_b32 %0, -1, 0\n\tv_mbcnt_hi_u32_b32 %0, -1, %0" : "=v"(ln_)); const int fr = ln_ & 15, fq = ln_ >> 4; (void)fr_; (void)fq_;
        const int tid = (wr * 4 + wc) * 64 + ln_;
        asm volatile("s_waitcnt vmcnt(0)" ::: "memory");
        __syncthreads();
        const int vec = (u.pm * BM) / rows_per_vec;
        const float* gp = mod + vec * 3072 + 2048 + u.pn * BM + wc * 32 + 4 * fq;
        f32x4 gv[2][2];
#pragma unroll
        for (int bj = 0; bj < 2; ++bj)
#pragma unroll
            for (int n = 0; n < 2; ++n) gv[bj][n] = mod4(gp + bj * HALF + n * 16);
        PG8_LAS float* X = (PG8_LAS float*)lds;
#pragma unroll
        for (int ai = 0; ai < 2; ++ai)
#pragma unroll
            for (int mh = 0; mh < 2; ++mh) {
#pragma unroll
                for (int j = 0; j < 2; ++j) { PG8_LAS float* xr = X + (wr * 32 + j * 16 + fr) * 260 + wc * 32 + 4 * fq;
#pragma unroll
                    for (int bj = 0; bj < 2; ++bj)
#pragma unroll
                        for (int n = 0; n < 2; ++n) *(PG8_LAS f32x4*)(xr + bj * HALF + n * 16) = gv[bj][n] * acc[ai][bj][2 * mh + j][n]; }
                __syncthreads();
                f32x4 rr[8];
#pragma unroll
                for (int i = 0; i < 8; ++i) { const int id = tid + 512 * i, rl = id >> 6, c4 = id & 63;
                    const size_t off = (size_t)(u.pm * BM + ai * HALF + (rl >> 5) * 64 + (2 * mh + ((rl >> 4) & 1)) * 16 + (rl & 15)) * 1024 + u.pn * BM + 4 * c4;
                    rr[i] = *(const f32x4*)(res + off); }
                asm volatile("" ::: "memory");
#pragma unroll
                for (int i = 0; i < 8; ++i) { const int id = tid + 512 * i, rl = id >> 6, c4 = id & 63;
                    const size_t off = (size_t)(u.pm * BM + ai * HALF + (rl >> 5) * 64 + (2 * mh + ((rl >> 4) & 1)) * 16 + (rl & 15)) * 1024 + u.pn * BM + 4 * c4;
                    const f32x4 o4 = rr[i] + *(const PG8_LAS f32x4*)(X + rl * 260 + 4 * c4);
                    if (wt) st_wt16(out + off, __builtin_bit_cast(u32x4, o4)); else *(f32x4*)(out + off) = o4; }
                asm volatile("" ::: "memory");
                __syncthreads();
            }
    }
};

template <class Epi, class Sched, bool ALIGN_EPI = false, bool SP2 = false>
__device__ __forceinline__ void gemm_phase(PG8_LAS unsigned char* lds, const Gemm g, const Sched& S, const Epi& E, const int tid) {
    const int wid = __builtin_amdgcn_readfirstlane(tid >> 6), lane = tid & 63, wr = wid >> 2, wc = wid & 3, fr = lane & 15, fq = lane >> 4;
    const int K = g.K, nt = K / BK;
    unsigned voffA[2], voffB[2];
#pragma unroll
    for (int i = 0; i < 2; ++i) { int R, C; stage_rc(tid * 16 + i * 8192, R, C);
        const int Rb = Epi::GROUP64 ? ((R >> 5) * 64 + perm32(R & 31)) : (Epi::PERM ? ((R & ~31) + perm32(R & 31)) : R);
        voffA[i] = (unsigned)(R * K + C) * 2u; voffB[i] = (unsigned)(Rb * K + C) * 2u; }
    const size_t kstep = (size_t)(BK * 2);
    const size_t hstep = (size_t)HALF * K * 2;
    const size_t hstepB = Epi::GROUP64 ? (size_t)32 * K * 2 : hstep;
    const size_t tstep = 2 * hstep;
    const unsigned ldsw = (unsigned)wid * 1024u;
    const int aoff = lds_byte(wr * 64 + fr, fq * 8), boff = lds_byte(wc * 32 + fr, fq * 8);
#define PG8_SA(b, h) (((b) * 2 + (h)) * HTB)
#define PG8_SB(b, h) ((4 + (b) * 2 + (h)) * HTB)
#define PG8_STAGE(bufoff, gbase, voff) do { _Pragma("unroll") for (int _i = 0; _i < 2; ++_i) \
        __builtin_amdgcn_global_load_lds((const unsigned*)((const char*)(gbase) + (voff)[_i]), (PG8_LAS unsigned*)(lds + (bufoff) + ldsw + _i * 8192), 16, 0, 0); } while (0)
#define PG8_LDA(dst, b, h) do { _Pragma("unroll") for (int m = 0; m < 4; ++m) _Pragma("unroll") for (int k = 0; k < 2; ++k) dst[m][k] = *(const PG8_LAS bf16x8*)(lds + PG8_SA(b, h) + aoff + m * 2048 + k * 1024); } while (0)
#define PG8_LDB(dst, b, h) do { _Pragma("unroll") for (int n = 0; n < 2; ++n) _Pragma("unroll") for (int k = 0; k < 2; ++k) dst[n][k] = *(const PG8_LAS bf16x8*)(lds + PG8_SB(b, h) + boff + n * 2048 + k * 1024); } while (0)
#define PG8_MMA(ai, bj, At, Bt) do { __builtin_amdgcn_s_setprio(1); _Pragma("unroll") for (int m = 0; m < 4; ++m) _Pragma("unroll") for (int n = 0; n < 2; ++n) _Pragma("unroll") for (int k = 0; k < 2; ++k) \
        acc[ai][bj][m][n] = __builtin_amdgcn_mfma_f32_16x16x32_bf16(Bt[n][k], At[m][k], acc[ai][bj][m][n], 0, 0, 0); __builtin_amdgcn_s_setprio(0); } while (0)
#define PG8_WAIT_V(n) asm volatile("s_waitcnt vmcnt(" #n ")" ::: "memory")
#define PG8_WAIT_L(n) asm volatile("s_waitcnt lgkmcnt(" #n ")" ::: "memory")
#define PG8_BAR __builtin_amdgcn_s_barrier()
#define PG8_SCHED __builtin_amdgcn_sched_barrier(0)
    Unit cur, nxt; int ui = 0;
    if (!S.next(0, cur)) return;
    f32x4 acc[2][2][4][2];
#pragma unroll
    for (int a = 0; a < 2; ++a)
#pragma unroll
        for (int b = 0; b < 2; ++b)
#pragma unroll
            for (int m = 0; m < 4; ++m)
#pragma unroll
                for (int n = 0; n < 2; ++n) acc[a][b][m][n] = (f32x4){0.f, 0.f, 0.f, 0.f};
    bf16x8 At[4][2], B0[2][2], B1[2][2];
    const char* cA = (const char*)g.A + (size_t)cur.pm * tstep; const char* cB = (const char*)g.Bt + (size_t)cur.pn * tstep;
    S.a_ready(cur);
    if constexpr (SP2) {
        PG8_STAGE(PG8_SB(0, 0), cB, voffB); PG8_STAGE(PG8_SB(0, 1), cB + hstepB, voffB); PG8_STAGE(PG8_SA(0, 0), cA, voffA); PG8_STAGE(PG8_SA(0, 1), cA + hstep, voffA);
        if (wr == 1) PG8_BAR;
        PG8_WAIT_V(2); PG8_BAR;
        PG8_STAGE(PG8_SB(1, 0), cB + kstep, voffB); PG8_STAGE(PG8_SA(1, 0), cA + kstep, voffA); PG8_STAGE(PG8_SB(1, 1), cB + hstepB + kstep, voffB);
        PG8_WAIT_V(6); PG8_BAR;
    } else {
        PG8_STAGE(PG8_SB(0, 0), cB, voffB); PG8_STAGE(PG8_SA(0, 0), cA, voffA); PG8_STAGE(PG8_SB(0, 1), cB + hstepB, voffB); PG8_STAGE(PG8_SA(0, 1), cA + hstep, voffA);
        if (wr == 1) PG8_BAR;
        PG8_WAIT_V(4); PG8_BAR;
        PG8_STAGE(PG8_SB(1, 0), cB + kstep, voffB); PG8_STAGE(PG8_SA(1, 0), cA + kstep, voffA); PG8_STAGE(PG8_SB(1, 1), cB + hstepB + kstep, voffB);
        PG8_WAIT_V(6); PG8_BAR;
    }
    for (;;) {
        const bool has_next = S.next(ui + 1, nxt);
        const char* nA = has_next ? (const char*)g.A + (size_t)nxt.pm * tstep : cA; const char* nB = has_next ? (const char*)g.Bt + (size_t)nxt.pn * tstep : cB;
        for (int t = 0; t < nt; t += 2) {
            const bool last = (t == nt - 2);
            const char* a1 = cA + (size_t)(t + 1) * kstep;
            const char* a2 = last ? nA : cA + (size_t)(t + 2) * kstep; const char* b2 = last ? nB : cB + (size_t)(t + 2) * kstep;
            const char* a3 = a2 + kstep; const char* b3 = b2 + kstep;
            if (last && has_next) S.a_ready(nxt);
            if constexpr (SP2) {
            PG8_LDB(B0, 0, 0); PG8_LDB(B1, 0, 1); PG8_SCHED; PG8_LDA(At, 0, 0); PG8_STAGE(PG8_SA(1, 1), a1 + hstep, voffA);
            PG8_WAIT_V(8); PG8_WAIT_L(0); PG8_BAR; PG8_MMA(0, 0, At, B0); PG8_MMA(0, 1, At, B1); PG8_BAR; PG8_SCHED;
            PG8_LDA(At, 0, 1); PG8_STAGE(PG8_SB(0, 0), b2, voffB); PG8_STAGE(PG8_SB(0, 1), b2 + hstepB, voffB); PG8_STAGE(PG8_SA(0, 0), a2, voffA);
            PG8_WAIT_V(8); PG8_WAIT_L(0); PG8_BAR; PG8_MMA(1, 0, At, B0); PG8_MMA(1, 1, At, B1); PG8_BAR; PG8_SCHED;
            PG8_LDB(B0, 1, 0); PG8_LDB(B1, 1, 1); PG8_SCHED; PG8_LDA(At, 1, 0); PG8_STAGE(PG8_SA(0, 1), a2 + hstep, voffA);
            PG8_WAIT_V(8); PG8_WAIT_L(0); PG8_BAR; PG8_MMA(0, 0, At, B0); PG8_MMA(0, 1, At, B1); PG8_BAR; PG8_SCHED;
            PG8_LDA(At, 1, 1); PG8_STAGE(PG8_SB(1, 0), b3, voffB); PG8_STAGE(PG8_SB(1, 1), b3 + hstepB, voffB); PG8_STAGE(PG8_SA(1, 0), a3, voffA);
            PG8_WAIT_V(8); PG8_WAIT_L(0); PG8_BAR; PG8_MMA(1, 0, At, B0); PG8_MMA(1, 1, At, B1); PG8_BAR; PG8_SCHED;
            } else {
            PG8_LDB(B0, 0, 0); PG8_SCHED; PG8_LDA(At, 0, 0); PG8_STAGE(PG8_SA(1, 1), a1 + hstep, voffA);
            PG8_WAIT_L(8); PG8_BAR; PG8_WAIT_L(0); PG8_MMA(0, 0, At, B0); PG8_BAR; PG8_SCHED;
            PG8_LDB(B1, 0, 1); PG8_STAGE(PG8_SB(0, 0), b2, voffB);
            PG8_BAR; PG8_WAIT_L(0); PG8_MMA(0, 1, At, B1); PG8_BAR;
            PG8_LDA(At, 0, 1); PG8_STAGE(PG8_SA(0, 0), a2, voffA);
            PG8_BAR; PG8_WAIT_L(0); PG8_MMA(1, 0, At, B0); PG8_BAR; PG8_SCHED;
            PG8_STAGE(PG8_SB(0, 1), b2 + hstepB, voffB);
            PG8_WAIT_V(6); PG8_BAR; PG8_MMA(1, 1, At, B1); PG8_BAR;
            PG8_LDB(B0, 1, 0); PG8_SCHED; PG8_LDA(At, 1, 0); PG8_STAGE(PG8_SA(0, 1), a2 + hstep, voffA);
            PG8_WAIT_L(8); PG8_BAR; PG8_WAIT_L(0); PG8_MMA(0, 0, At, B0); PG8_BAR; PG8_SCHED;
            PG8_LDB(B1, 1, 1); PG8_STAGE(PG8_SB(1, 0), b3, voffB);
            PG8_BAR; PG8_WAIT_L(0); PG8_MMA(0, 1, At, B1); PG8_BAR;
            PG8_LDA(At, 1, 1); PG8_STAGE(PG8_SA(1, 0), a3, voffA);
            PG8_BAR; PG8_WAIT_L(0); PG8_MMA(1, 0, At, B0); PG8_BAR; PG8_SCHED;
            PG8_STAGE(PG8_SB(1, 1), b3 + hstepB, voffB);
            PG8_WAIT_V(6); PG8_BAR; PG8_MMA(1, 1, At, B1); PG8_BAR;
            }
        }
        if constexpr (ALIGN_EPI) { if (wr == 0) PG8_BAR; }
        if constexpr (!Epi::AFTER_DRAIN) { E(acc, cur, wr, wc, fr, fq); S.done(cur); }
        if (!has_next) break;
#pragma unroll
        for (int a = 0; a < 2; ++a)
#pragma unroll
            for (int b = 0; b < 2; ++b)
#pragma unroll
                for (int m = 0; m < 4; ++m)
#pragma unroll
                    for (int n = 0; n < 2; ++n) acc[a][b][m][n] = (f32x4){0.f, 0.f, 0.f, 0.f};
        cur = nxt; cA = nA; cB = nB; ++ui;
        if constexpr (ALIGN_EPI) { if (wr == 1) PG8_BAR; }
    }
    PG8_WAIT_V(0);
    if constexpr (!ALIGN_EPI) { if (wr == 0) PG8_BAR; }
    PG8_BAR;
#undef PG8_SA
#undef PG8_SB
#undef PG8_STAGE
#undef PG8_LDA
#undef PG8_LDB
#undef PG8_MMA
#undef PG8_WAIT_V
#undef PG8_WAIT_L
#undef PG8_BAR
#undef PG8_SCHED
}
}

namespace att {
constexpr int NW = 8, QBLK = 32, KVBLK = 64;
constexpr size_t SHM_V = KVBLK * 128 * 2, SHM_K = KVBLK * 128 * 2, SHM_ATTN = 2 * SHM_V + 2 * SHM_K + NW * 64 * 4;
#define KSWZ(row, colB) ((row) * 256 + ((colB) ^ (((row) & 7) << 4)))
#define SBAR() __builtin_amdgcn_sched_barrier(0)
__device__ __forceinline__ int crow(int r, int hi) { return (r & 3) + 8 * (r >> 2) + 4 * hi; }
__device__ __forceinline__ unsigned cvtpk(float lo, float hi) { unsigned r; asm volatile("v_cvt_pk_bf16_f32 %0, %1, %2" : "=v"(r) : "v"(lo), "v"(hi)); return r; }
__device__ __forceinline__ void expA(f32x16& p0) {
#pragma unroll
    for (int r = 0; r < 16; ++r) p0[r] = __builtin_amdgcn_exp2f(p0[r]);
}
__device__ __forceinline__ void finishSM(f32x16& p0, f32x16& p1, float& l_reg, bf16x8& pa0, bf16x8& pa1, bf16x8& pa2, bf16x8& pa3) {
#pragma unroll
    for (int r = 0; r < 16; ++r) p1[r] = __builtin_amdgcn_exp2f(p1[r]);
    float ps = 0;
#pragma unroll
    for (int r = 0; r < 16; ++r) ps += p0[r];
#pragma unroll
    for (int r = 0; r < 16; ++r) ps += p1[r];
    l_reg += ps;
#define PK4(P, BASE, OUT) do { unsigned a0 = cvtpk(P[BASE + 0], P[BASE + 1]), a1 = cvtpk(P[BASE + 2], P[BASE + 3]);   \
    unsigned b0 = cvtpk(P[BASE + 4], P[BASE + 5]), b1 = cvtpk(P[BASE + 6], P[BASE + 7]);                              \
    auto r0 = __builtin_amdgcn_permlane32_swap(a0, b0, false, false); auto r1 = __builtin_amdgcn_permlane32_swap(a1, b1, false, false); \
    u32x4 w = {r0[0], r1[0], r0[1], r1[1]}; OUT = *reinterpret_cast<bf16x8*>(&w); } while (0)
    PK4(p0, 0, pa0); PK4(p0, 8, pa1); PK4(p1, 0, pa2); PK4(p1, 8, pa3);
#undef PK4
}
__device__ __forceinline__ void qkt(f32x16& p0, f32x16& p1, const char* Ks, const bf16x8* qr, int kbase, float negM) {
#pragma unroll
    for (int r = 0; r < 16; ++r) { p0[r] = negM; p1[r] = negM; }
#pragma unroll
    for (int d0 = 0; d0 < 4; ++d0) { int kb = kbase; asm volatile("" : "+v"(kb)); const int ad = kb ^ (d0 * 32);
        bf16x8 b0 = *reinterpret_cast<const bf16x8*>(Ks + ad);
        bf16x8 b1 = *reinterpret_cast<const bf16x8*>(Ks + ad + 8192);
        p0 = __builtin_amdgcn_mfma_f32_32x32x16_bf16(b0, qr[d0], p0, 0, 0, 0);
        p1 = __builtin_amdgcn_mfma_f32_32x32x16_bf16(b1, qr[d0], p1, 0, 0, 0); }
}
__device__ __forceinline__ int v_st(int k, int c) { const int kk = (k & ~0xC) | ((k & 4) << 1) | ((k & 8) >> 1); return ((kk >> 3) * 4 + (c >> 5)) * 512 + ((kk & 7) * 32 + (c & 31)) * 2; }
__device__ __forceinline__ int v_rd_base(int lane) { return ((lane & 3) << 3) | (((lane >> 2) & 3) << 6) | (((lane >> 4) & 1) << 5) | (((lane >> 5) & 1) << 8); }
constexpr int v_rd_off(int d0, int ks, int half) { return d0 * 512 + ks * 4096 + half * 2048; }
template <int OFF> __device__ __forceinline__ s16x4 tr_read(int vb) { s16x4 r; asm volatile("ds_read_b64_tr_b16 %0, %1 offset:%2" : "=&v"(r) : "v"(vb), "i"(OFF) : "memory"); return r; }
template <int D0> __device__ __forceinline__ void pv_one(f32x16& od, int vb, bf16x8 pa0, bf16x8 pa1, bf16x8 pa2, bf16x8 pa3) {
    const s16x4 l0 = tr_read<v_rd_off(D0, 0, 0)>(vb), h0 = tr_read<v_rd_off(D0, 0, 1)>(vb), l1 = tr_read<v_rd_off(D0, 1, 0)>(vb), h1 = tr_read<v_rd_off(D0, 1, 1)>(vb);
    const s16x4 l2 = tr_read<v_rd_off(D0, 2, 0)>(vb), h2 = tr_read<v_rd_off(D0, 2, 1)>(vb), l3 = tr_read<v_rd_off(D0, 3, 0)>(vb), h3 = tr_read<v_rd_off(D0, 3, 1)>(vb);
    asm volatile("s_waitcnt lgkmcnt(0)" ::: "memory"); SBAR();
#define PK(Lo, Hi) (bf16x8){Lo[0], Lo[1], Lo[2], Lo[3], Hi[0], Hi[1], Hi[2], Hi[3]}
    od = __builtin_amdgcn_mfma_f32_32x32x16_bf16(pa0, PK(l0, h0), od, 0, 0, 0);
    od = __builtin_amdgcn_mfma_f32_32x32x16_bf16(pa1, PK(l1, h1), od, 0, 0, 0);
    od = __builtin_amdgcn_mfma_f32_32x32x16_bf16(pa2, PK(l2, h2), od, 0, 0, 0);
    od = __builtin_amdgcn_mfma_f32_32x32x16_bf16(pa3, PK(l3, h3), od, 0, 0, 0);
#undef PK
}
__device__ __forceinline__ void pv_d0(f32x16* o, int vb, bf16x8 pa0, bf16x8 pa1, bf16x8 pa2, bf16x8 pa3) {
    pv_one<0>(o[0], vb, pa0, pa1, pa2, pa3); pv_one<1>(o[1], vb, pa0, pa1, pa2, pa3); pv_one<2>(o[2], vb, pa0, pa1, pa2, pa3); pv_one<3>(o[3], vb, pa0, pa1, pa2, pa3);
}
__device__ __forceinline__ void attn_item(const bf16* PB, bf16* Y, const float* subg, const float* SC, const bool cx, int b, int h, int q0, char* lds, const int tid) {
    const int wid = tid >> 6, lane = tid & 63, r32 = lane & 31, hi = lane >> 5, wq = wid & 3, map = wid >> 2;
    char* V_lds = lds; char* K_lds = lds + 2 * SHM_V;
    const float negM = __builtin_bit_cast(float, __builtin_amdgcn_readfirstlane(__builtin_bit_cast(int, -SC[1] * LOG2E)));
    float l_reg = 0; f32x16 o[4] = {}; bf16x8 qr[4];
    const int rowq0 = (cx ? M + b * CL : b * L) + q0;
    const bf16* Qw = PB + (size_t)(rowq0 + wq * QBLK + r32) * IN_W + Q_OFF + h * 128 + map * 64 + hi * 8;
#pragma unroll
    for (int d0 = 0; d0 < 4; ++d0) qr[d0] = *reinterpret_cast<const bf16x8*>(Qw + d0 * 16);
    const int sr = tid >> 4, sc = (tid & 15) * 8, vst0 = v_st(sr, sc), vst1 = v_st(32 + sr, sc);
    const int vb0 = (int)(uintptr_t)V_lds + v_rd_base(lane);
    const int kbase = r32 * 256 + ((map * 128 + hi * 16) ^ ((r32 & 7) << 4));
    const int NT = cx ? CL / KVBLK : (CL + L) / KVBLK;
    struct { bf16x8 vs0, vs1, ks0, ks1; } sr_[2];
    const __amdgpu_buffer_rsrc_t rs = __builtin_amdgcn_make_buffer_rsrc((void*)PB, (short)0, (int)((size_t)MT * IN_W * 2), 0x00020000);
    const unsigned voff = (unsigned)(sr * IN_W + sc) * 2u;
    const unsigned so_ctx = (unsigned)((M + b * CL) * IN_W + h * 128) * 2u, so_lat = (unsigned)((b * L - CL) * IN_W + h * 128) * 2u;
#define LD16(so) __builtin_bit_cast(bf16x8, __builtin_amdgcn_raw_buffer_load_b128(rs, voff, (so), 0))
#define SLOAD(i, t) do { const int t_ = (t); const unsigned so_ = (t_ < CL / KVBLK ? so_ctx : so_lat) + (unsigned)(t_ * KVBLK) * (unsigned)(IN_W * 2); \
        sr_[i].vs0 = LD16(so_ + V_OFF * 2); sr_[i].vs1 = LD16(so_ + V_OFF * 2 + 32 * IN_W * 2); sr_[i].ks0 = LD16(so_ + K_OFF * 2); sr_[i].ks1 = LD16(so_ + K_OFF * 2 + 32 * IN_W * 2); } while (0)
#define SWRITE(bb, i) do { *(bf16x8*)(V_lds + (bb) * SHM_V + vst0) = sr_[i].vs0; *(bf16x8*)(V_lds + (bb) * SHM_V + vst1) = sr_[i].vs1; const int kc = sc * 2; \
    *(bf16x8*)(K_lds + (bb) * SHM_K + KSWZ(sr, kc)) = sr_[i].ks0; *(bf16x8*)(K_lds + (bb) * SHM_K + KSWZ(32 + sr, kc)) = sr_[i].ks1; } while (0)
#define SWAIT() asm volatile("s_waitcnt vmcnt(4)" ::: "memory")
    f32x16 pA0, pA1, pB0, pB1; bf16x8 pa0, pa1, pa2, pa3;
    constexpr int SE = 0, SO = 1;
    SLOAD(SE, 0); asm volatile("s_waitcnt vmcnt(0)" ::: "memory"); SWRITE(0, SE); __syncthreads();
    qkt(pA0, pA1, K_lds, qr, kbase, negM); expA(pA0);
    SLOAD(SO, 1); if (2 < NT) SLOAD(SE, 2);
    SWAIT(); SWRITE(1, SO); __syncthreads();
    for (int j = 1; j + 1 < NT; j += 2) {
        SBAR(); qkt(pB0, pB1, K_lds + SHM_K, qr, kbase, negM);
        finishSM(pA0, pA1, l_reg, pa0, pa1, pa2, pa3); SBAR();
        SLOAD(SO, j + 2); SBAR();
        pv_d0(o, vb0, pa0, pa1, pa2, pa3); expA(pB0);
        __syncthreads(); SWAIT(); SWRITE(0, SE);
        __syncthreads();
        SBAR(); qkt(pA0, pA1, K_lds, qr, kbase, negM);
        finishSM(pB0, pB1, l_reg, pa0, pa1, pa2, pa3); SBAR();
        if (j + 3 < NT) SLOAD(SE, j + 3); SBAR();
        pv_d0(o, vb0 + (int)SHM_V, pa0, pa1, pa2, pa3); expA(pA0);
        __syncthreads(); SWAIT(); SWRITE(1, SO);
        __syncthreads();
    }
    SBAR(); qkt(pB0, pB1, K_lds + SHM_K, qr, kbase, negM);
    finishSM(pA0, pA1, l_reg, pa0, pa1, pa2, pa3); SBAR();
    pv_d0(o, vb0, pa0, pa1, pa2, pa3); expA(pB0);
    finishSM(pB0, pB1, l_reg, pa0, pa1, pa2, pa3); SBAR();
    pv_d0(o, vb0 + (int)SHM_V, pa0, pa1, pa2, pa3);
#undef SLOAD
#undef LD16
#undef SWRITE
#undef SWAIT
    int tid2 = tid; asm volatile("" : "+v"(tid2));
    { const int wid = tid2 >> 6, lane = tid2 & 63, r32 = lane & 31, hi = lane >> 5, wq = wid & 3, map = wid >> 2;
    float* li_l = (float*)(lds + 2 * SHM_V + 2 * SHM_K) + wid * 64;
    const float* SC2 = SC; asm volatile("" : "+s"(SC2));
    const float lam = SC2[0], lam_init = SC2[2];
    l_reg = half_swap_sum(l_reg);
    if (hi == 0) li_l[r32] = l_reg;
    asm volatile("s_waitcnt lgkmcnt(0)" ::: "memory");
    float rli[16];
#pragma unroll
    for (int r = 0; r < 16; ++r) rli[r] = __builtin_amdgcn_rcpf(li_l[crow(r, hi)]);
    __syncthreads();
    float* X = (float*)lds + wq * 4096;
    if (map == 1) {
#pragma unroll
        for (int r = 0; r < 16; ++r)
#pragma unroll
            for (int d0 = 0; d0 < 4; ++d0) X[crow(r, hi) * 128 + d0 * 32 + r32] = o[d0][r] * rli[r];
    }
    __syncthreads();
    if (map == 0) {
        const float oml = 1.f - lam_init;
        float sg[4];
#pragma unroll
        for (int d0 = 0; d0 < 4; ++d0) sg[d0] = subg[d0 * 32 + r32] * oml;
        const size_t rowb = (size_t)((cx ? M + b * CL : b * L) + q0 + wq * QBLK);
#pragma unroll
        for (int r = 0; r < 16; ++r) {
            const int qrow = crow(r, hi);
            float v[4], ss = 0.f;
#pragma unroll
            for (int d0 = 0; d0 < 4; ++d0) { v[d0] = o[d0][r] * rli[r] - lam * X[qrow * 128 + d0 * 32 + r32]; ss += v[d0] * v[d0]; }
            ss += sxor<1>(ss); ss += sxor<2>(ss); ss += sxor<4>(ss); ss += sxor<8>(ss); ss += sxor<16>(ss);
            const float rs = 1.0f / sqrtf(ss * (1.f / 128.f) + EPS);
            const bf16* grow = PB + (rowb + qrow) * IN_W + G_OFF + 512 + h * 128 + r32;
            bf16* yrow = Y + (rowb + qrow) * 1024 + 512 + h * 128 + r32;
#pragma unroll
            for (int d0 = 0; d0 < 4; ++d0) yrow[d0 * 32] = (bf16)f2bf(v[d0] * rs * sg[d0] * silu_f(bf2f(grow[d0 * 32])));
        }
    }
    }
    __syncthreads();
}
#undef KSWZ
#undef SBAR
}


namespace att2 {
constexpr int NW = 8, QBLK = 32, KVBLK = 64, NSLOT = 4, KSLOT = 16384, VSLOT = 16384;
constexpr int LDS_K = 0, LDS_V = NSLOT * KSLOT, LDS_WS = 132096, LDS_END = LDS_WS + NW * 256;
#define SBAR() __builtin_amdgcn_sched_barrier(0)
__device__ __forceinline__ int crow(int r, int hi) { return (r & 3) + 8 * (r >> 2) + 4 * hi; }
typedef __attribute__((address_space(3))) const char* lds_cptr;
typedef short v4i16_t __attribute__((ext_vector_type(4)));
typedef float f32x2_t __attribute__((ext_vector_type(2))); typedef __bf16 bf16x2_t __attribute__((ext_vector_type(2)));
__device__ __forceinline__ unsigned cvtpk_s(float lo, float hi) { f32x2_t v = {lo, hi}; bf16x2_t b = __builtin_convertvector(v, bf16x2_t); return __builtin_bit_cast(unsigned, b); }
__device__ __forceinline__ s16x4 vtr(lds_cptr p) { return __builtin_bit_cast(s16x4, __builtin_amdgcn_ds_read_tr16_b64_v4i16((__attribute__((address_space(3))) v4i16_t*)p)); }
__device__ __forceinline__ void glds16s(const void* sbase, unsigned voff, unsigned lds_dst) { unsigned keep;
    asm volatile("s_mov_b32 %0, m0\n\ts_mov_b32 m0, %3\n\ts_nop 0\n\tglobal_load_lds_dwordx4 %1, %2\n\ts_mov_b32 m0, %0" : "=&s"(keep) : "v"(voff), "s"(sbase), "s"(lds_dst) : "memory"); }
#define WAIT_BAR(N) asm volatile("s_waitcnt vmcnt(" #N ") lgkmcnt(0)\n\ts_barrier" ::: "memory")
__device__ __forceinline__ void kload2(bf16x8* kf, lds_cptr kp, int j) { kf[2 * j] = *(const __attribute__((address_space(3))) bf16x8*)(kp + j * 2048); kf[2 * j + 1] = *(const __attribute__((address_space(3))) bf16x8*)(kp + j * 2048 + 512); }

__device__ __forceinline__ void attn_item(const bf16* PB, const unsigned char* KT, const unsigned char* VT, bf16* Y, const float* subg, const float* SC, const bool cx, int b, int h, int q0, char* shm, const int tid) {
    const int lane = tid & 63, r32 = lane & 31, hi = lane >> 5; const int wid = __builtin_amdgcn_readfirstlane(tid >> 6); const int wq = wid & 3, map = wid >> 2;
    const int rowq0 = (cx ? M + b * CL : b * L) + q0;
    const unsigned lds0 = (unsigned)(uintptr_t)shm;
    const unsigned koff = (unsigned)(wid * 1024 + lane * 16);
    const unsigned voff = (unsigned)(((wid >> 2) * 4 + (wid & 3)) * 1024 + lane * 16);
    const unsigned kdst = lds0 + LDS_K + wid * 1024, vdst = lds0 + LDS_V + ((wid >> 2) * 4 + (wid & 3)) * 1024;
    const char* ktb = (const char*)KT + (size_t)((b * 4 + h) * NTILE) * 16384; const char* vtb = (const char*)VT + (size_t)((b * 4 + h) * NTILE) * 16384;
#define DMA_K(t, slot) do { const char* tb_ = ktb + (size_t)(t) * 16384; const unsigned d_ = (unsigned)__builtin_amdgcn_readfirstlane(kdst + (slot)); glds16s(tb_, koff, d_); glds16s(tb_, koff + 8192u, d_ + 8192u); } while (0)
#define DMA_V(t, slot) do { const char* tb_ = vtb + (size_t)(t) * 16384; const unsigned d_ = (unsigned)__builtin_amdgcn_readfirstlane(vdst + (slot)); glds16s(tb_, voff, d_); glds16s(tb_, voff + 8192u, d_ + 8192u); } while (0)
    const lds_cptr shm3 = (lds_cptr)shm;
    const lds_cptr kp0 = shm3 + LDS_K + map * 8192 + hi * 1024 + r32 * 16;
    const lds_cptr vp0 = shm3 + LDS_V + ((lane >> 4) & 1) * 32 + (lane & 3) * 8 + (4 * hi + ((lane & 15) >> 2)) * 64;
    const int NT = cx ? CL / KVBLK : (CL + L) / KVBLK;
    DMA_K(0, 0); DMA_V(0, 0); DMA_K(1, KSLOT);
    bf16x8 qr[4];
    { const bf16* Qw = PB + (size_t)(rowq0 + wq * QBLK + r32) * IN_W + Q_OFF + h * 128 + map * 64 + hi * 8;
#pragma unroll
      for (int d0 = 0; d0 < 4; ++d0) qr[d0] = *reinterpret_cast<const bf16x8*>(Qw + d0 * 16); }
    float l_reg = 0.f; f32x16 o[4]; o[0] = f32x16{}; o[1] = f32x16{}; o[2] = f32x16{}; o[3] = f32x16{};
    const f32x16 zero = f32x16{};
    f32x16 pA0, pA1, pB0, pB1; bf16x8 kf[8];
    int s_m2 = 3 * KSLOT, s_m1 = 0, s_0 = KSLOT, s_p1 = 2 * KSLOT;
#define ROT4() do { const int x_ = s_m2; s_m2 = s_m1; s_m1 = s_0; s_0 = s_p1; s_p1 = x_; } while (0)
    DMA_K(2, 2 * KSLOT);
    WAIT_BAR(6);
    {
      const lds_cptr kb = kp0;
#pragma unroll
      for (int d0 = 0; d0 < 4; ++d0) { const bf16x8 b0 = *(const __attribute__((address_space(3))) bf16x8*)(kb + d0 * 2048), b1 = *(const __attribute__((address_space(3))) bf16x8*)(kb + d0 * 2048 + 512);
          if (d0 == 0) { pA0 = __builtin_amdgcn_mfma_f32_32x32x16_bf16(b0, qr[0], zero, 0, 0, 0); pA1 = __builtin_amdgcn_mfma_f32_32x32x16_bf16(b1, qr[0], zero, 0, 0, 0); }
          else { pA0 = __builtin_amdgcn_mfma_f32_32x32x16_bf16(b0, qr[d0], pA0, 0, 0, 0); pA1 = __builtin_amdgcn_mfma_f32_32x32x16_bf16(b1, qr[d0], pA1, 0, 0, 0); } }
#pragma unroll
      for (int r = 0; r < 16; ++r) { pA0[r] = __builtin_amdgcn_exp2f(pA0[r]); pA1[r] = __builtin_amdgcn_exp2f(pA1[r]); } }
    WAIT_BAR(0);
    DMA_K(3, 3 * KSLOT); DMA_V(1, VSLOT);
    WAIT_BAR(4);
    s16x4 vlo[8], vhi[8]; u32x4 pw0, pw1, pw2, pw3;
#define PATH_ENTRY() int ln_; asm volatile("v_mbcnt_lo_u32_b32 %0, -1, 0\n\tv_mbcnt_hi_u32_b32 %0, -1, %0" : "=v"(ln_)); \
    const unsigned koff = (unsigned)(wid * 1024 + ln_ * 16); \
    const unsigned voff = (unsigned)(((wid >> 2) * 4 + (wid & 3)) * 1024 + ln_ * 16); \
    kload2(kf, kp0 + s_0, 0); kload2(kf, kp0 + s_0, 1); kload2(kf, kp0 + s_0, 2); kload2(kf, kp0 + s_0, 3);
#define PKW(P, B) cvtpk_s(P[B], P[B + 1])
#define PAF(k) __builtin_bit_cast(bf16x8, pw##k)
#define VFR(i) (bf16x8){vlo[i][0], vlo[i][1], vlo[i][2], vlo[i][3], vhi[i][0], vhi[i][1], vhi[i][2], vhi[i][3]}
#define PIN(x) asm volatile("" : "+v"(x))
#define EX(v) __builtin_amdgcn_exp2f(v)
#define VRD(s, d0, ks) do { vlo[s] = vtr(vp_ + ((d0) * 4096 + (ks) * 1024)); vhi[s] = vtr(vp_ + ((d0) * 4096 + (ks) * 1024 + 512)); } while (0)
#define GAPA(MF, A0, A1, A2, A3, W0, W1, PW) do { MF; W0; W1; PIN(PW); SBAR(); } while (0)
#define GAPB(MF, X, B, S) do { MF; X[B] = EX(X[B]); X[B + 1] = EX(X[B + 1]); PIN(X); sacc += S[B]; sacc += S[B + 1]; PIN(sacc); SBAR(); } while (0)
#define KRD(G, KS, j) do { if (G) { kload2(kf, kp0 + (KS), j); SBAR(); } } while (0)
#define MF32(a, b, c) __builtin_amdgcn_mfma_f32_32x32x16_bf16(a, b, c, 0, 0, 0)
#define PHASE_A(C0, C1, P0, P1, VS) do { SBAR(); \
    const lds_cptr vp_ = vp0 + (VS); \
    VRD(0, 0, 0); SBAR(); \
    GAPA(C0 = MF32(kf[0], qr[0], zero), P0[2], P0[3], P0[4], P0[5],     pw0[0] = PKW(P0, 0),  pw0[1] = PKW(P0, 2),  pw0); \
    VRD(1, 1, 0); SBAR(); GAPA(C1 = MF32(kf[1], qr[0], zero), P0[6], P0[7], P0[8], P0[9],     pw0[2] = PKW(P0, 4),  pw0[3] = PKW(P0, 6),  pw0); \
    VRD(2, 2, 0); SBAR(); GAPA(C0 = MF32(kf[2], qr[1], C0),   P0[10], P0[11], P0[12], P0[13], pw1[0] = PKW(P0, 8),  pw1[1] = PKW(P0, 10), pw1); \
    VRD(3, 3, 0); SBAR(); GAPA(C1 = MF32(kf[3], qr[1], C1),   P0[14], P0[15], P1[0], P1[1],   pw1[2] = PKW(P0, 12), pw1[3] = PKW(P0, 14), pw1); \
    VRD(4, 0, 1); SBAR(); GAPA(C0 = MF32(kf[4], qr[2], C0),   P1[2], P1[3], P1[4], P1[5],     pw2[0] = PKW(P1, 0),  pw2[1] = PKW(P1, 2),  pw2); \
    VRD(5, 1, 1); SBAR(); GAPA(C1 = MF32(kf[5], qr[2], C1),   P1[6], P1[7], P1[8], P1[9],     pw2[2] = PKW(P1, 4),  pw2[3] = PKW(P1, 6),  pw2); \
    VRD(6, 2, 1); SBAR(); GAPA(C0 = MF32(kf[6], qr[3], C0),   P1[10], P1[11], P1[12], P1[13], pw3[0] = PKW(P1, 8),  pw3[1] = PKW(P1, 10), pw3); \
    VRD(7, 3, 1); SBAR(); GAPA(C1 = MF32(kf[7], qr[3], C1),   P1[14], P1[15], 0.f, 0.f,       pw3[2] = PKW(P1, 12), pw3[3] = PKW(P1, 14), pw3); \
    SBAR(); } while (0)
#define PHASE_B(X0, X1, S0, S1, VS, KS, GL) do { SBAR(); \
    const lds_cptr vp_ = vp0 + (VS); float sacc = 0.f; \
    GAPB(o[0] = MF32(PAF(0), VFR(0), o[0]), X0, 0, S0);  VRD(0, 0, 2); SBAR(); \
    GAPB(o[1] = MF32(PAF(0), VFR(1), o[1]), X0, 2, S0);  VRD(1, 1, 2); SBAR(); \
    GAPB(o[2] = MF32(PAF(0), VFR(2), o[2]), X0, 4, S0);  VRD(2, 2, 2); SBAR(); \
    GAPB(o[3] = MF32(PAF(0), VFR(3), o[3]), X0, 6, S0);  VRD(3, 3, 2); SBAR(); KRD(GL, KS, 0); \
    GAPB(o[0] = MF32(PAF(1), VFR(4), o[0]), X0, 8, S0);  VRD(4, 0, 3); SBAR(); KRD(GL, KS, 1); \
    GAPB(o[1] = MF32(PAF(1), VFR(5), o[1]), X0, 10, S0); VRD(5, 1, 3); SBAR(); KRD(GL, KS, 2); \
    GAPB(o[2] = MF32(PAF(1), VFR(6), o[2]), X0, 12, S0); VRD(6, 2, 3); SBAR(); KRD(GL, KS, 3); \
    GAPB(o[3] = MF32(PAF(1), VFR(7), o[3]), X0, 14, S0); VRD(7, 3, 3); SBAR(); \
    GAPB(o[0] = MF32(PAF(2), VFR(0), o[0]), X1, 0, S1); \
    GAPB(o[1] = MF32(PAF(2), VFR(1), o[1]), X1, 2, S1); \
    GAPB(o[2] = MF32(PAF(2), VFR(2), o[2]), X1, 4, S1); \
    GAPB(o[3] = MF32(PAF(2), VFR(3), o[3]), X1, 6, S1); \
    GAPB(o[0] = MF32(PAF(3), VFR(4), o[0]), X1, 8, S1); \
    GAPB(o[1] = MF32(PAF(3), VFR(5), o[1]), X1, 10, S1); \
    GAPB(o[2] = MF32(PAF(3), VFR(6), o[2]), X1, 12, S1); \
    GAPB(o[3] = MF32(PAF(3), VFR(7), o[3]), X1, 14, S1); \
    l_reg += sacc; } while (0)
#define DMA_T(t) do { if ((t) + 3 < NT) { DMA_K((t) + 3, s_m1); } if ((t) + 1 < NT) { DMA_V((t) + 1, s_p1); } } while (0)
#define ENDW(tt) do { if ((tt) + 3 < NT) { WAIT_BAR(4); } else if ((tt) + 1 < NT) { WAIT_BAR(2); } else { WAIT_BAR(0); } } while (0)
#define DMA_F(t) do { DMA_K((t) + 3, s_m1); DMA_V((t) + 1, s_p1); } while (0)
    if (map == 0) {
        __builtin_amdgcn_s_setprio(1);
        PATH_ENTRY();
        int t = 1;
#pragma clang loop unroll(disable)
        for (; t + 5 < NT; t += 2) {
            PHASE_A(pB0, pB1, pA0, pA1, s_m1); DMA_F(t);     PHASE_B(pB0, pB1, pA0, pA1, s_m1, s_p1, true); WAIT_BAR(4); ROT4();
            PHASE_A(pA0, pA1, pB0, pB1, s_m1); DMA_F(t + 1); PHASE_B(pA0, pA1, pB0, pB1, s_m1, s_p1, true); WAIT_BAR(4); ROT4();
        }
#pragma clang loop unroll(disable)
        for (; t + 1 < NT; t += 2) {
            PHASE_A(pB0, pB1, pA0, pA1, s_m1); DMA_T(t);     PHASE_B(pB0, pB1, pA0, pA1, s_m1, s_p1, true); ENDW(t);     ROT4();
            PHASE_A(pA0, pA1, pB0, pB1, s_m1); DMA_T(t + 1); PHASE_B(pA0, pA1, pB0, pB1, s_m1, s_p1, true); ENDW(t + 1); ROT4();
        }
        PHASE_A(pB0, pB1, pA0, pA1, s_m1); PHASE_B(pB0, pB1, pA0, pA1, s_m1, s_p1, false); WAIT_BAR(0);
        __builtin_amdgcn_s_setprio(0);
    } else {
        PATH_ENTRY();
        DMA_T(1); PHASE_A(pB0, pB1, pA0, pA1, s_m1); ENDW(1); ROT4();
        int t = 2;
#pragma clang loop unroll(disable)
        for (; t + 5 < NT; t += 2) {
            PHASE_B(pB0, pB1, pA0, pA1, s_m2, s_0, true); DMA_F(t);     PHASE_A(pA0, pA1, pB0, pB1, s_m1); WAIT_BAR(4); ROT4();
            PHASE_B(pA0, pA1, pB0, pB1, s_m2, s_0, true); DMA_F(t + 1); PHASE_A(pB0, pB1, pA0, pA1, s_m1); WAIT_BAR(4); ROT4();
        }
#pragma clang loop unroll(disable)
        for (; t + 1 < NT; t += 2) {
            PHASE_B(pB0, pB1, pA0, pA1, s_m2, s_0, true); DMA_T(t);     PHASE_A(pA0, pA1, pB0, pB1, s_m1); ENDW(t);     ROT4();
            PHASE_B(pA0, pA1, pB0, pB1, s_m2, s_0, true); DMA_T(t + 1); PHASE_A(pB0, pB1, pA0, pA1, s_m1); ENDW(t + 1); ROT4();
        }
        PHASE_B(pB0, pB1, pA0, pA1, s_m2, s_0, false);
        s_0 = s_m1;
    }
#undef DMA_F
#undef PATH_ENTRY
    WAIT_BAR(0);
    { float sacc = pB0[0] + pB0[1];
#pragma unroll
      for (int r = 2; r < 16; ++r) sacc += pB0[r];
#pragma unroll
      for (int r = 0; r < 16; ++r) sacc += pB1[r];
      l_reg += sacc;
      pw0 = (u32x4){PKW(pB0, 0), PKW(pB0, 2), PKW(pB0, 4), PKW(pB0, 6)}; pw1 = (u32x4){PKW(pB0, 8), PKW(pB0, 10), PKW(pB0, 12), PKW(pB0, 14)};
      pw2 = (u32x4){PKW(pB1, 0), PKW(pB1, 2), PKW(pB1, 4), PKW(pB1, 6)}; pw3 = (u32x4){PKW(pB1, 8), PKW(pB1, 10), PKW(pB1, 12), PKW(pB1, 14)};
      SBAR();
      const lds_cptr vp_ = vp0 + s_0;
#pragma unroll
      for (int d0 = 0; d0 < 4; ++d0) {
          VRD(0, d0, 0); VRD(1, d0, 1); VRD(2, d0, 2); VRD(3, d0, 3);
          o[d0] = MF32(PAF(0), VFR(0), o[d0]); o[d0] = MF32(PAF(1), VFR(1), o[d0]); o[d0] = MF32(PAF(2), VFR(2), o[d0]); o[d0] = MF32(PAF(3), VFR(3), o[d0]); } }
#undef PKW
#undef PAF
#undef VFR
#undef PIN
#undef EX
#undef VRD
#undef GAPA
#undef GAPB
#undef KRD
#undef MF32
#undef PHASE_A
#undef PHASE_B
#undef DMA_T
#undef ENDW
#undef ROT4
#undef DMA_K
#undef DMA_V
    int tid2; asm volatile("v_mbcnt_lo_u32_b32 %0, -1, 0\n\tv_mbcnt_hi_u32_b32 %0, -1, %0" : "=v"(tid2)); tid2 += wid * 64;
    { const int wid = tid2 >> 6, lane = tid2 & 63, r32 = lane & 31, hi = lane >> 5, wq = wid & 3, map = wid >> 2;
    float* li_l = (float*)(shm + LDS_WS) + wid * 64;
    const float* SC2 = SC; asm volatile("" : "+s"(SC2));
    const float lam = SC2[0], lam_init = SC2[2];
    const size_t rowb = (size_t)((cx ? M + b * CL : b * L) + q0 + wq * QBLK);
    const int rsel = map * 16;
    u32x4 gt[4];
    { const bf16* gp = PB + (rowb + rsel + (lane >> 4)) * IN_W + G_OFF + 512 + h * 128 + (lane & 15) * 8;
#pragma unroll
      for (int i = 0; i < 4; ++i) gt[i] = *(const u32x4*)(gp + (size_t)(4 * i) * IN_W); }
    l_reg = half_swap_sum(l_reg);
    if (hi == 0) li_l[r32] = l_reg;
    asm volatile("s_waitcnt lgkmcnt(0)" ::: "memory");
    float own[4][8], giv[4][8];
#pragma unroll
    for (int rr = 0; rr < 8; ++rr) {
        const float rl0 = __builtin_amdgcn_rcpf(li_l[crow(rr, hi)]), rl1 = __builtin_amdgcn_rcpf(li_l[crow(rr + 8, hi)]);
#pragma unroll
        for (int d0 = 0; d0 < 4; ++d0) { const float lo = o[d0][rr] * rl0, hv = o[d0][rr + 8] * rl1; own[d0][rr] = map ? hv : lo; giv[d0][rr] = map ? lo : hv; } }
    __syncthreads();
    float* X = (float*)shm + wq * 4096;
    bf16* GY = (bf16*)(shm + LDS_V) + wq * 4096;
    const int orow = 16 - rsel;
#pragma unroll
    for (int rr = 0; rr < 8; ++rr)
#pragma unroll
        for (int d0 = 0; d0 < 4; ++d0) X[(orow + crow(rr, hi)) * 128 + d0 * 32 + r32] = giv[d0][rr];
#pragma unroll
    for (int i = 0; i < 4; ++i) *(u32x4*)(GY + (rsel + (lane >> 4) + 4 * i) * 128 + (lane & 15) * 8) = gt[i];
    __syncthreads();
    {
        const float oml = 1.f - lam_init;
        const float c_own = map ? -lam : 1.f, c_oth = map ? 1.f : -lam;
        float sg[4];
#pragma unroll
        for (int d0 = 0; d0 < 4; ++d0) sg[d0] = subg[d0 * 32 + r32] * oml;
#pragma unroll
        for (int rr = 0; rr < 8; ++rr) {
            const int qrow = rsel + crow(rr, hi);
            float v[4], ss = 0.f;
#pragma unroll
            for (int d0 = 0; d0 < 4; ++d0) { v[d0] = c_own * own[d0][rr] + c_oth * X[qrow * 128 + d0 * 32 + r32]; ss += v[d0] * v[d0]; }
            ss = sum32(ss);
            const float rs = __builtin_amdgcn_rsqf(ss * (1.f / 128.f) + EPS);
            bf16* gy = GY + qrow * 128 + r32;
#pragma unroll
            for (int d0 = 0; d0 < 4; ++d0) gy[d0 * 32] = (bf16)f2bf(v[d0] * rs * sg[d0] * silu_f(bf2f(gy[d0 * 32])));
        }
        asm volatile("s_waitcnt lgkmcnt(0)" ::: "memory");
        bf16* yp = Y + (rowb + rsel + (lane >> 4)) * 1024 + 512 + h * 128 + (lane & 15) * 8;
#pragma unroll
        for (int i = 0; i < 4; ++i) st_wt16(yp + (size_t)(4 * i) * 1024, *(const u32x4*)(GY + (rsel + (lane >> 4) + 4 * i) * 128 + (lane & 15) * 8));
    }
    }
    __syncthreads();
}
#undef SBAR
#undef WAIT_BAR
}

constexpr int NWAVES = 8;
constexpr int RING_OFF = 0, RING_BYTES = 131072;
constexpr int LDSCTL_OFF = RING_BYTES, MISC_OFF = LDSCTL_OFF + 320;
constexpr int LDS_BYTES = 147456;
constexpr int CW_BAR = 1024;
constexpr int CW_FFT = 8192;
constexpr int CW_SEAM = 4608;
#define SEAM_HCNT(i) (CW_SEAM + 16 * (i))
#define SEAM_CCNT    (CW_SEAM + 16 * 64)
#define SEAM_MODCNT  (CW_SEAM + 16 * 130)
#define SEAM_PREPCNT (CW_SEAM + 16 * 131)
constexpr int CW_Q = 8192 + 1024;
constexpr int CW_YCNT = 10240;
#define SEAM_YCNT(l, blk) (CW_YCNT + 16 * (66 * (l) + (blk)))
#define SEAM_XCNT(i) (CW_YCNT + 16 * (132 + (i)))
#define SEAM_CXCNT   (CW_YCNT + 16 * 196)
#define SEAM_MIXDONE (CW_YCNT + 16 * 197)
#define SEAM_NQ      (CW_YCNT + 16 * 198)

typedef GAS unsigned gu32;
#define RLX_AGENT __ATOMIC_RELAXED, __HIP_MEMORY_SCOPE_AGENT
#define LDS_WAIT() asm volatile("s_waitcnt lgkmcnt(0)" ::: "memory")
#define VM_WAIT() asm volatile("s_waitcnt vmcnt(0)" ::: "memory")

#define XB_TMO      128
#define XB_XCNT(j)  (256  + 64 * (j))
#define XB_XSUB(j)  (1280 + 64 * (j))
#define XB_XGEN(j)  (2304 + 64 * (j))
#define XB_TOP      3328
#define XB_TOPGEN   3392
#define XCD_BAR_WORDS 3456
#define XB_SPIN_CAP (1u << 18)
__device__ __forceinline__ unsigned xb_ld(unsigned* p)              { return __hip_atomic_load(p, __ATOMIC_RELAXED, __HIP_MEMORY_SCOPE_AGENT); }
__device__ __forceinline__ unsigned xb_add(unsigned* p, unsigned v) { return __hip_atomic_fetch_add(p, v, __ATOMIC_RELAXED, __HIP_MEMORY_SCOPE_AGENT); }
__device__ __forceinline__ unsigned xb_xcc_id() { return (unsigned)__builtin_amdgcn_s_getreg((3 << 11) | 20) & 0xFu; }
#define XB_SPIN(cond, bar) do { unsigned _sp = 0; while (cond) { __builtin_amdgcn_s_sleep(1); \
    if ((++_sp & 255u) == 0u) { if (xb_ld(&(bar)[XB_TMO])) break; if (_sp > XB_SPIN_CAP) { atomicAdd(&(bar)[XB_TMO], 1u); break; } } } } while (0)
struct XcdBarrier { unsigned* bar; unsigned x; volatile LAS unsigned* st; };
__device__ __forceinline__ XcdBarrier xcd_barrier_post(unsigned* bar, volatile LAS unsigned* st) {
    XcdBarrier b; b.bar = bar; b.x = xb_xcc_id(); b.st = st;
    if (threadIdx.x == 0) (void)xb_add(&bar[XB_XCNT(b.x)], 1u);
    return b;
}
__device__ __forceinline__ void xcd_barrier_complete(unsigned* bar, unsigned x, unsigned& nloc, unsigned& nx) {
    const unsigned G = gridDim.x * gridDim.y * gridDim.z;
    unsigned sum, cnt, mine, sp = 0u;
    for (;;) {
        sum = 0u; cnt = 0u; mine = 0u;
#pragma unroll 1
        for (unsigned j = 0; j < 16; ++j) { const unsigned c = xb_ld(&bar[XB_XCNT(j)]); sum += c; cnt += (c > 0u) ? 1u : 0u; mine = (j == x) ? c : mine; }
        if (sum == G) break;
        __builtin_amdgcn_s_sleep(1);
        if ((++sp & 255u) == 0u) { if (xb_ld(&bar[XB_TMO])) break; if (sp > XB_SPIN_CAP) { atomicAdd(&bar[XB_TMO], 1u); break; } }
    }
    nloc = mine > 0u ? mine : 1u; nx = cnt > 0u ? cnt : 1u;
}
__device__ __forceinline__ void xcd_barrier(const XcdBarrier& b) {
    asm volatile("s_waitcnt vmcnt(0)" ::: "memory");
    __syncthreads();
    if (threadIdx.x == 0) {
        unsigned* bar = b.bar;
        __builtin_amdgcn_s_waitcnt(0);
        unsigned nloc = b.st[0], nx = b.st[1];
        if (nloc == 0u) { xcd_barrier_complete(bar, b.x, nloc, nx); b.st[0] = nloc; b.st[1] = nx; }
        const unsigned old = xb_add(&bar[XB_XSUB(b.x)], 1u);
        const unsigned gen = old / nloc;
        if (old + 1u == (gen + 1u) * nloc) {
            __builtin_amdgcn_fence(__ATOMIC_RELEASE, "agent");
            asm volatile("s_waitcnt vmcnt(0)" ::: "memory");
            const unsigned og = xb_add(&bar[XB_TOP], 1u);
            const unsigned tg = og / nx;
            if (og + 1u == (tg + 1u) * nx) xb_add(&bar[XB_TOPGEN], 1u);
            else XB_SPIN(xb_ld(&bar[XB_TOPGEN]) == tg, bar);
            __builtin_amdgcn_fence(__ATOMIC_ACQUIRE, "agent");
            xb_add(&bar[XB_XGEN(b.x)], 1u);
            asm volatile("s_waitcnt vmcnt(0)" ::: "memory");
        } else {
            XB_SPIN(xb_ld(&bar[XB_XGEN(b.x)]) == gen, bar);
            __builtin_amdgcn_fence(__ATOMIC_ACQUIRE, "agent");
            asm volatile("s_waitcnt vmcnt(0)" ::: "memory");
        }
    }
    __syncthreads();
}

struct Args {
    const float* in[15]; float* out; unsigned char* ws; int ph_lo, ph_hi, skip, pad;
};

struct Frame {
    LAS unsigned char* lds;
    int tid, lane, wave, vcu, G;
};

__device__ __forceinline__ void p0_transpose_item(const float* W, int K, int N, bf16* WT, LAS float* scr, int item, int lane) {
    const int nblk = N / 32, kb = item / nblk, nb = item % nblk, k0 = 64 * kb, n0 = 32 * nb;
    float tv[32];
#pragma unroll
    for (int i = 0; i < 32; ++i) { const int kk = 2 * i + (lane >> 5); tv[i] = W[(size_t)(k0 + kk) * N + n0 + (lane & 31)]; }
#pragma unroll
    for (int i = 0; i < 32; ++i) { const int kk = 2 * i + (lane >> 5); scr[kk * 33 + (lane & 31)] = tv[i]; }
    LDS_WAIT(); asm volatile("" ::: "memory");
    const int c = lane & 7;
#pragma unroll
    for (int j = 0; j < 4; ++j) { const int n = (lane >> 3) + 8 * j; const LAS float* s = scr + (8 * c) * 33 + n;
        u32x4 o; o.x = pk2(s[0 * 33], s[1 * 33]); o.y = pk2(s[2 * 33], s[3 * 33]); o.z = pk2(s[4 * 33], s[5 * 33]); o.w = pk2(s[6 * 33], s[7 * 33]);
        st_wt16(WT + (size_t)(n0 + n) * K + k0 + 8 * c, o); }
    LDS_WAIT(); asm volatile("" ::: "memory");
}

__device__ __forceinline__ void phase_mod(Frame& F, const __attribute__((address_space(4))) Args* ap, unsigned char* ws) {
    const float* c = ap->in[1]; const float* c_ctx = ap->in[3]; const float* w_mod = ap->in[5]; const float* b_mod = ap->in[6]; const float* qk_norm_g = ap->in[11]; const float* lam_vecs = ap->in[12];
    float* MODP = (float*)(ws + WS_MOD); float* SC = (float*)(ws + WS_SC);
    LAS float* red = (LAS float*)F.lds;
    LAS float* scl = (LAS float*)(F.lds + 8192);
    if ((int)blockIdx.x * 2 < DEPTH * 48 * 4) {
#pragma unroll
        for (int i = 0; i < 6; ++i) { const int idx = F.tid + 512 * i, v = idx >> 10, k = idx & 1023; scl[idx] = silu_f(v == 2 ? c_ctx[k] : c[v * 1024 + k]); }
    }
    __syncthreads();
    const int half = F.wave >> 2, w4 = F.wave & 3;
    for (int t0 = blockIdx.x * 2; t0 < DEPTH * 48 * 4; t0 += 2 * F.G) {
        const int task = t0 + half;
        const int kq = task & 3, lc = task >> 2, l = lc / 48, chunk = lc % 48, j = chunk * 64 + F.lane;
        const float* W = w_mod + (size_t)l * 1024 * 3072 + j;
        float a0 = 0.f, a1 = 0.f, a2 = 0.f;
        const int k0 = kq * 256 + w4 * 64;
        float wv[64];
#pragma unroll
        for (int i = 0; i < 64; ++i) wv[i] = W[(size_t)(k0 + i) * 3072];
#pragma unroll
        for (int i = 0; i < 64; i += 4) {
            const f32x4 s0 = *(const LAS f32x4*)(scl + k0 + i), s1 = *(const LAS f32x4*)(scl + 1024 + k0 + i), s2 = *(const LAS f32x4*)(scl + 2048 + k0 + i);
            a0 += s0.x * wv[i] + s0.y * wv[i + 1] + s0.z * wv[i + 2] + s0.w * wv[i + 3];
            a1 += s1.x * wv[i] + s1.y * wv[i + 1] + s1.z * wv[i + 2] + s1.w * wv[i + 3];
            a2 += s2.x * wv[i] + s2.y * wv[i + 1] + s2.z * wv[i + 2] + s2.w * wv[i + 3]; }
        __syncthreads();
        red[(F.wave * 3 + 0) * 64 + F.lane] = a0; red[(F.wave * 3 + 1) * 64 + F.lane] = a1; red[(F.wave * 3 + 2) * 64 + F.lane] = a2;
        __syncthreads();
        { const int t = F.tid & 255;
          if (t < 192) { const int v = t >> 6, ln = t & 63; float s = 0.f;
#pragma unroll
            for (int w = 0; w < 4; ++w) s += red[((half * 4 + w) * 3 + v) * 64 + ln];
            const int jj = chunk * 64 + ln;
            __hip_atomic_store(MODP + kq * MODQ + (l * 3 + v) * 3072 + jj, s + (kq == 0 ? b_mod[l * 3072 + jj] : 0.f), __ATOMIC_RELAXED, __HIP_MEMORY_SCOPE_AGENT); } }
        asm volatile("s_waitcnt vmcnt(0)" ::: "memory");
        __syncthreads();
        if (F.tid == 0) (void)__hip_atomic_fetch_add((gu32*)(ws + WS_CTL) + SEAM_MODCNT, 2u, __ATOMIC_RELAXED, __HIP_MEMORY_SCOPE_AGENT);
    }
    __syncthreads();
    if (blockIdx.x == 0 && F.wave < DEPTH) {
        int l = F.wave; asm volatile("" : "+s"(l)); const int lane = F.lane; const float* lv = lam_vecs + l * 256;
        const float sa = wave_sum(lv[lane] * lv[64 + lane]), sb = wave_sum(lv[128 + lane] * lv[192 + lane]);
        const float lam_init = l == 0 ? 0.2f : 0.8f - 0.6f * 0.7408182206817179f;
        float gq = fabsf(qk_norm_g[l * 128 + lane]), gk = fabsf(qk_norm_g[l * 128 + 64 + lane]);
        gq = wave_max(gq); gk = wave_max(gk);
        if (lane == 0) { SC[l * 4 + 0] = expf(sa) - expf(sb) + lam_init; SC[l * 4 + 1] = 8.f * gq * gk; SC[l * 4 + 2] = lam_init; }
    }
}
__device__ __forceinline__ void phase_prep(Frame& F, const __attribute__((address_space(4))) Args* ap, unsigned char* ws) {
    const float* w_in = ap->in[7]; const float* w_fourier = ap->in[8]; const float* w_pool = ap->in[9]; const float* w_out = ap->in[14];
    float* ROPE = (float*)(ws + WS_ROPE); float* TW = (float*)(ws + WS_TW);
    bf16* WF = (bf16*)(ws + WS_WF); bf16* WP = (bf16*)(ws + WS_WP); bf16* WIN = (bf16*)(ws + WS_WIN); bf16* WOUT = (bf16*)(ws + WS_WOUT);
    {
        LAS float* scr = (LAS float*)(F.lds + F.wave * 12288);
        const int gw = F.vcu * NWAVES + F.wave, NGW = F.G * NWAVES;
        constexpr int I_IN = (D / 64) * (IN_W / 32), I_OUT = (D / 64) * (D / 32);
        constexpr int NITEMS = DEPTH * (I_IN + I_OUT);
        for (int it = gw; it < NITEMS; it += NGW) {
            int r = it;
            if (r < DEPTH * I_IN) { const int l = r / I_IN; p0_transpose_item(w_in + (size_t)l * D * IN_W, D, IN_W, WIN + (size_t)l * IN_W * D, scr, r % I_IN, F.lane); continue; }
            r -= DEPTH * I_IN;
            { const int l = r / I_OUT; p0_transpose_item(w_out + (size_t)l * D * D, D, D, WOUT + (size_t)l * D * D, scr, r % I_OUT, F.lane); }
        }
    }
    {
        const int gt = blockIdx.x * 512 + F.tid, NGT = F.G * 512;
        LAS float* cst = (LAS float*)(F.lds + 98304);
        __syncthreads();
        if (F.tid < 64) { float sv, cv; sincospif((float)F.tid / 32.f, &sv, &cv); cst[2 * F.tid] = cv; cst[2 * F.tid + 1] = sv; }
        __syncthreads();
        for (int i = gt; i < DEPTH * 4 * 64 * 128; i += NGT) {
            const int k = i & 127, n = (i >> 7) & 63, lg = i >> 13; const int cc = k >> 1; const int sn = k & 1;
            const float* wf = w_fourier + (size_t)lg * 64 * 64 + n;
            float s = 0.f;
#pragma unroll 16
            for (int m = 0; m < 64; ++m) s += cst[2 * ((cc * m) & 63) + sn] * wf[m * 64];
            WF[i] = (bf16)f2bf(s);
        }
        for (int i = gt; i < DEPTH * 4 * 64 * 64; i += NGT) { const int k = i & 63, n = (i >> 6) & 63, lg = i >> 12; WP[i] = (bf16)f2bf(w_pool[(size_t)lg * 4096 + k * 64 + n]); }
        for (int i = gt; i < 128 * 16; i += NGT) { const int pos = i >> 4, j = i & 15; const float inv = powf(10000.f, -(float)j / 16.f), ang = (float)pos * inv; __hip_atomic_store((unsigned long long*)(ROPE + 2 * i), (unsigned long long)__builtin_bit_cast(unsigned, cosf(ang)) | ((unsigned long long)__builtin_bit_cast(unsigned, sinf(ang)) << 32), __ATOMIC_RELAXED, __HIP_MEMORY_SCOPE_AGENT); }
        for (int i = gt; i < 8191; i += NGT) { const int half = 1 << (31 - __clz(i + 1)), pos = i + 1 - half; float sv, cv; sincospif(-(float)pos / (float)half, &sv, &cv); TW[2 * i] = cv; TW[2 * i + 1] = sv; }
    }
}

template <int NR, bool WT>
__device__ __forceinline__ void nm_rows(const float* x0, bf16* h0, const float* ng, const float* md, int lane) {
    f32x4 v[NR][4];
#pragma unroll
    for (int q = 0; q < NR; ++q) { const float* xr = x0 + (size_t)q * D + 4 * lane;
#pragma unroll
        for (int j = 0; j < 4; ++j) v[q][j] = *(const f32x4*)(xr + 256 * j); }
    f32x4 a[4], c[4];
#pragma unroll
    for (int j = 0; j < 4; ++j) { const int k = 4 * lane + 256 * j; a[j] = *(const f32x4*)(ng + k) * (mod4(md + 1024 + k) + 1.f); c[j] = mod4(md + k); }
    asm volatile("" ::: "memory");
#pragma unroll
    for (int q = 0; q < NR; ++q) {
        float s = 0.f;
#pragma unroll
        for (int j = 0; j < 4; ++j) s += (v[q][j].x * v[q][j].x + v[q][j].y * v[q][j].y) + (v[q][j].z * v[q][j].z + v[q][j].w * v[q][j].w);
        const float rstd = 1.0f / sqrtf(wave_sum(s) * (1.f / D) + EPS);
        unsigned long long* o8 = (unsigned long long*)(h0 + (size_t)q * D) + lane;
#pragma unroll
        for (int j = 0; j < 4; ++j) { const f32x4 y = v[q][j] * rstd * a[j] + c[j];
            const unsigned long long w = (unsigned long long)pk2(y.x, y.y) | ((unsigned long long)pk2(y.z, y.w) << 32);
            if (WT) __hip_atomic_store(o8 + 64 * j, w, __ATOMIC_RELAXED, __HIP_MEMORY_SCOPE_AGENT); else o8[64 * j] = w; } }
}
template <bool SEAM>
__device__ __forceinline__ void phase_normmod(Frame& F, const float* xin, const float* cin, const float* ng, const float* mod, bf16* H, gu32* ctl) {
    const int gw = F.vcu * NWAVES + F.wave, NGW = F.G * NWAVES;
    for (int blk = gw; blk < M / 8; blk += NGW) {
        const int r0 = blk * 8;
        nm_rows<8, SEAM>(xin + (size_t)r0 * D, H + (size_t)r0 * D, ng, mod + (r0 / L) * 3072, F.lane);
        if (SEAM) { asm volatile("s_waitcnt vmcnt(0)" ::: "memory"); if (F.lane == 0) (void)__hip_atomic_fetch_add(ctl + SEAM_HCNT(r0 >> 8), 1u, __ATOMIC_RELAXED, __HIP_MEMORY_SCOPE_AGENT); }
    }
    for (int r = M + gw; r < MT; r += NGW) {
        nm_rows<1, SEAM>(cin + (size_t)(r - M) * D, H + (size_t)r * D, ng, mod + 2 * 3072, F.lane);
        if (SEAM) { asm volatile("s_waitcnt vmcnt(0)" ::: "memory"); if (F.lane == 0) (void)__hip_atomic_fetch_add(ctl + SEAM_CCNT, 1u, __ATOMIC_RELAXED, __HIP_MEMORY_SCOPE_AGENT); }
    }
}
__device__ __forceinline__ void seam_wait_ge(gu32* cnt, unsigned want);
__device__ __forceinline__ void phase_normmod_jobs(Frame& F, volatile LAS unsigned* MISC, const float* x1, const float* c1, const float* ng, const float* mod, bf16* H, gu32* ctl_seam, gu32* ctlbase) {
#pragma unroll 1
    for (;;) {
        if (F.tid == 0) MISC[46] = __hip_atomic_fetch_add(ctlbase + SEAM_NQ, 1u, __ATOMIC_RELAXED, __HIP_MEMORY_SCOPE_AGENT);
        __syncthreads();
        const int j = __builtin_amdgcn_readfirstlane((int)MISC[46]);
        __syncthreads();
        if (j >= 256 + 8) break;
        if (F.tid == 0) { if (j < 256) seam_wait_ge(ctlbase + SEAM_XCNT(j >> 2), 4u); else seam_wait_ge(ctlbase + SEAM_CXCNT, 256u); }
        asm volatile("" ::: "memory");
        __syncthreads();
        const bool lat = j < 256; const int r0 = 64 * (lat ? j : j - 256) + 8 * F.wave;
        const float* xs = (lat ? x1 : c1) + (size_t)r0 * D; bf16* hs = H + (size_t)(lat ? r0 : M + r0) * D;
        const float* md = mod + (lat ? r0 / L : 2) * 3072; gu32* cnt = ctl_seam + (lat ? SEAM_HCNT(r0 >> 8) : SEAM_CCNT);
        nm_rows<8, true>(xs, hs, ng, md, F.lane);
        asm volatile("s_waitcnt vmcnt(0)" ::: "memory"); if (F.lane == 0) (void)__hip_atomic_fetch_add(cnt, lat ? 1u : 8u, __ATOMIC_RELAXED, __HIP_MEMORY_SCOPE_AGENT);
    }
}
__device__ __forceinline__ void seam_wait_ge(gu32* cnt, unsigned want) { unsigned sp = 0; while (__hip_atomic_load(cnt, __ATOMIC_RELAXED, __HIP_MEMORY_SCOPE_AGENT) < want) { __builtin_amdgcn_s_sleep(8); if (++sp > (1u << 20)) break; } }

__device__ __forceinline__ void phase_qkprep(Frame& F, bf16* PB, const float* qkg, const float* ROPE, int nrows) {
    const int gw = F.vcu * NWAVES + F.wave, NGW = F.G * NWAVES;
    const int g8 = F.lane & 7;
    for (int r = gw; r < nrows; r += NGW) {
        const bool isc = r >= M; const int t = r & (L - 1), pr = t >> 6, pc = t & 63;
#pragma unroll
        for (int part = 0; part < 2; ++part) {
            bf16* p = PB + (size_t)r * IN_W + (part ? K_OFF : Q_OFF) + F.lane * 8;
            const u32x4 w = *(const u32x4*)p;
            float x[8] = {bflo(w.x), bfhi(w.x), bflo(w.y), bfhi(w.y), bflo(w.z), bfhi(w.z), bflo(w.w), bfhi(w.w)};
            float ss = 0.f;
#pragma unroll
            for (int e = 0; e < 8; ++e) ss += x[e] * x[e];
            ss += sxor<1>(ss); ss += sxor<2>(ss); ss += sxor<4>(ss);
            const float rs = 1.0f / sqrtf(ss * (1.f / 64.f) + EPS);
            const f32x4 ga = *(const f32x4*)(qkg + part * 64 + g8 * 8), gb = *(const f32x4*)(qkg + part * 64 + g8 * 8 + 4);
            const float gg[8] = {ga.x, ga.y, ga.z, ga.w, gb.x, gb.y, gb.z, gb.w};
            float y[8];
#pragma unroll
            for (int e = 0; e < 8; ++e) y[e] = x[e] * rs * gg[e];
            if (!isc) {
                const int ax = g8 >> 2, ph = (g8 >> 1) & 1, jb = 8 * (g8 & 1);
                const float* rp = ROPE + ((ax ? pc : pr) * 16 + jb) * 2;
                const f32x4 c0 = *(const f32x4*)(rp), c1 = *(const f32x4*)(rp + 4), c2 = *(const f32x4*)(rp + 8), c3 = *(const f32x4*)(rp + 12);
                const float cs[8] = {c0.x, c0.z, c1.x, c1.z, c2.x, c2.z, c3.x, c3.z}, sn[8] = {c0.y, c0.w, c1.y, c1.w, c2.y, c2.w, c3.y, c3.w};
#pragma unroll
                for (int e = 0; e < 8; ++e) { const float other = sxor<2>(y[e]); y[e] = ph ? (y[e] * cs[e] + other * sn[e]) : (y[e] * cs[e] - other * sn[e]); }
            }
            if (part == 0) {
#pragma unroll
                for (int e = 0; e < 8; ++e) y[e] *= 0.125f * LOG2E;
            }
            u32x4 o; o.x = pk2(y[0], y[1]); o.y = pk2(y[2], y[3]); o.z = pk2(y[4], y[5]); o.w = pk2(y[6], y[7]);
            *(u32x4*)p = o;
        }
    }
}

#define FSW(j) ((j) ^ (((j) >> 7) & 31))
__device__ __forceinline__ void fft13_item(Frame& F, const unsigned* at, u32x2* ut, const float* TW) {
    int tid = F.tid; asm volatile("" : "+v"(tid));
    typedef float f32x2v __attribute__((ext_vector_type(2)));
    LAS f32x2v* z = (LAS f32x2v*)F.lds;
    unsigned v[16]; f32x2v wp[3][2], wf[4];
#pragma unroll
    for (int k = 0; k < 16; ++k) v[k] = at[tid + 512 * k];
#pragma unroll
    for (int pi = 0; pi < 3; ++pi) { const int h = 8 << (3 * pi);
#pragma unroll
        for (int q = 0; q < 2; ++q) wp[pi][q] = *(const f32x2v*)(TW + 2 * (4 * h - 1 + ((tid + 512 * q) & (h - 1)))); }
    asm volatile("" ::: "memory");
#define BF1(p, r)  do { const f32x2v t_ = x[r]; x[r] = x[p] - t_; x[p] = x[p] + t_; } while (0)
#define BFMI(p, r) do { const f32x2v t_ = {x[r].y, -x[r].x}; x[r] = x[p] - t_; x[p] = x[p] + t_; } while (0)
#define BFW1(p, r) do { const f32x2v t_ = {(x[r].x + x[r].y) * 0.70710678118654752f, (x[r].y - x[r].x) * 0.70710678118654752f}; x[r] = x[p] - t_; x[p] = x[p] + t_; } while (0)
#define BFW3(p, r) do { const f32x2v t_ = {(x[r].y - x[r].x) * 0.70710678118654752f, -(x[r].x + x[r].y) * 0.70710678118654752f}; x[r] = x[p] - t_; x[p] = x[p] + t_; } while (0)
#define CMUL(w, b) ((f32x2v){(w).x * (b).x - (w).y * (b).y, (w).x * (b).y + (w).y * (b).x})
#define BFLY(p, r, w) do { const f32x2v t_ = CMUL(w, x[r]); x[r] = x[p] - t_; x[p] = x[p] + t_; } while (0)
#pragma unroll
    for (int g = 0; g < 2; ++g) {
        f32x2v x[8];
#pragma unroll
        for (int j = 0; j < 8; ++j) { const int q = ((j & 1) << 2) | (j & 2) | (j >> 2); x[j] = (f32x2v){bflo(v[2 * q + g]), bfhi(v[2 * q + g])}; }
        BF1(0, 1); BF1(2, 3); BF1(4, 5); BF1(6, 7);
        BF1(0, 2); BF1(4, 6); BFMI(1, 3); BFMI(5, 7);
        BF1(0, 4); BFW1(1, 5); BFMI(2, 6); BFW3(3, 7);
        const int m8 = (int)(__brev((unsigned)(tid + 512 * g)) >> 22) << 3;
#pragma unroll
        for (int j = 0; j < 8; ++j) z[FSW(m8 + j)] = x[j];
    }
    __syncthreads();
#pragma unroll
    for (int pi = 0; pi < 3; ++pi) {
        const int s = 4 + 3 * pi, h = 1 << (s - 1);
        if (pi == 2) {
#pragma unroll
            for (int q = 0; q < 4; ++q) wf[q] = *(const f32x2v*)(TW + 2 * (4095 + tid + 512 * q)); }
#pragma unroll
        for (int q = 0; q < 2; ++q) { const int t = tid + 512 * q;
            const int pos = t & (h - 1), base = ((t >> (s - 1)) << (s + 2)) + pos;
            const f32x2v w3 = wp[pi][q];
            const f32x2v w2 = {w3.x * w3.x - w3.y * w3.y, (w3.x + w3.x) * w3.y};
            const f32x2v w1 = {w2.x * w2.x - w2.y * w2.y, (w2.x + w2.x) * w2.y};
            int e[8]; f32x2v x[8];
#pragma unroll
            for (int j = 0; j < 8; ++j) { e[j] = FSW(base + j * h); x[j] = z[e[j]]; }
            BFLY(0, 1, w1); BFLY(2, 3, w1); BFLY(4, 5, w1); BFLY(6, 7, w1);
            const f32x2v w2b = {w2.y, -w2.x};
            BFLY(0, 2, w2); BFLY(4, 6, w2); BFLY(1, 3, w2b); BFLY(5, 7, w2b);
            const float r2 = 0.70710678118654752f;
            const f32x2v w3a = {(w3.x + w3.y) * r2, (w3.y - w3.x) * r2}, w3b = {w3.y, -w3.x}, w3c = {(w3.y - w3.x) * r2, -(w3.x + w3.y) * r2};
            BFLY(0, 4, w3); BFLY(1, 5, w3a); BFLY(2, 6, w3b); BFLY(3, 7, w3c);
#pragma unroll
            for (int j = 0; j < 8; ++j) z[e[j]] = x[j]; }
        __syncthreads();
    }
#undef BF1
#undef BFMI
#undef BFW1
#undef BFW3
#undef BFLY
    const float sc = 0.5f / sqrtf(8192.f * 64.f);
#define UNPK(kk, za, zb) do { const float ar = ((za).x + (zb).x) * sc, ai = ((za).y - (zb).y) * sc, br = ((za).y + (zb).y) * sc, bi = ((zb).x - (za).x) * sc; \
        __hip_atomic_store((unsigned long long*)(ut + (kk)), (unsigned long long)pk2(ar, ai) | ((unsigned long long)pk2(br, bi) << 32), __ATOMIC_RELAXED, __HIP_MEMORY_SCOPE_AGENT); } while (0)
#pragma unroll
    for (int q = 0; q < 4; ++q) { const int p = tid + 512 * q;
        const int x2 = (4096 - p) & 4095;
        const f32x2v wv = wf[q];
        const f32x2v a1 = z[FSW(p)], b1 = z[FSW(p + 4096)], a2 = z[FSW(x2)], b2 = z[FSW(x2 + 4096)];
        const f32x2v t1 = CMUL(wv, b1);
        const f32x2v w2 = {-wv.x, wv.y};
        const f32x2v t2 = CMUL(w2, b2);
        const f32x2v ZA = a1 + t1, ZB = a1 - t1;
        if (p == 0) { UNPK(0, ZA, ZA); UNPK(4096, ZB, ZB); }
        else {
            const f32x2v ZC = a2 + t2, ZD = a2 - t2;
            UNPK(p, ZA, ZD); UNPK(p + 4096, ZB, ZC); UNPK(x2, ZC, ZB); UNPK(x2 + 4096, ZD, ZA);
        }
    }
    if (tid == 0) {
        const f32x2v a1 = z[FSW(2048)], b1 = z[FSW(6144)];
        const f32x2v t1 = {b1.y, -b1.x};
        const f32x2v ZA = a1 + t1, ZB = a1 - t1;
        UNPK(2048, ZA, ZB); UNPK(6144, ZB, ZA);
    }
#undef UNPK
#undef CMUL
    asm volatile("s_waitcnt vmcnt(0)" ::: "memory");
    __syncthreads();
}

__device__ __forceinline__ void fft_item(Frame& F, const unsigned* at, int logn, u32x2* ut, const float* TW) {
    const int n = 1 << logn, tid = F.tid;
    typedef float f32x2v __attribute__((ext_vector_type(2)));
    LAS f32x2v* z = (LAS f32x2v*)F.lds; LAS float* tw = (LAS float*)(z + 8192);
    for (int i = tid; i < n - 1; i += 512) { const float2 w = *(const float2*)(TW + 2 * i); tw[2 * i] = w.x; tw[2 * i + 1] = w.y; }
    for (int i = tid; i < n; i += 512) { const unsigned v = at[i]; const int j = FSW((int)(__brev((unsigned)i) >> (32 - logn))); z[j] = (f32x2v){bflo(v), bfhi(v)}; }
    __syncthreads();
    int s = 1;
    if (logn & 1) {
        for (int t = tid; t < n / 2; t += 512) { const int i0 = FSW(2 * t), i1 = FSW(2 * t + 1); const f32x2v u_ = z[i0], x_ = z[i1]; z[i0] = u_ + x_; z[i1] = u_ - x_; }
        __syncthreads(); s = 2;
    }
    for (; s <= logn; s += 2) {
        const int h = 1 << (s - 1);
        for (int t = tid; t < n / 4; t += 512) {
            const int pos = t & (h - 1), base = ((t >> (s - 1)) << (s + 1)) + pos;
            const float c1 = tw[2 * (h - 1 + pos)], s1 = tw[2 * (h - 1 + pos) + 1];
            const float c2 = tw[2 * (2 * h - 1 + pos)], s2 = tw[2 * (2 * h - 1 + pos) + 1];
            const int e0 = FSW(base), e1 = FSW(base + h), e2 = FSW(base + 2 * h), e3 = FSW(base + 3 * h);
            const f32x2v z0 = z[e0], z1 = z[e1], z2 = z[e2], z3 = z[e3];
            const float a0r = z0.x, a0i = z0.y, a1r = z1.x, a1i = z1.y, a2r = z2.x, a2i = z2.y, a3r = z3.x, a3i = z3.y;
            const float t1r = a1r * c1 - a1i * s1, t1i = a1r * s1 + a1i * c1, t3r = a3r * c1 - a3i * s1, t3i = a3r * s1 + a3i * c1;
            const float b0r = a0r + t1r, b0i = a0i + t1i, b1r = a0r - t1r, b1i = a0i - t1i, b2r = a2r + t3r, b2i = a2i + t3i, b3r = a2r - t3r, b3i = a2i - t3i;
            const float u2r = b2r * c2 - b2i * s2, u2i = b2r * s2 + b2i * c2;
            const float w3r = b3r * c2 - b3i * s2, w3i = b3r * s2 + b3i * c2;
            z[e0] = (f32x2v){b0r + u2r, b0i + u2i}; z[e2] = (f32x2v){b0r - u2r, b0i - u2i};
            z[e1] = (f32x2v){b1r + w3i, b1i - w3r}; z[e3] = (f32x2v){b1r - w3i, b1i + w3r};
        }
        __syncthreads();
    }
    const float sc = 0.5f / sqrtf((float)n * 64.f);
    for (int k = tid; k < n; k += 512) {
        const int k2 = (n - k) & (n - 1);
        const f32x2v za = z[FSW(k)], zb = z[FSW(k2)]; const float zr = za.x, zi = za.y, wr_ = zb.x, wi_ = zb.y;
        const float ar = (zr + wr_) * sc, ai = (zi - wi_) * sc, br = (zi + wi_) * sc, bi = (wr_ - zr) * sc;
        __hip_atomic_store((unsigned long long*)(ut + k), (unsigned long long)pk2(ar, ai) | ((unsigned long long)pk2(br, bi) << 32), __ATOMIC_RELAXED, __HIP_MEMORY_SCOPE_AGENT);
    }
    asm volatile("s_waitcnt vmcnt(0)" ::: "memory");
    __syncthreads();
}

template <int KG>
__device__ __forceinline__ void group_linear(const LAS bf16* At, int lda, const bf16* W, int g, int rh, int lane, f32x16& acc0, f32x16& acc1) {
    const int r32 = lane & 31, hi = lane >> 5;
    acc0 = f32x16{}; acc1 = f32x16{};
    const LAS bf16* ap = At + (rh * 32 + r32) * lda + g * KG + hi * 8;
    const bf16* wp = W + (size_t)g * 64 * KG + (size_t)r32 * KG + hi * 8;
#pragma unroll
    for (int ks = 0; ks < KG / 16; ++ks) {
        const bf16x8 af = *(const LAS bf16x8*)(ap + ks * 16);
        const bf16x8 b0 = *(const bf16x8*)(wp + ks * 16), b1 = *(const bf16x8*)(wp + 32 * KG + ks * 16);
        acc0 = __builtin_amdgcn_mfma_f32_32x32x16_bf16(af, b0, acc0, 0, 0, 0);
        acc1 = __builtin_amdgcn_mfma_f32_32x32x16_bf16(af, b1, acc1, 0, 0, 0);
    }
}

__device__ __forceinline__ void gated_store_tile(LAS float* X, const f32x16& a0, const f32x16& a1, const bf16* gate, int gstride, bf16* yout, const float* sc, int lane) {
    const int r32 = lane & 31, hi = lane >> 5, ch = lane & 7, rl = lane >> 3;
    u32x4 gt[4];
#pragma unroll
    for (int i = 0; i < 4; ++i) gt[i] = *(const u32x4*)(gate + (size_t)(rl + 8 * i) * gstride + ch * 8);
#pragma unroll
    for (int r = 0; r < 16; ++r) { const int row = att::crow(r, hi); X[row * 64 + r32] = a0[r]; X[row * 64 + 32 + r32] = a1[r]; }
    f32x4 sa = {1.f, 1.f, 1.f, 1.f}, sb = {1.f, 1.f, 1.f, 1.f};
    if (sc) { sa = *(const f32x4*)(sc + ch * 8); sb = *(const f32x4*)(sc + ch * 8 + 4); }
#pragma unroll
    for (int i = 0; i < 4; ++i) {
        const LAS float* xp = X + (rl + 8 * i) * 64 + ch * 8;
        const f32x4 xa = *(const LAS f32x4*)xp * sa, xb = *(const LAS f32x4*)(xp + 4) * sb;
        const u32x4 gq = gt[i];
        u32x4 w;
        w.x = pk2(xa[0] * silu_f(bflo(gq.x)), xa[1] * silu_f(bfhi(gq.x))); w.y = pk2(xa[2] * silu_f(bflo(gq.y)), xa[3] * silu_f(bfhi(gq.y)));
        w.z = pk2(xb[0] * silu_f(bflo(gq.z)), xb[1] * silu_f(bfhi(gq.z))); w.w = pk2(xb[2] * silu_f(bflo(gq.w)), xb[3] * silu_f(bfhi(gq.w)));
        st_wt16(yout + (size_t)(rl + 8 * i) * 1024 + ch * 8, w);
    }
}

template <int W>
__device__ __forceinline__ void pool_strip(const LAS unsigned* B2, LAS bf16* Ao, int tb, int Lr) {
    constexpr int LO = W / 2, HI = W - LO - 1, K0 = 8 - LO, NV = 16 + W - 1;
    unsigned v[NV];
#pragma unroll
    for (int k = 0; k < NV; ++k) v[k] = B2[(K0 + k) * 128];
    float s0 = 0.f, s1 = 0.f;
#pragma unroll
    for (int k = 0; k < W; ++k) { s0 += bflo(v[k]); s1 += bfhi(v[k]); }
#pragma unroll
    for (int i = 0; i < 16; ++i) { const int t = tb + i;
        const int a = max(t - LO, 0), e = min(t + HI, Lr - 1);
        const unsigned c = v[LO + i];
        const float inv = __builtin_amdgcn_rcpf((float)(e - a + 1));
        *(LAS unsigned*)(Ao + i * 264) = pk2(s0 * inv - bflo(c), s1 * inv - bfhi(c));
        if (i < 15) { s0 += bflo(v[i + W]) - bflo(v[i]); s1 += bfhi(v[i + W]) - bfhi(v[i]); } }
}
__device__ __forceinline__ unsigned pool_item(Frame& F, const bf16* PB, bf16* Y, int rb, int Lr, int t0, const bf16* WPl, const float* pscale, gu32* tkq, gu32* pub) {
    LAS bf16* Braw = (LAS bf16*)F.lds;
    LAS bf16* At = (LAS bf16*)(F.lds + 40960);
    const int tid = F.tid;
    for (int i = tid; i < 80 * 32; i += 512) { const int rr = i >> 5, ch = i & 31; const int t = t0 - 8 + rr;
        u32x4 v = {0u, 0u, 0u, 0u}; if (t >= 0 && t < Lr) v = *(const u32x4*)(PB + (size_t)(rb + t) * IN_W + B_OFF + ch * 8);
        *(LAS u32x4*)(Braw + rr * 256 + ch * 8) = v; }
    asm volatile("s_waitcnt vmcnt(0)" ::: "memory");
    __syncthreads();
    if (pub && F.tid == 0) (void)__hip_atomic_fetch_add(pub, 1u, __ATOMIC_RELAXED, __HIP_MEMORY_SCOPE_AGENT);
    {
      const int cp = (F.wave >> 1) * 32 + (F.lane & 31), rq = (F.wave & 1) * 2 + (F.lane >> 5), col = 2 * cp;
      const LAS unsigned* B2 = (const LAS unsigned*)Braw + cp + (rq * 16) * 128;
      LAS bf16* Ao = At + (rq * 16) * 264 + col;
      const int tb = t0 + rq * 16;
      switch (F.wave >> 1) {
        case 0: pool_strip<2>(B2, Ao, tb, Lr); break;
        case 1: pool_strip<4>(B2, Ao, tb, Lr); break;
        case 2: pool_strip<8>(B2, Ao, tb, Lr); break;
        default: pool_strip<16>(B2, Ao, tb, Lr); break;
      } }
    __syncthreads();
    const int g = F.wave >> 1, rh = F.wave & 1, r32 = F.lane & 31, hi = F.lane >> 5;
    f32x16 a0, a1; group_linear<64>(At, 264, WPl, g, rh, F.lane, a0, a1);
    (void)r32; (void)hi;
    __syncthreads();
    unsigned nxt_ = 0u; if (F.tid == 0) nxt_ = __hip_atomic_fetch_add(tkq, 1u, __ATOMIC_RELAXED, __HIP_MEMORY_SCOPE_AGENT);
    { const size_t r0 = (size_t)(rb + t0 + rh * 32);
      gated_store_tile((LAS float*)F.lds + F.wave * 2048, a0, a1, PB + r0 * IN_W + G_OFF + 256 + g * 64, IN_W, Y + r0 * 1024 + 256 + g * 64, pscale + g * 64, F.lane); }
    __syncthreads();
    return nxt_;
}

__device__ __forceinline__ unsigned flin_item(Frame& F, const bf16* PB, const bf16* U, bf16* Y, int row0, const bf16* WFl, gu32* tkq, gu32* pub) {
    LAS bf16* At = (LAS bf16*)F.lds;
    const int tid = F.tid;
    {
      const bool cxs = row0 >= M; const int rr0 = cxs ? row0 - M : row0;
      const int bseg = cxs ? (rr0 >> 8) : (rr0 >> 13), k0 = cxs ? (rr0 & 255) : (rr0 & (L - 1)), nseg = cxs ? CL : L;
      const int p = tid >> 2, q = tid & 3;
      const u32x2* up = (const u32x2*)U + (cxs ? AT_CTX : 0) + ((size_t)(bseg * 128 + p)) * nseg + k0 + q * 16;
      u32x4 v[8];
#pragma unroll
      for (int i = 0; i < 8; ++i) v[i] = *(const u32x4*)(up + 2 * i);
#pragma unroll
      for (int i = 0; i < 8; ++i) { *(LAS u32x2*)(At + (q * 16 + 2 * i) * 520 + p * 4) = (u32x2){v[i].x, v[i].y}; *(LAS u32x2*)(At + (q * 16 + 2 * i + 1) * 520 + p * 4) = (u32x2){v[i].z, v[i].w}; } }
    asm volatile("s_waitcnt vmcnt(0)" ::: "memory");
    __syncthreads();
    if (pub && F.tid == 0) (void)__hip_atomic_fetch_add(pub, 1u, __ATOMIC_RELAXED, __HIP_MEMORY_SCOPE_AGENT);
    const int g = F.wave >> 1, rh = F.wave & 1, r32 = F.lane & 31, hi = F.lane >> 5;
    f32x16 a0, a1; group_linear<128>(At, 520, WFl, g, rh, F.lane, a0, a1);
    (void)r32; (void)hi;
    __syncthreads();
    unsigned nxt_ = 0u; if (F.tid == 0) nxt_ = __hip_atomic_fetch_add(tkq, 1u, __ATOMIC_RELAXED, __HIP_MEMORY_SCOPE_AGENT);
    { const size_t r0 = (size_t)(row0 + rh * 32);
      gated_store_tile((LAS float*)F.lds + F.wave * 2048, a0, a1, PB + r0 * IN_W + G_OFF + g * 64, IN_W, Y + r0 * 1024 + g * 64, nullptr, F.lane); }
    __syncthreads();
    return nxt_;
}


__device__ __forceinline__ void ctx_load(Frame& F, const bf16* A, const bf16* Bt, int rb, int cg, bf16x8 (&a)[8], bf16x8 (&b0)[8], bf16x8 (&b1)[8]) {
    const int lane = F.lane, r32 = lane & 31, hi = lane >> 5, k0 = F.wave * 128;
    const bf16* ap = A + (size_t)(rb * 32 + r32) * D + k0 + hi * 8;
    const bf16* bp = Bt + (size_t)(cg * 64 + r32) * D + k0 + hi * 8;
#pragma unroll
    for (int ks = 0; ks < 8; ++ks) { a[ks] = *(const bf16x8*)(ap + ks * 16); b0[ks] = *(const bf16x8*)(bp + ks * 16); b1[ks] = *(const bf16x8*)(bp + 32 * D + ks * 16); }
}
__device__ __forceinline__ void ctx_mma(const bf16x8 (&a)[8], const bf16x8 (&b0)[8], const bf16x8 (&b1)[8], f32x16& c0, f32x16& c1) {
    c0 = f32x16{}; c1 = f32x16{};
#pragma unroll
    for (int ks = 0; ks < 8; ++ks) { c0 = __builtin_amdgcn_mfma_f32_32x32x16_bf16(a[ks], b0[ks], c0, 0, 0, 0); c1 = __builtin_amdgcn_mfma_f32_32x32x16_bf16(a[ks], b1[ks], c1, 0, 0, 0); }
}
template <int MODE>
__device__ __forceinline__ void ctx_tail(Frame& F, const f32x16& c0, const f32x16& c1, int rb, int cg, bf16* PBc, const float* qkg, const float* res, float* outp, const float* gate, unsigned char* KTp, unsigned char* VTp, unsigned* ATp);
template <int MODE>
__device__ __forceinline__ void ctx_tile(Frame& F, const bf16* A, const bf16* Bt, int rb, int cg, bf16* PBc, const float* qkg, const float* res, float* outp, const float* gate, unsigned char* KTp = nullptr, unsigned char* VTp = nullptr, unsigned* ATp = nullptr) {
    bf16x8 a[8], b0[8], b1[8];
    ctx_load(F, A, Bt, rb, cg, a, b0, b1);
    f32x16 c0, c1; ctx_mma(a, b0, b1, c0, c1);
    ctx_tail<MODE>(F, c0, c1, rb, cg, PBc, qkg, res, outp, gate, KTp, VTp, ATp);
}
template <int MODE>
__device__ __forceinline__ void ctx_tail(Frame& F, const f32x16& c0, const f32x16& c1, int rb, int cg, bf16* PBc, const float* qkg, const float* res, float* outp, const float* gate, unsigned char* KTp, unsigned char* VTp, unsigned* ATp) {
    const int lane = F.lane, r32 = lane & 31, hi = lane >> 5;
    LAS float* red = (LAS float*)F.lds + F.wave * 2048;
#pragma unroll
    for (int r = 0; r < 16; ++r) { const int row = att2::crow(r, hi); red[row * 64 + r32] = c0[r]; red[row * 64 + 32 + r32] = c1[r]; }
    __syncthreads();
    const int row = F.tid >> 4, c4 = (F.tid & 15) * 4;
    f32x4 v = {0.f, 0.f, 0.f, 0.f};
#pragma unroll
    for (int w = 0; w < 8; ++w) v += *(const LAS f32x4*)((LAS float*)F.lds + w * 2048 + row * 64 + c4);
    const int grow = rb * 32 + row;
    if (MODE == 0) {
        if (cg >= 8 && cg < 24) {
            const int part = cg >= 16 ? 1 : 0;
            float ss = (v[0] * v[0] + v[1] * v[1]) + (v[2] * v[2] + v[3] * v[3]);
            ss += dpp_f<0xB1>(ss); ss += dpp_f<0x4E>(ss); ss += dpp_f<0x141>(ss); ss += dpp_f<0x140>(ss);
            const float rs = __builtin_amdgcn_rsqf(ss * (1.f / 64.f) + EPS) * (part ? 1.f : 0.125f * LOG2E);
            const f32x4 g = *(const f32x4*)(qkg + part * 64 + c4);
            v = v * rs * g;
        }
        const u32x2 w2 = (u32x2){pk2(v[0], v[1]), pk2(v[2], v[3])};
        if (cg >= 16 && cg < 32) {
            const int bb = grow >> 8, kidx = grow & 255, g = (cg - 16) & 7, hh = g >> 1;
            const size_t blk = ((size_t)((bb * 4 + hh) * NTILE + (kidx >> 6))) * 16384; const int key = kidx & 63;
            if (cg < 24) *(u32x2*)(KTp + blk + (g & 1) * 8192 + (c4 >> 3) * 1024 + key * 16 + (c4 & 7) * 2) = w2;
            else { const int dv = (g & 1) * 64 + c4; *(u32x2*)(VTp + blk + (dv >> 5) * 4096 + key * 64 + (dv & 31) * 2) = w2; }
        } else if (cg < 4) {
            unsigned* ap = ATp + AT_CTX + ((size_t)((grow >> 8) * 128 + cg * 32 + (c4 >> 1))) * CL + (grow & 255);
            ap[0] = w2.x; ap[CL] = w2.y;
        } else *(u32x2*)(PBc + (size_t)grow * IN_W + cg * 64 + c4) = w2;
    } else {
        const size_t off = (size_t)grow * D + cg * 64 + c4;
        const f32x4 o4 = *(const f32x4*)(res + off) + mod4(gate + cg * 64 + c4) * v;
        st_wt16(outp + off, __builtin_bit_cast(u32x4, o4));
        asm volatile("s_waitcnt vmcnt(0)" ::: "memory");
    }
    __syncthreads();
}

__global__ void __launch_bounds__(NWAVES * 64, 2) mk_fwd(Args args) {
    extern __shared__ __attribute__((aligned(16))) unsigned char lds[];
    {
        LAS unsigned* z = (LAS unsigned*)((LAS unsigned char*)lds + LDSCTL_OFF);
        for (int u = threadIdx.x; u < (LDS_BYTES - LDSCTL_OFF) / 4; u += NWAVES * 64) z[u] = 0u;
    }
    __syncthreads();
    const int wave_id = __builtin_amdgcn_readfirstlane((int)threadIdx.x >> 6);
    volatile LAS unsigned* MISC = (volatile LAS unsigned*)((LAS unsigned char*)lds + MISC_OFF);
    const int lo = args.ph_lo, hi = args.ph_hi;
    XcdBarrier bar; bar.bar = (unsigned*)(args.ws + WS_CTL) + CW_BAR; bar.x = 0; bar.st = nullptr;
    if (hi - lo > 1) bar = xcd_barrier_post((unsigned*)(args.ws + WS_CTL) + CW_BAR, MISC + 8);

#pragma unroll 1
    for (int ph = lo; ph < hi; ++ph) {
        const int Gd = gridDim.x, vcu = (Gd % 8 == 0) ? ((int)blockIdx.x % 8) * (Gd / 8) + (int)blockIdx.x / 8 : (int)blockIdx.x;
#define MKFRAME(F) Frame F; { int ln_; asm volatile("v_mbcnt_lo_u32_b32 %0, -1, 0\n\tv_mbcnt_hi_u32_b32 %0, -1, %0" : "=v"(ln_)); F.lane = ln_; F.wave = wave_id; F.tid = wave_id * 64 + ln_; F.lds = (LAS unsigned char*)lds; { int g_ = Gd, v_ = vcu; asm volatile("" : "+s"(g_), "+s"(v_)); F.G = g_; F.vcu = v_; } }
        const __attribute__((address_space(4))) Args* ka = (const __attribute__((address_space(4))) Args*)__builtin_amdgcn_kernarg_segment_ptr(); asm volatile("" : "+s"(ka));
        unsigned char* ws = ka->ws; asm volatile("" : "+s"(ws));
        const int l = ph == 0 ? 0 : (ph - 1) / 5, kind = ph == 0 ? 0 : 1 + (ph - 1) % 5;
        const bool upd = l < DEPTH - 1;
        float* out = ka->out;
        const float* xin = l == 0 ? ka->in[0] : out;
        const float* cin = l == 0 ? ka->in[2] : (const float*)(ws + WS_CTX1);
        const float* mod = (const float*)(ws + WS_MOD) + l * 3 * 3072;
        bf16* PB = (bf16*)(ws + WS_PB); bf16* Y = (bf16*)(ws + WS_Y); bf16* U = (bf16*)(ws + WS_U);
        if (kind == 0) {
            MKFRAME(F);
            phase_mod(F, ka, ws);
            __syncthreads();
            phase_prep(F, ka, ws);
            asm volatile("s_waitcnt vmcnt(0)" ::: "memory");
            __syncthreads();
            if (F.tid == 0) (void)__hip_atomic_fetch_add((gu32*)(ws + WS_CTL) + SEAM_PREPCNT, 1u, __ATOMIC_RELAXED, __HIP_MEMORY_SCOPE_AGENT);
        } else if (kind == 1) {
            MKFRAME(F);
            if (l == 0) { if (F.tid == 0) seam_wait_ge((gu32*)(ws + WS_CTL) + SEAM_MODCNT, (unsigned)(DEPTH * 48 * 4)); asm volatile("" ::: "memory"); __syncthreads(); }
            if (l == 0) phase_normmod<true>(F, xin, cin, ka->in[4] + l * D, mod, (bf16*)(ws + WS_H), (gu32*)(ws + WS_CTL) + 16 * 65 * l);
            else phase_normmod_jobs(F, MISC, xin, cin, ka->in[4] + l * D, mod, (bf16*)(ws + WS_H), (gu32*)(ws + WS_CTL) + 16 * 65 * l, (gu32*)(ws + WS_CTL));
        } else if (kind == 2) {
            MKFRAME(F);
            pg8::Gemm g{(const bf16*)(ws + WS_H), (const bf16*)(ws + WS_WIN) + (size_t)l * IN_W * D, M, IN_W, D}; pg8::StaticOrder S; S.init(M, IN_W, F.G, (int)blockIdx.x);
            pg8::EpiIn E{PB, ka->in[11] + l * 128, (const float*)(ws + WS_ROPE), ws + WS_KT, ws + WS_VT, (unsigned*)(ws + WS_AT)};
            {
                if (l == 0 && F.tid == 0) seam_wait_ge((gu32*)(ws + WS_CTL) + SEAM_PREPCNT, (unsigned)F.G);
                if (l > 0 && F.tid == 0) seam_wait_ge((gu32*)(ws + WS_CTL) + SEAM_MIXDONE, (unsigned)F.G);
                { pg8::Unit u_; u_.pm = 0; u_.pn = 0;
#pragma unroll 1
                  for (int i = 0; S.next(i, u_); ++i) { gu32* f_ = (gu32*)(ws + WS_CTL) + 16 * 65 * l + SEAM_HCNT(u_.pm); if (F.tid == 0) seam_wait_ge(f_, 32u); } }
                asm volatile("" ::: "memory");
                __syncthreads();
            }
            pg8::gemm_phase<pg8::EpiIn, pg8::StaticOrder, true, true>(F.lds + RING_OFF, g, S, E, F.tid);
            { if (F.tid == 0) seam_wait_ge((gu32*)(ka->ws + WS_CTL) + 16 * 65 * l + SEAM_CCNT, (unsigned)(MT - M)); asm volatile("" ::: "memory"); __syncthreads(); }
            { const int ncg = upd ? 48 : 16, cg0 = upd ? 0 : 16;
              const bf16* Hc = (const bf16*)(ws + WS_H) + (size_t)M * D; const bf16* Wl = (const bf16*)(ws + WS_WIN) + (size_t)l * IN_W * D;
              if (F.vcu < 16 * ncg) {
                  bf16x8 a[8], b0[8], b1[8];
                  ctx_load(F, Hc, Wl, F.vcu & 15, cg0 + (F.vcu >> 4), a, b0, b1);
#pragma unroll 1
                  for (int id = F.vcu; id < 16 * ncg; id += F.G) {
                      f32x16 c0, c1; ctx_mma(a, b0, b1, c0, c1);
                      const int nid = id + F.G;
                      if (nid < 16 * ncg) ctx_load(F, Hc, Wl, nid & 15, cg0 + (nid >> 4), a, b0, b1);
                      ctx_tail<0>(F, c0, c1, id & 15, cg0 + (id >> 4), PB + (size_t)M * IN_W, ka->in[11] + l * 128, nullptr, nullptr, nullptr, ws + WS_KT, ws + WS_VT, (unsigned*)(ws + WS_AT));
                  }
              } }
        } else if (kind == 3) {
        } else if (kind == 4) {
            {
                MKFRAME(F);
                const float* TW = (const float*)(ws + WS_TW);
                gu32* fcnt = (gu32*)(ws + WS_CTL) + CW_FFT + 64 * l;
                const int nfft = upd ? 512 : 256;
#pragma unroll 1
                for (int it = F.vcu; it < nfft; it += F.G) {
                    const bool cx = it >= 256; const int j = it & 255, b = j >> 7, p = j & 127;
                    const size_t eo = cx ? AT_CTX + (size_t)(b * 128 + p) * CL : (size_t)(b * 128 + p) * L;
                    if (cx) fft_item(F, (const unsigned*)(ws + WS_AT) + eo, 8, (u32x2*)(ws + WS_U) + eo, TW);
                    else fft13_item(F, (const unsigned*)(ws + WS_AT) + eo, (u32x2*)(ws + WS_U) + eo, TW);
                    if (F.tid == 0) __hip_atomic_fetch_add(fcnt, 1u, __ATOMIC_RELAXED, __HIP_MEMORY_SCOPE_AGENT);
                }
            }
            const int skip = ka->skip;
            const int nitem = (skip & 1) ? 0 : (upd ? 528 : 512);
#pragma unroll 1
            for (int it = vcu; it < nitem; it += Gd) {
                const bool cx = it >= 512;
                const int j = cx ? it - 512 : it, bh = cx ? (j >> 1) : (j >> 6), qb = cx ? (j & 1) : (j & 63);
                int t2; asm volatile("v_mbcnt_lo_u32_b32 %0, -1, 0\n\tv_mbcnt_hi_u32_b32 %0, -1, %0" : "=v"(t2)); t2 += wave_id * 64;
                const __attribute__((address_space(4))) Args* ka2 = ka; asm volatile("" : "+s"(ka2));
                unsigned char* ws2 = ka2->ws; asm volatile("" : "+s"(ws2));
                att2::attn_item((const bf16*)(ws2 + WS_PB), ws2 + WS_KT, ws2 + WS_VT, (bf16*)(ws2 + WS_Y), ka2->in[13] + l * 128, (const float*)(ws2 + WS_SC) + l * 4, cx, bh >> 2, bh & 3, qb * 128, (char*)lds + RING_OFF, t2);
            }
            const int ntile = (skip & 2) ? 0 : (upd ? 264 : 256);
            MKFRAME(F2);
            asm volatile("s_waitcnt vmcnt(0)" ::: "memory");
            {
                gu32* fcnt = (gu32*)(ka->ws + WS_CTL) + CW_FFT + 64 * l; const unsigned want = upd ? 512u : 256u;
                if (F2.tid == 0) { unsigned sp = 0; while (__hip_atomic_load(fcnt, __ATOMIC_RELAXED, __HIP_MEMORY_SCOPE_AGENT) < want) { __builtin_amdgcn_s_sleep(8); if (++sp > (1u << 22)) break; }
                    __builtin_amdgcn_fence(__ATOMIC_ACQUIRE, "agent"); asm volatile("s_waitcnt vmcnt(0)" ::: "memory"); }
                __syncthreads();
                if (F2.tid == 0) {
                    for (int it = F2.vcu; it < nitem; it += F2.G) { const int blk = it < 512 ? ((it >> 8) * 32 + ((it & 63) >> 1)) : 64 + ((it - 512) >> 3);
                        (void)__hip_atomic_fetch_add((gu32*)(ka->ws + WS_CTL) + SEAM_YCNT(l, blk), 1u, __ATOMIC_RELAXED, __HIP_MEMORY_SCOPE_AGENT); } }
            }
            gu32* qcnt = (gu32*)(ka->ws + WS_CTL) + CW_Q + 64 * l;
            int prev = -1;
            if (F2.tid == 0) MISC[46] = __hip_atomic_fetch_add(qcnt, 1u, __ATOMIC_RELAXED, __HIP_MEMORY_SCOPE_AGENT);
#pragma unroll 1
            for (;;) {
                __syncthreads();
                const int it = __builtin_amdgcn_readfirstlane((int)MISC[46]);
                unsigned char* ws3 = ka->ws; asm volatile("" : "+s"(ws3));
                gu32* pub = nullptr;
                if (prev >= 0) { const int t_ = prev < ntile ? prev : prev - ntile; const int blk = t_ < 256 ? (t_ >> 2) : 64 + ((t_ - 256) >> 2); pub = (gu32*)(ws3 + WS_CTL) + SEAM_YCNT(l, blk); }
                __syncthreads();
                if (it >= 2 * ntile) {
                    asm volatile("s_waitcnt vmcnt(0)" ::: "memory");
                    __syncthreads();
                    if (pub && F2.tid == 0) (void)__hip_atomic_fetch_add(pub, 1u, __ATOMIC_RELAXED, __HIP_MEMORY_SCOPE_AGENT);
                    break; }
                prev = it;
                if (it < ntile) {
                    const bool cx = it >= 256; const int j = it - 256;
                    const int rb = cx ? M + (j >> 2) * CL : (it >> 7) * L, Lr = cx ? CL : L, t0 = cx ? (j & 3) * 64 : (it & 127) * 64;
                    const unsigned n_ = pool_item(F2, (bf16*)(ws3 + WS_PB), (bf16*)(ws3 + WS_Y), rb, Lr, t0, (const bf16*)(ws3 + WS_WP) + (size_t)l * 4 * 64 * 64, ka->in[10] + l * 256, qcnt, pub);
                    if (F2.tid == 0) MISC[46] = n_;
                } else {
                    const unsigned n_ = flin_item(F2, (const bf16*)(ws3 + WS_PB), (const bf16*)(ws3 + WS_U), (bf16*)(ws3 + WS_Y), (it - ntile) * 64, (const bf16*)(ws3 + WS_WF) + (size_t)l * 4 * 64 * 128, qcnt, pub);
                    if (F2.tid == 0) MISC[46] = n_; }
            }
        } else {
            MKFRAME(F);
            const int Mo = M;
            pg8::Gemm g{Y, (const bf16*)(ws + WS_WOUT) + (size_t)l * D * D, Mo, D, D};
            pg8::EpiResL E{xin, out, mod, L, F.lds + RING_OFF, upd ? 1 : 0};
            gu32* oq = (gu32*)(ws + WS_CTL) + CW_Q + 64 * l + 48;
            if (upd && F.tid == 0) (void)__hip_atomic_fetch_add((gu32*)(ws + WS_CTL) + SEAM_MIXDONE, 1u, __ATOMIC_RELAXED, __HIP_MEMORY_SCOPE_AGENT);
#pragma unroll 1
            for (;;) {
                if (F.tid == 0) MISC[46] = __hip_atomic_fetch_add(oq, 1u, __ATOMIC_RELAXED, __HIP_MEMORY_SCOPE_AGENT);
                __syncthreads();
                const int tk = __builtin_amdgcn_readfirstlane((int)MISC[46]);
                __syncthreads();
                if (tk >= (Mo / 256) * 4) break;
                pg8::OneUnit S; S.pm = tk >> 2; S.pn = tk & 3;
                if (F.tid == 0) seam_wait_ge((gu32*)(ws + WS_CTL) + SEAM_YCNT(l, S.pm), 16u);
                asm volatile("" ::: "memory");
                __syncthreads();
                pg8::gemm_phase<pg8::EpiResL, pg8::OneUnit, true, true>(F.lds + RING_OFF, g, S, E, F.tid);
                if (upd && F.tid == 0) (void)__hip_atomic_fetch_add((gu32*)(ws + WS_CTL) + SEAM_XCNT(S.pm), 1u, __ATOMIC_RELAXED, __HIP_MEMORY_SCOPE_AGENT);
            }
            if (upd) {
#pragma unroll 1
                for (int id = F.vcu; id < 256; id += F.G) { if (F.tid == 0) seam_wait_ge((gu32*)(ka->ws + WS_CTL) + SEAM_YCNT(l, 64 + ((id & 15) >> 3)), 16u); asm volatile("" ::: "memory"); __syncthreads(); ctx_tile<1>(F, Y + (size_t)M * D, (const bf16*)(ws + WS_WOUT) + (size_t)l * D * D, id & 15, id >> 4, nullptr, nullptr, cin, (float*)(ws + WS_CTX1), mod + 2 * 3072 + 2048);
                    if (F.tid == 0) (void)__hip_atomic_fetch_add((gu32*)(ka->ws + WS_CTL) + SEAM_CXCNT, 1u, __ATOMIC_RELAXED, __HIP_MEMORY_SCOPE_AGENT); } }
        }
        if (ph + 1 < hi && kind != 3 && kind != 1 && kind != 0 && kind != 4 && kind != 5) xcd_barrier(bar);
    }
#undef MKFRAME
}


extern "C" void kernel_launch(void* const* d_in, const int* in_sizes, int n_in, void* d_out, int out_size, void* d_ws, size_t ws_size, hipStream_t stream) {
    static int grid = 0;
    if (grid == 0) {
        if (n_in != 15 || out_size != M * D || ws_size < WS_END) { fprintf(stderr, "kernel_launch: unexpected shapes (n_in %d out %d ws %zu)\n", n_in, out_size, ws_size); grid = -1; return; }
        int dev = 0, cus = 0, per_cu = 0;
        if (hipGetDevice(&dev) != hipSuccess || hipDeviceGetAttribute(&cus, hipDeviceAttributeMultiprocessorCount, dev) != hipSuccess) { grid = -1; return; }
        if (hipFuncSetAttribute((const void*)mk_fwd, hipFuncAttributeMaxDynamicSharedMemorySize, LDS_BYTES) != hipSuccess) { fprintf(stderr, "kernel_launch: hipFuncSetAttribute failed\n"); grid = -1; return; }
        if (hipOccupancyMaxActiveBlocksPerMultiprocessor(&per_cu, (const void*)mk_fwd, NWAVES * 64, LDS_BYTES) != hipSuccess || per_cu < 1) { fprintf(stderr, "kernel_launch: occupancy query says %d\n", per_cu); per_cu = 1; }
        (void)hipGetLastError();
        grid = cus;
    }
    if (grid < 0) return;
    (void)hipMemsetAsync((char*)d_ws + WS_CTL, 0, CTL_ZERO_BYTES, stream);
    Args a; memset(&a, 0, sizeof a);
    for (int i = 0; i < 15; ++i) a.in[i] = (const float*)d_in[i];
    a.out = (float*)d_out; a.ws = (unsigned char*)d_ws;
#if MK_PER_PHASE
    for (int ph = 0; ph < NPH; ++ph) { a.ph_lo = ph; a.ph_hi = ph + 1; hipLaunchKernelGGL(mk_fwd, dim3(grid), dim3(NWAVES * 64), LDS_BYTES, stream, a); }
#else
    a.ph_lo = 0; a.ph_hi = NPH; hipLaunchKernelGGL(mk_fwd, dim3(grid), dim3(NWAVES * 64), LDS_BYTES, stream, a);
#endif
    const hipError_t le = hipPeekAtLastError();
    if (le != hipSuccess) fprintf(stderr, "kernel_launch: launch failed: %s\n", hipGetErrorName(le));
}
```
